# Optimizing an MI355X kernel written in HIP

```python
import math
import jax, jax.numpy as jnp
from jax import lax
import numpy as np

D_MODEL = 1024
BATCH = 8
SEQ = 4096
DEPTH = 2

GRID_W = 64
CTX_LEN = 256
EPS = 1e-6

GLA_HEADS = 4
GLA_DK = D_MODEL // 16
GLA_DV = D_MODEL // 8
GLA_QK = GLA_HEADS * GLA_DK
GLA_V = GLA_HEADS * GLA_DV
GLA_RANK = 16
GLA_TAU = 16.0
GLA_CHUNK = 16

GDN_HEADS = 4
GDN_DK = D_MODEL // 8
GDN_DV = D_MODEL // 8
GDN_QK = GDN_HEADS * GDN_DK
GDN_V = GDN_HEADS * GDN_DV
GDN_CONV_DIM = 2 * GDN_QK + GDN_V
CONV_W = 3
GDN_CHUNK = 64

D_MIX = GLA_V + GDN_V
D_FF = 4 * D_MODEL
PROJ_WIDTHS = (GLA_QK, GLA_QK, GLA_V, GLA_V, GLA_RANK, GDN_CONV_DIM, GDN_V, 2 * GDN_HEADS, 2 * GDN_HEADS)
PROJ_DIM = GLA_QK * 2 + GLA_V * 2 + GLA_RANK + GDN_CONV_DIM + GDN_V + 4 * GDN_HEADS

kernel_name = "hybrid_gla_gdn_prefix_dit"


def rmsnorm(x, g):
    xf = x.astype(jnp.float32)
    y = xf * lax.rsqrt(jnp.mean(xf * xf, axis=-1, keepdims=True) + EPS)
    return (y * g.astype(jnp.float32)).astype(x.dtype)


def l2norm(x):
    return x * lax.rsqrt(jnp.sum(x * x, axis=-1, keepdims=True) + EPS)


def _heads(u, n_heads):
    B, T, _ = u.shape
    return u.reshape(B, T, n_heads, -1).transpose(0, 2, 1, 3)


def short_conv(u, w, rows):
    B, T, C = u.shape
    if rows is not None:
        u = u.reshape(B, rows, GRID_W, C)
    pad = CONV_W // 2
    up = jnp.pad(u, [(0, 0)] * (u.ndim - 2) + [(pad, pad), (0, 0)])
    L = u.shape[-2]
    y = sum(w[i] * up[..., i:i + L, :] for i in range(CONV_W))
    return y.reshape(B, T, C)


def gla_chunked(q, k, v, log_a, S0):
    B, H, T, DK = q.shape
    DV = v.shape[-1]
    C = GLA_CHUNK
    N = T // C
    q = q.reshape(B, H, N, C, DK)
    k = k.reshape(B, H, N, C, DK)
    v = v.reshape(B, H, N, C, DV)
    b = jnp.cumsum(log_a.reshape(B, H, N, C, DK), axis=3)
    b_last = b[:, :, :, -1:, :]
    causal = jnp.tril(jnp.ones((C, C), dtype=bool))[:, :, None]
    diff = b[:, :, :, :, None, :] - b[:, :, :, None, :, :]
    decay = jnp.exp(jnp.where(causal, diff, -jnp.inf))
    scores = jnp.sum(q[:, :, :, :, None, :] * k[:, :, :, None, :, :] * decay, axis=-1)
    intra = jnp.einsum('bhnij,bhnje->bhnie', scores, v)
    dS = jnp.einsum('bhnjd,bhnje->bhnde', k * jnp.exp(b_last - b), v)
    a_chunk = jnp.exp(b_last[:, :, :, 0, :])

    def step(S, inp):
        a_n, dS_n = inp
        return a_n[..., None] * S + dS_n, S

    S_fin, S_prev = lax.scan(step, S0, (jnp.moveaxis(a_chunk, 2, 0), jnp.moveaxis(dS, 2, 0)))
    S_prev = jnp.moveaxis(S_prev, 0, 2)
    inter = jnp.einsum('bhnid,bhnde->bhnie', q * jnp.exp(b), S_prev)
    return (intra + inter).reshape(B, H, T, DV), S_fin


def gdn_chunked(q, k, v, log_alpha, beta, S0):
    B, H, T, DK = q.shape
    DV = v.shape[-1]
    C = GDN_CHUNK
    N = T // C
    q = q.reshape(B, H, N, C, DK)
    k = k.reshape(B, H, N, C, DK)
    v = v.reshape(B, H, N, C, DV)
    beta = beta.reshape(B, H, N, C)
    g = jnp.cumsum(log_alpha.reshape(B, H, N, C), axis=-1)
    g_last = g[..., -1:]
    strict = jnp.tril(jnp.ones((C, C), dtype=bool), -1)
    incl = jnp.tril(jnp.ones((C, C), dtype=bool))
    gdiff = g[..., :, None] - g[..., None, :]
    kk = jnp.einsum('bhnid,bhnjd->bhnij', k, k)
    L = jnp.where(strict, beta[..., :, None] * kk * jnp.exp(jnp.where(strict, gdiff, 0.0)), 0.0)
    A = jnp.eye(C, dtype=L.dtype) + L
    U = lax.linalg.triangular_solve(A, beta[..., None] * v, left_side=True, lower=True, unit_diagonal=True)
    W = lax.linalg.triangular_solve(A, (beta * jnp.exp(g))[..., None] * k, left_side=True, lower=True,
                                    unit_diagonal=True)
    qk = jnp.einsum('bhnid,bhnjd->bhnij', q, k)
    Aqk = jnp.where(incl, qk * jnp.exp(jnp.where(incl, gdiff, 0.0)), 0.0)
    q_dec = q * jnp.exp(g)[..., None]
    k_dec = k * jnp.exp(g_last - g)[..., None]
    a_chunk = jnp.exp(g_last[..., 0])

    def step(S, inp):
        U_n, W_n, Aqk_n, qd_n, kd_n, a_n = inp
        delta = U_n - jnp.einsum('bhcd,bhde->bhce', W_n, S)
        o = jnp.einsum('bhcd,bhde->bhce', qd_n, S) + jnp.einsum('bhij,bhje->bhie', Aqk_n, delta)
        S_new = a_n[..., None, None] * S + jnp.einsum('bhcd,bhce->bhde', kd_n, delta)
        return S_new, o

    xs = tuple(jnp.moveaxis(t, 2, 0) for t in (U, W, Aqk, q_dec, k_dec, a_chunk))
    S_fin, o = lax.scan(step, S0, xs)
    return jnp.moveaxis(o, 0, 2).reshape(B, H, T, DV), S_fin


def prepare_mixers(h, w_in, w_lr, b_lr, conv_w, a_log, dt_bias, rows):
    f32 = jnp.float32
    B, T, _ = h.shape
    p = h @ w_in
    splits = np.cumsum(PROJ_WIDTHS)[:-1].tolist()
    q_a, k_a, v_a, g_a, r_a, qkv_b, g_b, a_b, beta_b = jnp.split(p, splits, axis=-1)
    gla_q = _heads(q_a.astype(f32), GLA_HEADS) * GLA_DK ** -0.5
    gla_k = _heads(k_a.astype(f32), GLA_HEADS)
    gla_v = _heads(v_a.astype(f32), GLA_HEADS)
    lr = jnp.einsum('btr,zrk->zbtk', r_a, w_lr) + b_lr[:, None, None, :]
    gla_log_a = (jax.nn.log_sigmoid(lr.astype(f32)) / GLA_TAU)
    gla_log_a = gla_log_a.reshape(2, B, T, GLA_HEADS, GLA_DK).transpose(0, 1, 3, 2, 4)
    qkv = jax.nn.silu(short_conv(qkv_b, conv_w, rows)).astype(f32)
    q_b, k_b, v_b = jnp.split(qkv, [GDN_QK, 2 * GDN_QK], axis=-1)
    gdn_q = l2norm(_heads(q_b, GDN_HEADS)) * GDN_DK ** -0.5
    gdn_k = l2norm(_heads(k_b, GDN_HEADS))
    gdn_v = _heads(v_b, GDN_HEADS)
    a = a_b.astype(f32).reshape(B, T, 2, GDN_HEADS)
    log_alpha = -jnp.exp(a_log.astype(f32)) * jax.nn.softplus(a + dt_bias.astype(f32))
    gdn_log_alpha = log_alpha.transpose(2, 0, 3, 1)
    gdn_beta = jax.nn.sigmoid(beta_b.astype(f32).reshape(B, T, 2, GDN_HEADS)).transpose(2, 0, 3, 1)
    return dict(gla_q=gla_q, gla_k=gla_k, gla_v=gla_v, gla_log_a=gla_log_a, gla_g=g_a.astype(f32),
                gdn_q=gdn_q, gdn_k=gdn_k, gdn_v=gdn_v, gdn_log_alpha=gdn_log_alpha, gdn_beta=gdn_beta,
                gdn_g=g_b.astype(f32))


def run_mixers(p, init):
    B = p['gla_q'].shape[0]
    if init is None:
        zg = jnp.zeros((B, GLA_HEADS, GLA_DK, GLA_DV), jnp.float32)
        zd = jnp.zeros((B, GDN_HEADS, GDN_DK, GDN_DV), jnp.float32)
        init = (zg, zg, zd, zd)
    o_gla, o_gdn, fin_gla, fin_gdn = 0.0, 0.0, [], []
    for d in range(2):
        f = (lambda u: jnp.flip(u, axis=2)) if d == 1 else (lambda u: u)
        oa, sa = gla_chunked(f(p['gla_q']), f(p['gla_k']), f(p['gla_v']), f(p['gla_log_a'][d]), init[d])
        ob, sb = gdn_chunked(f(p['gdn_q']), f(p['gdn_k']), f(p['gdn_v']), f(p['gdn_log_alpha'][d]),
                             f(p['gdn_beta'][d]), init[2 + d])
        o_gla = o_gla + f(oa)
        o_gdn = o_gdn + f(ob)
        fin_gla.append(sa)
        fin_gdn.append(sb)
    return o_gla, o_gdn, (fin_gla[0], fin_gla[1], fin_gdn[0], fin_gdn[1])


def merge_heads(o_gla, o_gdn, p, gla_norm_g, gdn_norm_g, w_out, dtype):
    B, _, T, _ = o_gla.shape
    ya = rmsnorm(o_gla, gla_norm_g).transpose(0, 2, 1, 3).reshape(B, T, GLA_V) * jax.nn.silu(p['gla_g'])
    yb = rmsnorm(o_gdn, gdn_norm_g).transpose(0, 2, 1, 3).reshape(B, T, GDN_V) * jax.nn.silu(p['gdn_g'])
    return jnp.concatenate([ya, yb], axis=-1).astype(dtype) @ w_out


def sq_relu_mlp(h, w1, w2):
    return jnp.square(jax.nn.relu(h @ w1)) @ w2


def setup_inputs(seed: int = 0) -> dict:
    key = jax.random.key(seed)
    ks = jax.random.split(key, 20)
    f32 = jnp.float32

    def nrm(k, shape, scale):
        return jax.random.normal(k, shape, f32) * scale

    x = nrm(ks[0], (BATCH, SEQ, D_MODEL), 1.0)
    c = nrm(ks[1], (BATCH, D_MODEL), 1.0)
    ctx = nrm(ks[2], (BATCH, CTX_LEN, D_MODEL), 1.0)
    c_ctx = nrm(ks[3], (D_MODEL,), 1.0)
    w_ada = nrm(ks[4], (DEPTH, D_MODEL, 6 * D_MODEL), 0.5 * D_MODEL ** -0.5)
    b_ada = nrm(ks[5], (DEPTH, 6 * D_MODEL), 0.01)
    norm1_g = 1.0 + nrm(ks[6], (DEPTH, D_MODEL), 0.02)
    norm2_g = 1.0 + nrm(ks[7], (DEPTH, D_MODEL), 0.02)
    w_in = nrm(ks[8], (DEPTH, D_MODEL, PROJ_DIM), D_MODEL ** -0.5)
    gla_w_lr = nrm(ks[9], (DEPTH, 2, GLA_RANK, GLA_QK), GLA_RANK ** -0.5)
    gla_b_lr = nrm(ks[10], (DEPTH, 2, GLA_QK), 0.1)
    gdn_conv_w = nrm(ks[11], (DEPTH, CONV_W, GDN_CONV_DIM), CONV_W ** -0.5)
    gdn_a_log = jnp.log(jax.random.uniform(ks[12], (DEPTH, 2, GDN_HEADS), f32, 1.0, 16.0))
    dt = jnp.exp(jax.random.uniform(ks[13], (DEPTH, 2, GDN_HEADS), f32, math.log(1e-3), math.log(1e-1)))
    gdn_dt_bias = dt + jnp.log(-jnp.expm1(-dt))
    gla_norm_g = 1.0 + nrm(ks[14], (DEPTH, GLA_DV), 0.02)
    gdn_norm_g = 1.0 + nrm(ks[15], (DEPTH, GDN_DV), 0.02)
    w_out = nrm(ks[16], (DEPTH, D_MIX, D_MODEL), D_MIX ** -0.5)
    w_ff1 = nrm(ks[17], (DEPTH, D_MODEL, D_FF), D_MODEL ** -0.5)
    w_ff2 = nrm(ks[18], (DEPTH, D_FF, D_MODEL), D_FF ** -0.5)
    final_norm_g = 1.0 + nrm(ks[19], (D_MODEL,), 0.02)
    return {"x": x, "c": c, "ctx": ctx, "c_ctx": c_ctx, "w_ada": w_ada, "b_ada": b_ada,
            "norm1_g": norm1_g, "norm2_g": norm2_g, "w_in": w_in, "gla_w_lr": gla_w_lr,
            "gla_b_lr": gla_b_lr, "gdn_conv_w": gdn_conv_w, "gdn_a_log": gdn_a_log,
            "gdn_dt_bias": gdn_dt_bias, "gla_norm_g": gla_norm_g, "gdn_norm_g": gdn_norm_g,
            "w_out": w_out, "w_ff1": w_ff1, "w_ff2": w_ff2, "final_norm_g": final_norm_g}


def reference(x, c, ctx, c_ctx, w_ada, b_ada, norm1_g, norm2_g, w_in, gla_w_lr, gla_b_lr, gdn_conv_w,
              gdn_a_log, gdn_dt_bias, gla_norm_g, gdn_norm_g, w_out, w_ff1, w_ff2, final_norm_g):
    B, T, _ = x.shape
    rows = T // GRID_W
    xc = ctx
    silu_c = jax.nn.silu(c)
    silu_cc = jax.nn.silu(c_ctx)
    for l in range(DEPTH):
        last = l == DEPTH - 1
        mod_x = (silu_c @ w_ada[l] + b_ada[l])[:, None, :]
        mod_c = silu_cc @ w_ada[l] + b_ada[l]
        sh1x, sc1x, gt1x, sh2x, sc2x, gt2x = jnp.split(mod_x, 6, axis=-1)
        sh1c, sc1c, gt1c, sh2c, sc2c, gt2c = jnp.split(mod_c, 6, axis=-1)
        hx = rmsnorm(x, norm1_g[l]) * (1.0 + sc1x) + sh1x
        hc = rmsnorm(xc, norm1_g[l]) * (1.0 + sc1c) + sh1c
        args = (w_in[l], gla_w_lr[l], gla_b_lr[l], gdn_conv_w[l], gdn_a_log[l], gdn_dt_bias[l])
        p_c = prepare_mixers(hc, *args, None)
        p_x = prepare_mixers(hx, *args, rows)
        oc_gla, oc_gdn, ctx_states = run_mixers(p_c, None)
        ox_gla, ox_gdn, _ = run_mixers(p_x, ctx_states)
        x = x + gt1x * merge_heads(ox_gla, ox_gdn, p_x, gla_norm_g[l], gdn_norm_g[l], w_out[l], x.dtype)
        hx2 = rmsnorm(x, norm2_g[l]) * (1.0 + sc2x) + sh2x
        x = x + gt2x * sq_relu_mlp(hx2, w_ff1[l], w_ff2[l])
        if not last:
            xc = xc + gt1c * merge_heads(oc_gla, oc_gdn, p_c, gla_norm_g[l], gdn_norm_g[l], w_out[l], xc.dtype)
            hc2 = rmsnorm(xc, norm2_g[l]) * (1.0 + sc2c) + sh2c
            xc = xc + gt2c * sq_relu_mlp(hc2, w_ff1[l], w_ff2[l])
    return rmsnorm(x, final_norm_g)
```

```cpp
#ifndef EMU
#include <hip/hip_runtime.h>
#include <hip/hip_cooperative_groups.h>
#include <cstdio>
#include <cstdint>
namespace cg = cooperative_groups;
typedef short bf16x8 __attribute__((ext_vector_type(8)));
typedef short s16x4 __attribute__((ext_vector_type(4)));
typedef float f32x4 __attribute__((ext_vector_type(4)));
typedef float f32x2 __attribute__((ext_vector_type(2)));
typedef unsigned u32x4 __attribute__((ext_vector_type(4)));
typedef unsigned u32x2 __attribute__((ext_vector_type(2)));
#define LAS __attribute__((address_space(3)))
#define DEV __device__ __forceinline__
#define MDEV __device__ __forceinline__
#else
#define LAS
#define DEV static inline __attribute__((always_inline))
#define MDEV inline __attribute__((always_inline))
#endif
typedef unsigned short bf16_t;

#ifndef CFG_BATCH
#define CFG_BATCH 8
#define CFG_SEQ 4096
#define CFG_CTX 256
#endif
constexpr int D = 1024, NB = CFG_BATCH, SEQ = CFG_SEQ, CTX = CFG_CTX, FF = 4096, NP = 3840, NPROJ = 3616;
constexpr int RL = NB * SEQ, RC = NB * CTX, ROWS = RL + RC;
constexpr int NCL = SEQ / 64, NCC = CTX / 64, NCH = ROWS / 64;
constexpr int NMOD = NB + 1;
constexpr bool SKIP_CTX_LAST = (RL % 256 == 0);
constexpr int M_LAST = SKIP_CTX_LAST ? RL : ROWS;
constexpr float EPSN = 1e-6f;
static_assert(ROWS % 256 == 0 && SEQ % 64 == 0 && CTX % 64 == 0, "shape");
constexpr int NT = 512, NWAVE = 8;

constexpr size_t al256(size_t x) { return (x + 255) & ~(size_t)255; }
constexpr size_t WS_CTL = 0;                                   constexpr size_t CTL_BYTES = 65536;
constexpr size_t WS_MOD = WS_CTL + CTL_BYTES;                  constexpr size_t MOD_BYTES = al256((size_t)2 * NMOD * 6 * D * 4);
constexpr size_t WS_GS = WS_MOD + MOD_BYTES;                   constexpr size_t GS_BYTES = al256((size_t)2 * 2 * NMOD * D * 4);
constexpr size_t WS_SHW1 = WS_GS + GS_BYTES;                   constexpr size_t SHW1_BYTES = al256((size_t)2 * NMOD * NP * 4);
constexpr size_t WS_SHW2 = WS_SHW1 + SHW1_BYTES;               constexpr size_t SHW2_BYTES = al256((size_t)2 * NMOD * FF * 4);
constexpr size_t WS_SUMSQ = WS_SHW2 + SHW2_BYTES;              constexpr size_t SUMSQ_BYTES = al256((size_t)5 * ROWS * 4);
constexpr size_t WS_GATE = WS_SUMSQ + SUMSQ_BYTES;             constexpr size_t GATE_BYTES = al256((size_t)ROWS * 32 * 4);
constexpr size_t WS_XC = WS_GATE + GATE_BYTES;                 constexpr size_t XC_BYTES = al256((size_t)RC * D * 4);
constexpr size_t WS_WIN = WS_XC + XC_BYTES;                    constexpr size_t WIN_BYTES = al256((size_t)NP * D * 2);
constexpr size_t WS_WOUT = WS_WIN + 2 * WIN_BYTES;             constexpr size_t WOUT_BYTES = al256((size_t)D * D * 2);
constexpr size_t WS_WFF1 = WS_WOUT + WOUT_BYTES;               constexpr size_t WFF1_BYTES = al256((size_t)FF * D * 2);
constexpr size_t WS_WFF2 = WS_WFF1 + WFF1_BYTES;               constexpr size_t WFF2_BYTES = al256((size_t)D * FF * 2);
constexpr size_t WS_QKVNC = WS_WFF2 + WFF2_BYTES;              constexpr size_t QKVNC_BYTES = al256((size_t)RC * 1536 * 2);
constexpr size_t WS_YC = WS_QKVNC + QKVNC_BYTES;               constexpr size_t YC_BYTES = al256((size_t)RC * D * 2);
constexpr size_t WS_TEMP = WS_YC + YC_BYTES;
constexpr size_t SZA = (size_t)ROWS * D * 2;
constexpr size_t TAQK_ITEM = 8192 + 8192 + 1024;
constexpr size_t T_A = WS_TEMP;
constexpr size_t T_PG = WS_TEMP + SZA;
constexpr size_t T_PGLAQK = WS_TEMP + 2 * SZA;
constexpr size_t T_PGLAV = T_PGLAQK + SZA / 2;
constexpr size_t T_PGDN = WS_TEMP + 3 * SZA;
constexpr size_t T_TAQK = T_PGDN + SZA + SZA / 2;
constexpr size_t TAQK_BYTES = al256((size_t)NCH * 8 * TAQK_ITEM);
constexpr size_t T_OGDN = T_TAQK + TAQK_BYTES;
constexpr size_t T_OGLA = T_A;
constexpr size_t T_Y = T_PGLAQK;
constexpr size_t T_HID = T_PG;
constexpr size_t WS_END = T_OGDN + SZA;
static_assert(T_HID + (size_t)ROWS * FF * 2 <= WS_END, "hid fits");
static_assert(WS_END <= (size_t)512 * 1024 * 1024, "workspace budget (512 MiB)");

constexpr int LDS_BYTES = 163840;
constexpr int LDS_RING = 0;

#ifndef EMU
DEV f32x4 mfma16(bf16x8 a, bf16x8 b, f32x4 c) { return __builtin_amdgcn_mfma_f32_16x16x32_bf16(a, b, c, 0, 0, 0); }
DEV f32x4 mfma4f32(float a, float b, f32x4 c) { return __builtin_amdgcn_mfma_f32_16x16x4f32(a, b, c, 0, 0, 0); }
DEV void block_sync() { __syncthreads(); }
DEV float wshfl_xor(float v, int m) { return __shfl_xor(v, m); }
DEV float wshfl_up(float v, int d) { return __shfl_up(v, d); }
DEV float wshfl(float v, int l) { return __shfl(v, l); }
DEV s16x4 lds_tr16(const LAS unsigned char* p) { return __builtin_amdgcn_ds_read_tr16_b64_v4i16((LAS s16x4*)p); }
DEV void atomic_addf(float* p, float v) { atomicAdd(p, v); }
DEV float fexp(float x) { return __builtin_amdgcn_exp2f(x * 1.4426950408889634f); }
DEV float flog(float x) { return __builtin_amdgcn_logf(x) * 0.6931471805599453f; }
DEV float frcp(float x) { return __builtin_amdgcn_rcpf(x); }
DEV float frsq(float x) { return __builtin_amdgcn_rsqf(x); }
DEV float fexp_raw(float x) { return __builtin_amdgcn_exp2f(x * 1.4426950408889634f); }
DEV float flog_raw(float x) { return __builtin_amdgcn_logf(x) * 0.6931471805599453f; }
DEV int uniform_i(int x) { return __builtin_amdgcn_readfirstlane(x); }
DEV int opaque_i(int x) { asm volatile("" : "+v"(x)); return x; }
DEV void wave_sync() { asm volatile("s_waitcnt lgkmcnt(0)" ::: "memory"); __builtin_amdgcn_wave_barrier(); }
DEV int tidx() { return opaque_i((int)threadIdx.x); }
#else
DEV f32x4 mfma16(bf16x8 a, bf16x8 b, f32x4 c) { return emu_mfma16(a, b, c); }
DEV f32x4 mfma4f32(float a, float b, f32x4 c) { return emu_mfma4f32(a, b, c); }
DEV void block_sync() { emu_syncthreads(); }
DEV float wshfl_xor(float v, int m) { return emu_shfl_xor(v, m); }
DEV float wshfl_up(float v, int d) { return emu_shfl_up(v, d); }
DEV float wshfl(float v, int l) { return emu_shfl(v, l); }
DEV s16x4 lds_tr16(const unsigned char* p) { return emu_ds_read_tr16(p); }
DEV void atomic_addf(float* p, float v) { emu_atomic_add(p, v); }
DEV float fexp(float x) { return expf(x); }
DEV float flog(float x) { return logf(x); }
DEV float frcp(float x) { return 1.0f / x; }
DEV float frsq(float x) { return 1.0f / sqrtf(x); }
DEV float fexp_raw(float x) { return expf(x); }
DEV float flog_raw(float x) { return logf(x); }
DEV int uniform_i(int x) { return x; }
DEV int opaque_i(int x) { return x; }
DEV void wave_sync() { int z = 0; (void)emu_wave_exchange(&z, 4); }
DEV int tidx() { return (int)threadIdx.x; }
#endif
#ifndef EMU
#define VM_DRAIN() asm volatile("s_waitcnt vmcnt(0)" ::: "memory")
#define LGKM_DRAIN() asm volatile("s_waitcnt lgkmcnt(0)" ::: "memory")
#define RAW_BAR() __builtin_amdgcn_s_barrier()
#define SCHED_FENCE() __builtin_amdgcn_sched_barrier(0)
#else
#define VM_DRAIN()
#define LGKM_DRAIN()
#define RAW_BAR() emu_syncthreads()
#define SCHED_FENCE()
#endif
DEV unsigned f2bf(float f) { unsigned u = __builtin_bit_cast(unsigned, f); return (u + 0x7fffu + ((u >> 16) & 1u)) >> 16; }
#ifndef EMU
typedef __bf16 hwbf16x2 __attribute__((ext_vector_type(2)));
DEV unsigned pk2(float lo, float hi) { const f32x2 f = {lo, hi}; return __builtin_bit_cast(unsigned, __builtin_convertvector(f, hwbf16x2)); }
#else
DEV unsigned pk2(float lo, float hi) { return f2bf(lo) | (f2bf(hi) << 16); }
#endif
DEV float bf2f(unsigned short s) { return __builtin_bit_cast(float, (unsigned)s << 16); }
DEV float bflo(unsigned u) { return __builtin_bit_cast(float, u << 16); }
DEV float bfhi(unsigned u) { return __builtin_bit_cast(float, u & 0xffff0000u); }
DEV float silu_f(float x) { return x * frcp(1.f + fexp(-x)); }
DEV float sigmoid_f(float x) { return frcp(1.f + fexp(-x)); }
DEV float logsigmoid_f(float x) { return fminf(x, 0.f) - flog(1.f + fexp(-fabsf(x))); }
DEV float softplus_f(float x) { return fmaxf(x, 0.f) + log1pf(fexp(-fabsf(x))); }
DEV float wave_sum(float v) {
#pragma unroll
    for (int o = 1; o < 64; o <<= 1) v += wshfl_xor(v, o);
    return v;
}
DEV int mod_of_row(int row) { return row < RL ? row / SEQ : NB; }
DEV int win_src_col(int n) {
    if (n < 1536) return n;
    if (n < 3584) return n + 16;
    if (n < 3600) return n - 3584 + 1536;
    if (n < 3616) return n;
    return -1;
}

#define PROF_B(t)
#define PROF_E(t)
struct Params {
    const float *x, *c, *ctx, *c_ctx, *w_ada, *b_ada, *norm1_g, *norm2_g, *w_in, *gla_w_lr, *gla_b_lr, *gdn_conv_w, *gdn_a_log, *gdn_dt_bias,
        *gla_norm_g, *gdn_norm_g, *w_out, *w_ff1, *w_ff2, *final_norm_g;
    float* out; unsigned char* ws;
};

template <class VecFn, class ColFn>
DEV void gemv_item(LAS unsigned char* lds, VecFn vecfn, const float* W, int ldw, ColFn colfn, int n0, const float* bias, float* out, int ldo) {
    LAS float* vec = (LAS float*)lds;
    LAS float* red = (LAS float*)(lds + NMOD * D * 4);
    const int tid = tidx(), wave = tid >> 6, lane = tid & 63;
    static_assert((NMOD * D) % NT == 0, "vec staging");
    { float tmp[NMOD * D / NT];
#pragma unroll
      for (int u = 0; u < NMOD * D / NT; ++u) { const int i = tid + u * NT; tmp[u] = vecfn(i / D, i % D); }
#pragma unroll
      for (int u = 0; u < NMOD * D / NT; ++u) vec[tid + u * NT] = tmp[u]; }
    block_sync();
    const int sc = colfn(n0 + lane);
    float acc[NMOD];
#pragma unroll
    for (int b = 0; b < NMOD; ++b) acc[b] = 0.f;
    const int k0 = wave * (D / 8);
    const float* wp = W + (sc >= 0 ? sc : 0);
    const float wm = sc >= 0 ? 1.f : 0.f;
#pragma unroll 1
    for (int k = k0; k < k0 + D / 8; k += 32) {
        float w[32];
#pragma unroll
        for (int u = 0; u < 32; ++u) w[u] = wp[(size_t)(k + u) * ldw];
#pragma unroll
        for (int u = 0; u < 32; ++u) { const float wv = w[u] * wm;
#pragma unroll
            for (int b = 0; b < NMOD; ++b) acc[b] += vec[b * D + k + u] * wv; }
    }
#pragma unroll
    for (int b = 0; b < NMOD; ++b) red[(wave * NMOD + b) * 64 + lane] = acc[b];
    block_sync();
    for (int i = tid; i < NMOD * 64; i += NT) {
        const int b = i >> 6, ln = i & 63; float s = 0.f;
#pragma unroll
        for (int w = 0; w < 8; ++w) s += red[(w * NMOD + b) * 64 + ln];
        const int sc2 = colfn(n0 + ln);
        if (bias && sc2 >= 0) s += bias[sc2];
        out[(size_t)b * ldo + n0 + ln] = s;
    }
    block_sync();
}
template <class ColFn>
DEV void transpose_item(const float* W, int K, int ldw, bf16_t* WT, int nblk, ColFn colfn, LAS float* scr, int item, int lane) {
    const int kb = item / nblk, nb = item % nblk, k0 = 64 * kb, n0 = 32 * nb;
    const int sc = colfn(n0 + (lane & 31));
    { float tv[32]; const float* wp = W + (sc >= 0 ? sc : 0); const float wm = sc >= 0 ? 1.f : 0.f;
#pragma unroll
      for (int i = 0; i < 32; ++i) tv[i] = wp[(size_t)(k0 + 2 * i + (lane >> 5)) * ldw];
#pragma unroll
      for (int i = 0; i < 32; ++i) scr[(2 * i + (lane >> 5)) * 33 + (lane & 31)] = tv[i] * wm; }
    wave_sync();
    const int c = lane & 7;
#pragma unroll
    for (int j = 0; j < 4; ++j) { const int n = (lane >> 3) + 8 * j; const LAS float* s = scr + (8 * c) * 33 + n;
        u32x4 o; o.x = pk2(s[0 * 33], s[1 * 33]); o.y = pk2(s[2 * 33], s[3 * 33]); o.z = pk2(s[4 * 33], s[5 * 33]); o.w = pk2(s[6 * 33], s[7 * 33]);
        *(u32x4*)(WT + (size_t)(n0 + n) * K + k0 + 8 * c) = o; }
    wave_sync();
}
struct ColId { MDEV int operator()(int n) const { return n; } };
struct ColWin { MDEV int operator()(int n) const { return win_src_col(n); } };

DEV void convert_weights(const Params& P, LAS unsigned char* lds, int vb, int nvb, int layer_set) {
    const int tid = tidx(), wave = tid >> 6, lane = tid & 63;
    LAS float* scr = (LAS float*)(lds + wave * 16384);
    const int gw = vb * NWAVE + wave, NGW = nvb * NWAVE;
    constexpr int I_IN = (D / 64) * (NP / 32), I_OUT = (D / 64) * (D / 32), I_F1 = (D / 64) * (FF / 32), I_F2 = (FF / 64) * (D / 32);
    bf16_t* win0 = (bf16_t*)(P.ws + WS_WIN); bf16_t* win1 = (bf16_t*)(P.ws + WS_WIN + WIN_BYTES);
    bf16_t* wout = (bf16_t*)(P.ws + WS_WOUT); bf16_t* wff1 = (bf16_t*)(P.ws + WS_WFF1); bf16_t* wff2 = (bf16_t*)(P.ws + WS_WFF2);
    const int l = layer_set;
    const int nitems = (l == 0 ? 2 * I_IN : 0) + I_OUT + I_F1 + I_F2;
    for (int it = gw; it < nitems; it += NGW) {
        int r = it;
        if (l == 0) {
            if (r < I_IN) { transpose_item(P.w_in, D, NPROJ, win0, NP / 32, ColWin(), scr, r, lane); continue; } r -= I_IN;
            if (r < I_IN) { transpose_item(P.w_in + (size_t)D * NPROJ, D, NPROJ, win1, NP / 32, ColWin(), scr, r, lane); continue; } r -= I_IN;
        }
        if (r < I_OUT) { transpose_item(P.w_out + (size_t)l * D * D, D, D, wout, D / 32, ColId(), scr, r, lane); continue; } r -= I_OUT;
        if (r < I_F1) { transpose_item(P.w_ff1 + (size_t)l * D * FF, D, FF, wff1, FF / 32, ColId(), scr, r, lane); continue; } r -= I_F1;
        transpose_item(P.w_ff2 + (size_t)l * FF * D, FF, D, wff2, D / 32, ColId(), scr, r, lane);
    }
}

DEV void phase0a(const Params& P, LAS unsigned char* lds, int vb, int nvb) {
    const int tid = tidx();
    { float* ss = (float*)(P.ws + WS_SUMSQ); for (size_t i = (size_t)vb * NT + tid; i < (size_t)5 * ROWS; i += (size_t)nvb * NT) ss[i] = 0.f; }
    float* MOD = (float*)(P.ws + WS_MOD);
    constexpr int NBLK = 6 * D / 64;
    for (int it = vb; it < 2 * NBLK; it += nvb) {
        const int l = it / NBLK, nb = it % NBLK;
        auto vf = [&](int b, int k) { const float v = b < NB ? P.c[(size_t)b * D + k] : P.c_ctx[k]; return silu_f(v); };
        gemv_item(lds, vf, P.w_ada + (size_t)l * D * 6 * D, 6 * D, ColId(), nb * 64, P.b_ada + (size_t)l * 6 * D, MOD + (size_t)l * NMOD * 6 * D, 6 * D);
    }
    block_sync();
    convert_weights(P, lds, vb, nvb, 0);
}

DEV void phase0b(const Params& P, LAS unsigned char* lds, int vb, int nvb) {
    const int tid = tidx(), wave = tid >> 6, lane = tid & 63;
    const float* MOD = (const float*)(P.ws + WS_MOD);
    { float* GS = (float*)(P.ws + WS_GS);
      for (int i = vb * NT + tid; i < 2 * 2 * NMOD * D; i += nvb * NT) {
          const int k = i % D, b = (i / D) % NMOD, wh = (i / (D * NMOD)) & 1, l = i / (D * NMOD * 2);
          const float g = (wh ? P.norm2_g : P.norm1_g)[l * D + k];
          GS[i] = g * (1.f + MOD[((size_t)l * NMOD + b) * 6 * D + (wh ? 4 : 1) * D + k]);
      } }
    constexpr int NB1 = NP / 64, NB2 = FF / 64;
    for (int it = vb; it < 2 * (NB1 + NB2); it += nvb) {
        const int l = it / (NB1 + NB2), r = it % (NB1 + NB2);
        if (r < NB1) {
            auto vf = [&](int b, int k) { return MOD[((size_t)l * NMOD + b) * 6 * D + 0 * D + k]; };
            gemv_item(lds, vf, P.w_in + (size_t)l * D * NPROJ, NPROJ, ColWin(), r * 64, nullptr, (float*)(P.ws + WS_SHW1) + (size_t)l * NMOD * NP, NP);
        } else {
            auto vf = [&](int b, int k) { return MOD[((size_t)l * NMOD + b) * 6 * D + 3 * D + k]; };
            gemv_item(lds, vf, P.w_ff1 + (size_t)l * D * FF, FF, ColId(), (r - NB1) * 64, nullptr, (float*)(P.ws + WS_SHW2) + (size_t)l * NMOD * FF, FF);
        }
    }
    bf16_t* A = (bf16_t*)(P.ws + T_A); float* ss = (float*)(P.ws + WS_SUMSQ);
    for (int row0 = 2 * (vb * NWAVE + wave); row0 < ROWS; row0 += 2 * nvb * NWAVE) {
        f32x4 v[2][4]; const float* scp[2];
#pragma unroll
        for (int u = 0; u < 2; ++u) { const int row = row0 + u; const int b9 = mod_of_row(row);
            const float* xr = row < RL ? P.x + (size_t)row * D : P.ctx + (size_t)(row - RL) * D;
            scp[u] = MOD + (size_t)b9 * 6 * D + 1 * D;
#pragma unroll
            for (int j = 0; j < 4; ++j) v[u][j] = *(const f32x4*)(xr + 4 * (64 * j + lane)); }
#pragma unroll
        for (int u = 0; u < 2; ++u) { const int row = row0 + u; float s = 0.f;
#pragma unroll
            for (int j = 0; j < 4; ++j) {
                const int col = 4 * (64 * j + lane);
                const f32x4 x = v[u][j]; const f32x4 g = *(const f32x4*)(P.norm1_g + col); const f32x4 c = *(const f32x4*)(scp[u] + col);
                s += (x[0] * x[0] + x[1] * x[1]) + (x[2] * x[2] + x[3] * x[3]);
                u32x2 o; o.x = pk2(x[0] * g[0] * (1.f + c[0]), x[1] * g[1] * (1.f + c[1])); o.y = pk2(x[2] * g[2] * (1.f + c[2]), x[3] * g[3] * (1.f + c[3]));
                *(u32x2*)(A + (size_t)row * D + col) = o;
            }
            s = wave_sum(s);
            if (lane == 0) ss[row] = s; }
    }
}

namespace pg8 {
constexpr int BM = 256, BK = 64, HALF = 128, HTB = HALF * BK * 2, STAGE_BYTES = 8 * HTB, NXCD = 8, WGM = 8;
DEV int lds_byte(int r, int c) { const int st = (r >> 4) * 2 + (c >> 5), rr = r & 15, cc = c & 31, ob = rr * 64 + cc * 2; return st * 1024 + (ob ^ (((ob >> 9) & 1) << 5)); }
DEV void stage_rc(int b, int& R, int& C) { const int st = b / 1024, sb = b % 1024, swz = sb ^ (((sb >> 9) & 1) << 5); R = (st >> 1) * 16 + swz / 64; C = (st & 1) * 32 + (swz % 64) / 2; }
DEV int perm32(int rho) { const int n = rho >> 4, i = rho & 15; return 8 * (i >> 2) + 4 * n + (i & 3); }
struct Unit { int pm, pn; };
struct Gemm { const bf16_t* A; const bf16_t* Bt; int M, N, K; };
struct StaticOrder {
    int nM, nN, nwg, G, c;
    MDEV void init(int M, int N, int G_, int c_) { nM = M / BM; nN = N / BM; nwg = nM * nN; G = G_; c = c_; }
    MDEV void tile_of(long L, Unit& u) const {
        int wgid = (int)L; { const int q = nwg / NXCD, r = nwg % NXCD, xcd = wgid % NXCD, off = wgid / NXCD; wgid = (xcd < r ? xcd * (q + 1) : r * (q + 1) + (xcd - r) * q) + off; }
        const int nig = WGM * nN, gid = wgid / nig, fm = gid * WGM, gsz = (nM - fm) < WGM ? (nM - fm) : WGM;
        u.pm = fm + ((wgid % nig) % gsz); u.pn = (wgid % nig) / gsz;
    }
    MDEV bool next(int i, Unit& u) const { const long L = (long)i * G + c; if (L >= nwg) return false; tile_of(L, u); return true; }
};
struct SegOrder {
    StaticOrder so; int pm0, l0, lstride, lcount;
    MDEV void init(int pm0_, int npm, int N, int l0_, int lstride_, int lcount_) { so.init(npm * BM, N, 1, 0); pm0 = pm0_; l0 = l0_; lstride = lstride_; lcount = lcount_; }
    MDEV bool next(int i, Unit& u) const { if (i >= lcount) return false; const long L = (long)l0 + (long)i * lstride; if (L >= so.nwg) return false; so.tile_of(L, u); u.pm += pm0; return true; }
};
#ifndef EMU
DEV unsigned cvt_pk_bf16(float lo, float hi) { return pk2(lo, hi); }
DEV void glds16(const void* g, LAS unsigned char* l) { __builtin_amdgcn_global_load_lds((const unsigned*)g, (LAS unsigned*)l, 16, 0, 0); }
#define PG8_WAIT_V(n) asm volatile("s_waitcnt vmcnt(" #n ")" ::: "memory")
#define PG8_WAIT_L(n) asm volatile("s_waitcnt lgkmcnt(" #n ")" ::: "memory")
#define PG8_BAR __builtin_amdgcn_s_barrier()
#define PG8_SCHED __builtin_amdgcn_sched_barrier(0)
#define PG8_PRIO(x) __builtin_amdgcn_s_setprio(x)
#else
DEV unsigned cvt_pk_bf16(float lo, float hi) { return pk2(lo, hi); }
DEV void glds16(const void* g, unsigned char* l) { memcpy(l + (threadIdx.x & 63) * 16, g, 16); }
#define PG8_WAIT_V(n)
#define PG8_WAIT_L(n)
#define PG8_BAR emu_syncthreads()
#define PG8_SCHED
#define PG8_PRIO(x)
#endif

template <class Epi, class Sched>
DEV void gemm_phase(LAS unsigned char* lds, const Gemm g, const Sched& S, const Epi& E) {
    const int tid = tidx(), wid = uniform_i(tid >> 6), lane = tid & 63, wr = wid >> 2, wc = wid & 3, fr = lane & 15, fq = lane >> 4;
    const int K = g.K, nt = K / BK;
    unsigned voffA[2], voffB[2];
#pragma unroll
    for (int i = 0; i < 2; ++i) { int R, C; stage_rc(tid * 16 + i * 8192, R, C); const int Rb = Epi::PERM ? ((R & ~31) + perm32(R & 31)) : R;
        voffA[i] = (unsigned)(R * K + C) * 2u; voffB[i] = (unsigned)(Rb * K + C) * 2u; }
    const size_t kstep = (size_t)(BK * 2);
    const size_t hstep = (size_t)HALF * K * 2;
    const size_t tstep = 2 * hstep;
    const unsigned ldsw = (unsigned)wid * 1024u;
    const int aoff = lds_byte(wr * 64 + fr, fq * 8), boff = lds_byte(wc * 32 + fr, fq * 8);
#define PG8_SA(b, h) (((b) * 2 + (h)) * HTB)
#define PG8_SB(b, h) ((4 + (b) * 2 + (h)) * HTB)
#define PG8_STAGE(bufoff, gbase, voff) do { _Pragma("unroll") for (int _i = 0; _i < 2; ++_i) \
        glds16((const char*)(gbase) + (voff)[_i], lds + (bufoff) + ldsw + _i * 8192); } while (0)
#define PG8_LDA(dst, b, h) do { _Pragma("unroll") for (int m = 0; m < 4; ++m) _Pragma("unroll") for (int k = 0; k < 2; ++k) dst[m][k] = *(const LAS bf16x8*)(lds + PG8_SA(b, h) + aoff + m * 2048 + k * 1024); } while (0)
#define PG8_LDB(dst, b, h) do { _Pragma("unroll") for (int n = 0; n < 2; ++n) _Pragma("unroll") for (int k = 0; k < 2; ++k) dst[n][k] = *(const LAS bf16x8*)(lds + PG8_SB(b, h) + boff + n * 2048 + k * 1024); } while (0)
#define PG8_MMA(ai, bj, At, Bt) do { PG8_PRIO(1); _Pragma("unroll") for (int m = 0; m < 4; ++m) _Pragma("unroll") for (int n = 0; n < 2; ++n) _Pragma("unroll") for (int k = 0; k < 2; ++k) \
        acc[ai][bj][m][n] = mfma16(Bt[n][k], At[m][k], acc[ai][bj][m][n]); PG8_PRIO(0); } while (0)
    Unit cur, nxt; int ui = 0;
    if (!S.next(0, cur)) return;
    f32x4 acc[2][2][4][2];
#pragma unroll
    for (int a = 0; a < 2; ++a)
#pragma unroll
        for (int b = 0; b < 2; ++b)
#pragma unroll
            for (int m = 0; m < 4; ++m)
#pragma unroll
                for (int n = 0; n < 2; ++n) acc[a][b][m][n] = (f32x4){0.f, 0.f, 0.f, 0.f};
    bf16x8 At[4][2], B0[2][2], B1[2][2];
    const char* cA = (const char*)g.A + (size_t)cur.pm * tstep; const char* cB = (const char*)g.Bt + (size_t)cur.pn * tstep;
    PG8_STAGE(PG8_SB(0, 0), cB, voffB); PG8_STAGE(PG8_SB(0, 1), cB + hstep, voffB); PG8_STAGE(PG8_SA(0, 0), cA, voffA); PG8_STAGE(PG8_SA(0, 1), cA + hstep, voffA);
    if (wr == 1) PG8_BAR;
    PG8_WAIT_V(2); PG8_BAR;
    PG8_STAGE(PG8_SB(1, 0), cB + kstep, voffB); PG8_STAGE(PG8_SA(1, 0), cA + kstep, voffA); PG8_STAGE(PG8_SB(1, 1), cB + hstep + kstep, voffB);
    PG8_WAIT_V(6); PG8_BAR;
    for (;;) {
        const bool has_next = S.next(ui + 1, nxt);
        const char* nA = has_next ? (const char*)g.A + (size_t)nxt.pm * tstep : cA; const char* nB = has_next ? (const char*)g.Bt + (size_t)nxt.pn * tstep : cB;
        for (int t = 0; t < nt; t += 2) {
            const bool last = (t == nt - 2);
            const char* a1 = cA + (size_t)(t + 1) * kstep;
            const char* a2 = last ? nA : cA + (size_t)(t + 2) * kstep; const char* b2 = last ? nB : cB + (size_t)(t + 2) * kstep;
            const char* a3 = a2 + kstep; const char* b3 = b2 + kstep;
            PG8_LDB(B0, 0, 0); PG8_LDB(B1, 0, 1); PG8_SCHED; PG8_LDA(At, 0, 0); PG8_STAGE(PG8_SA(1, 1), a1 + hstep, voffA);
            PG8_WAIT_V(8); PG8_WAIT_L(0); PG8_BAR; PG8_MMA(0, 0, At, B0); PG8_MMA(0, 1, At, B1); PG8_BAR; PG8_SCHED;
            PG8_LDA(At, 0, 1); PG8_STAGE(PG8_SB(0, 0), b2, voffB); PG8_STAGE(PG8_SB(0, 1), b2 + hstep, voffB); PG8_STAGE(PG8_SA(0, 0), a2, voffA);
            PG8_WAIT_V(8); PG8_WAIT_L(0); PG8_BAR; PG8_MMA(1, 0, At, B0); PG8_MMA(1, 1, At, B1); PG8_BAR; PG8_SCHED;
            PG8_LDB(B0, 1, 0); PG8_LDB(B1, 1, 1); PG8_SCHED; PG8_LDA(At, 1, 0); PG8_STAGE(PG8_SA(0, 1), a2 + hstep, voffA);
            PG8_WAIT_V(8); PG8_WAIT_L(0); PG8_BAR; PG8_MMA(0, 0, At, B0); PG8_MMA(0, 1, At, B1); PG8_BAR; PG8_SCHED;
            PG8_LDA(At, 1, 1); PG8_STAGE(PG8_SB(1, 0), b3, voffB); PG8_STAGE(PG8_SB(1, 1), b3 + hstep, voffB); PG8_STAGE(PG8_SA(1, 0), a3, voffA);
            PG8_WAIT_V(8); PG8_WAIT_L(0); PG8_BAR; PG8_MMA(1, 0, At, B0); PG8_MMA(1, 1, At, B1); PG8_BAR; PG8_SCHED;
        }
        if (wr == 0) PG8_BAR;
        E(acc, cur, wr, wc, fr, fq);
        if (!has_next) break;
#pragma unroll
        for (int a = 0; a < 2; ++a)
#pragma unroll
            for (int b = 0; b < 2; ++b)
#pragma unroll
                for (int m = 0; m < 4; ++m)
#pragma unroll
                    for (int n = 0; n < 2; ++n) acc[a][b][m][n] = (f32x4){0.f, 0.f, 0.f, 0.f};
        cur = nxt; cA = nA; cB = nB; ++ui;
        if (wr == 1) PG8_BAR;
    }
    PG8_WAIT_V(0);
    PG8_BAR;
#undef PG8_SA
#undef PG8_SB
#undef PG8_STAGE
#undef PG8_LDA
#undef PG8_LDB
#undef PG8_MMA
}

struct EpiIn {
    static constexpr bool PERM = true;
    const float* sumsq; const float* shw; unsigned char* ws;
    MDEV void operator()(const f32x4 (&acc)[2][2][4][2], const Unit& u, int wr, int wc, int fr, int fq) const {
        const int pn = u.pn;
        bf16_t* base; int ld, cofs;
        if (pn < 2) { base = (bf16_t*)(ws + T_PGLAQK); ld = 512; cofs = pn * 256; }
        else if (pn < 4) { base = (bf16_t*)(ws + T_PGLAV); ld = 512; cofs = (pn - 2) * 256; }
        else if (pn < 6) { base = (bf16_t*)(ws + T_PG); ld = 1024; cofs = (pn - 4) * 256; }
        else if (pn < 12) { base = (bf16_t*)(ws + T_PGDN); ld = 1536; cofs = (pn - 6) * 256; }
        else if (pn < 14) { base = (bf16_t*)(ws + T_PG); ld = 1024; cofs = 512 + (pn - 12) * 256; }
        else { base = nullptr; ld = 0; cofs = 0; }
        const int lc = wc * 32 + 8 * fq;
        const int r0 = u.pm * BM + wr * 64 + fr;
        const int b9t = mod_of_row(u.pm * BM); const bool uni = b9t == mod_of_row(u.pm * BM + BM - 1);
        float ssv[2][4];
#pragma unroll
        for (int ai = 0; ai < 2; ++ai)
#pragma unroll
            for (int m = 0; m < 4; ++m) ssv[ai][m] = sumsq[r0 + ai * HALF + m * 16];
        f32x4 bv[2][2];
        { const float* sh = shw + (size_t)b9t * NP + pn * BM + lc;
#pragma unroll
          for (int bj = 0; bj < 2; ++bj) { bv[bj][0] = *(const f32x4*)(sh + bj * HALF); bv[bj][1] = *(const f32x4*)(sh + bj * HALF + 4); } }
#pragma unroll
        for (int ai = 0; ai < 2; ++ai)
#pragma unroll
            for (int m = 0; m < 4; ++m) {
                const int row = r0 + ai * HALF + m * 16;
                const float rstd = frsq(ssv[ai][m] * (1.0f / D) + EPSN);
                if (!uni) { const float* sh = shw + (size_t)mod_of_row(row) * NP + pn * BM + lc;
#pragma unroll
                    for (int bj = 0; bj < 2; ++bj) { bv[bj][0] = *(const f32x4*)(sh + bj * HALF); bv[bj][1] = *(const f32x4*)(sh + bj * HALF + 4); } }
                if (base) {
#pragma unroll
                    for (int bj = 0; bj < 2; ++bj) {
                        const f32x4 v0 = acc[ai][bj][m][0] * rstd + bv[bj][0], v1 = acc[ai][bj][m][1] * rstd + bv[bj][1];
                        u32x4 w; w.x = cvt_pk_bf16(v0[0], v0[1]); w.y = cvt_pk_bf16(v0[2], v0[3]); w.z = cvt_pk_bf16(v1[0], v1[1]); w.w = cvt_pk_bf16(v1[2], v1[3]);
                        *(u32x4*)(base + (size_t)row * ld + cofs + lc + bj * HALF) = w;
                    }
                } else if (wc == 0) {
                    float* gp = (float*)(ws + WS_GATE) + (size_t)row * 32 + lc;
                    *(f32x4*)gp = acc[ai][0][m][0] * rstd + bv[0][0]; *(f32x4*)(gp + 4) = acc[ai][0][m][1] * rstd + bv[0][1];
                }
            }
    }
};
struct EpiFF1 {
    static constexpr bool PERM = true;
    const float* sumsq; const float* shw; bf16_t* hid;
    MDEV void operator()(const f32x4 (&acc)[2][2][4][2], const Unit& u, int wr, int wc, int fr, int fq) const {
        const int c0 = u.pn * BM + wc * 32 + 8 * fq;
        const int r0 = u.pm * BM + wr * 64 + fr;
        const int b9t = mod_of_row(u.pm * BM); const bool uni = b9t == mod_of_row(u.pm * BM + BM - 1);
        float ssv[2][4];
#pragma unroll
        for (int ai = 0; ai < 2; ++ai)
#pragma unroll
            for (int m = 0; m < 4; ++m) ssv[ai][m] = sumsq[r0 + ai * HALF + m * 16];
        f32x4 bv[2][2];
        { const float* sh = shw + (size_t)b9t * FF + c0;
#pragma unroll
          for (int bj = 0; bj < 2; ++bj) { bv[bj][0] = *(const f32x4*)(sh + bj * HALF); bv[bj][1] = *(const f32x4*)(sh + bj * HALF + 4); } }
#pragma unroll
        for (int ai = 0; ai < 2; ++ai)
#pragma unroll
            for (int m = 0; m < 4; ++m) {
                const int row = r0 + ai * HALF + m * 16;
                const float rstd = frsq(ssv[ai][m] * (1.0f / D) + EPSN);
                if (!uni) { const float* sh = shw + (size_t)mod_of_row(row) * FF + c0;
#pragma unroll
                    for (int bj = 0; bj < 2; ++bj) { bv[bj][0] = *(const f32x4*)(sh + bj * HALF); bv[bj][1] = *(const f32x4*)(sh + bj * HALF + 4); } }
#pragma unroll
                for (int bj = 0; bj < 2; ++bj) {
                    f32x4 v0 = acc[ai][bj][m][0] * rstd + bv[bj][0], v1 = acc[ai][bj][m][1] * rstd + bv[bj][1];
#pragma unroll
                    for (int e = 0; e < 4; ++e) { const float a = fmaxf(v0[e], 0.f), b = fmaxf(v1[e], 0.f); v0[e] = a * a; v1[e] = b * b; }
                    u32x4 w; w.x = cvt_pk_bf16(v0[0], v0[1]); w.y = cvt_pk_bf16(v0[2], v0[3]); w.z = cvt_pk_bf16(v1[0], v1[1]); w.w = cvt_pk_bf16(v1[2], v1[3]);
                    *(u32x4*)(hid + (size_t)row * FF + c0 + bj * HALF) = w;
                }
            }
    }
};
struct EpiRes {
    static constexpr bool PERM = false;
    const float* res_lat; const float* res_ctx;
    float* out_lat; float* out_ctx;
    const float* gt;
    const float* gsn;
    bf16_t* anext; float* ssn;
    MDEV void operator()(const f32x4 (&acc)[2][2][4][2], const Unit& u, int wr, int wc, int fr, int fq) const {
        const int c0 = u.pn * BM + wc * 32 + 4 * fq;
        float part[2][4];
        const int b9t = mod_of_row(u.pm * BM); const bool uni = b9t == mod_of_row(u.pm * BM + BM - 1);
        f32x4 gtv[2][2], gsv[2][2];
#pragma unroll
        for (int bj = 0; bj < 2; ++bj)
#pragma unroll
            for (int n = 0; n < 2; ++n) { const int col = c0 + bj * HALF + n * 16;
                gtv[bj][n] = *(const f32x4*)(gt + (size_t)b9t * 6 * D + col); gsv[bj][n] = gsn ? *(const f32x4*)(gsn + (size_t)b9t * D + col) : (f32x4){0.f, 0.f, 0.f, 0.f}; }
#pragma unroll
        for (int ai = 0; ai < 2; ++ai)
#pragma unroll
            for (int m = 0; m < 4; ++m) {
                const int row = u.pm * BM + ai * HALF + wr * 64 + m * 16 + fr;
                const float* rp = row < RL ? res_lat + (size_t)row * D : res_ctx + (size_t)(row - RL) * D;
                float* op = row < RL ? out_lat + (size_t)row * D : out_ctx + (size_t)(row - RL) * D;
                f32x4 rv[2][2];
#pragma unroll
                for (int bj = 0; bj < 2; ++bj)
#pragma unroll
                    for (int n = 0; n < 2; ++n) rv[bj][n] = *(const f32x4*)(rp + c0 + bj * HALF + n * 16);
                if (!uni) { const int b9 = mod_of_row(row);
#pragma unroll
                    for (int bj = 0; bj < 2; ++bj)
#pragma unroll
                        for (int n = 0; n < 2; ++n) { const int col = c0 + bj * HALF + n * 16;
                            gtv[bj][n] = *(const f32x4*)(gt + (size_t)b9 * 6 * D + col); if (gsn) gsv[bj][n] = *(const f32x4*)(gsn + (size_t)b9 * D + col); } }
                float s = 0.f;
#pragma unroll
                for (int bj = 0; bj < 2; ++bj)
#pragma unroll
                    for (int n = 0; n < 2; ++n) {
                        const int col = c0 + bj * HALF + n * 16;
                        const f32x4 xn = rv[bj][n] + gtv[bj][n] * acc[ai][bj][m][n];
                        *(f32x4*)(op + col) = xn;
                        s += (xn[0] * xn[0] + xn[1] * xn[1]) + (xn[2] * xn[2] + xn[3] * xn[3]);
                        if (gsn) { const f32x4 gs = gsv[bj][n]; u32x2 w; w.x = cvt_pk_bf16(xn[0] * gs[0], xn[1] * gs[1]); w.y = cvt_pk_bf16(xn[2] * gs[2], xn[3] * gs[3]);
                            *(u32x2*)(anext + (size_t)row * D + col) = w; }
                    }
                part[ai][m] = s;
            }
        if (ssn) {
#pragma unroll
            for (int ai = 0; ai < 2; ++ai) {
                float v[4];
#pragma unroll
                for (int m = 0; m < 4; ++m) { float s = part[ai][m]; s += wshfl_xor(s, 16); s += wshfl_xor(s, 32); v[m] = s; }
                const float mine = fq == 0 ? v[0] : fq == 1 ? v[1] : fq == 2 ? v[2] : v[3];
                atomic_addf(ssn + u.pm * BM + ai * HALF + wr * 64 + fq * 16 + fr, mine);
            }
        }
    }
};
}

DEV int swz256(int row, int chunk16) { return row * 256 + (((chunk16) ^ (row & 15)) << 4); }
DEV bf16_t* gdn_qkvn_row(unsigned char* ws, int row) {
    return row < RL ? (bf16_t*)(ws + T_PGDN) + (size_t)row * 1536 : (bf16_t*)(ws + WS_QKVNC) + (size_t)(row - RL) * 1536;
}
#ifndef EMU
DEV unsigned row_ror1(unsigned v) { return (unsigned)__builtin_amdgcn_update_dpp(0, (int)v, 0x121, 0xf, 0xf, false); }
DEV unsigned row_ror15(unsigned v) { return (unsigned)__builtin_amdgcn_update_dpp(0, (int)v, 0x12f, 0xf, 0xf, false); }
#else
DEV unsigned row_ror1(unsigned v) { const int l = threadIdx.x & 63; return __builtin_bit_cast(unsigned, emu_shfl(__builtin_bit_cast(float, v), (l & ~15) | ((l - 1) & 15))); }
DEV unsigned row_ror15(unsigned v) { const int l = threadIdx.x & 63; return __builtin_bit_cast(unsigned, emu_shfl(__builtin_bit_cast(float, v), (l & ~15) | ((l + 1) & 15))); }
#endif
DEV u32x4 ror1x4(const u32x4 v) { const unsigned a = v.x, b = v.y, c = v.z, d = v.w; u32x4 r; r.x = row_ror1(a); r.y = row_ror1(b); r.z = row_ror1(c); r.w = row_ror1(d); return r; }
DEV u32x4 ror15x4(const u32x4 v) { const unsigned a = v.x, b = v.y, c = v.z, d = v.w; u32x4 r; r.x = row_ror15(a); r.y = row_ror15(b); r.z = row_ror15(c); r.w = row_ror15(d); return r; }
DEV u32x4 shfl4(const u32x4 v, int src) {
    const unsigned a = v.x, b = v.y, c = v.z, d = v.w;
    u32x4 r;
    r.x = __builtin_bit_cast(unsigned, wshfl(__builtin_bit_cast(float, a), src));
    r.y = __builtin_bit_cast(unsigned, wshfl(__builtin_bit_cast(float, b), src));
    r.z = __builtin_bit_cast(unsigned, wshfl(__builtin_bit_cast(float, c), src));
    r.w = __builtin_bit_cast(unsigned, wshfl(__builtin_bit_cast(float, d), src));
    return r;
}
DEV void gdn_conv_unit(const Params& P, const LAS float* cwl, int l, int gc, int h, int part, int lane) {
    const int fr = lane & 15, fq = lane >> 4;
    const int row0 = gc * 64; const bool is_ctx = row0 >= RL;
    const bf16_t* raw = (const bf16_t*)(P.ws + T_PGDN) + part * 512 + h * 128 + 8 * fq;
    u32x4 c0[4][4], hp[4], hn[4];
#pragma unroll
    for (int it = 0; it < 4; ++it)
#pragma unroll
        for (int s4 = 0; s4 < 4; ++s4) c0[it][s4] = *(const u32x4*)(raw + (size_t)(row0 + 16 * it + fr) * 1536 + 32 * s4);
    { bool hasp = false, hasn = false;
      if (is_ctx) { const int pos0 = (row0 - RL) % CTX; hasp = pos0 > 0; hasn = pos0 + 64 < CTX; }
      const unsigned mp = hasp ? 0xffffffffu : 0u, mn = hasn ? 0xffffffffu : 0u;
      const bf16_t* rp = raw + (size_t)(hasp ? row0 - 1 : row0) * 1536; const bf16_t* rn = raw + (size_t)(hasn ? row0 + 64 : row0) * 1536;
#pragma unroll
      for (int s4 = 0; s4 < 4; ++s4) { hp[s4] = *(const u32x4*)(rp + 32 * s4) & mp; hn[s4] = *(const u32x4*)(rn + 32 * s4) & mn; } }
    const LAS float* cwp = cwl + part * 512 + h * 128 + 8 * fq;
#pragma unroll
    for (int it = 0; it < 4; ++it) {
        float y[4][8]; float ssq = 0.f;
#pragma unroll
        for (int s4 = 0; s4 < 4; ++s4) {
            const u32x4 up = ror1x4(c0[it][s4]), dn = ror15x4(c0[it][s4]);
            u32x4 upb, dnb;
            if (it > 0) upb = ror1x4(c0[it > 0 ? it - 1 : 0][s4]); else upb = hp[s4];
            if (it < 3) dnb = ror15x4(c0[it < 3 ? it + 1 : 3][s4]); else dnb = hn[s4];
            const u32x4 cm = fr > 0 ? up : upb, cp = fr < 15 ? dn : dnb, cc = c0[it][s4];
            const LAS float* cw = cwp + 32 * s4;
            f32x4 w0[2], w1[2], w2[2];
#pragma unroll
            for (int e = 0; e < 2; ++e) { w0[e] = *(const LAS f32x4*)(cw + 4 * e); w1[e] = *(const LAS f32x4*)(cw + 1536 + 4 * e); w2[e] = *(const LAS f32x4*)(cw + 3072 + 4 * e); }
#pragma unroll
            for (int j = 0; j < 4; ++j) {
                const int e = j >> 1, o = (j & 1) * 2;
                const float a = w0[e][o] * bflo(cm[j]) + w1[e][o] * bflo(cc[j]) + w2[e][o] * bflo(cp[j]);
                const float b = w0[e][o + 1] * bfhi(cm[j]) + w1[e][o + 1] * bfhi(cc[j]) + w2[e][o + 1] * bfhi(cp[j]);
                const float sa = silu_f(a), sb = silu_f(b);
                y[s4][2 * j] = sa; y[s4][2 * j + 1] = sb; ssq += sa * sa + sb * sb;
            }
        }
        float scale = 1.f;
        if (part < 2) { ssq += wshfl_xor(ssq, 16); ssq += wshfl_xor(ssq, 32); scale = 1.0f / sqrtf(ssq + EPSN); if (part == 0) scale *= 0.08838834764831845f; }
        bf16_t* orow = gdn_qkvn_row(P.ws, row0 + 16 * it + fr) + part * 512 + h * 128 + 8 * fq;
#pragma unroll
        for (int s4 = 0; s4 < 4; ++s4) { u32x4 w;
#pragma unroll
            for (int j = 0; j < 4; ++j) w[j] = pk2(y[s4][2 * j] * scale, y[s4][2 * j + 1] * scale);
            *(u32x4*)(orow + 32 * s4) = w; }
        SCHED_FENCE();
    }
}
DEV void gdn_mat_unit(const Params& P, LAS unsigned char* slot, LAS float* gb, int l, int gc, int h, int dir, int lane) {
    const int fr = lane & 15, fq = lane >> 4;
    const int row0 = gc * 64;
    unsigned char* item = P.ws + T_TAQK + (size_t)((gc * 4 + h) * 2 + dir) * TAQK_ITEM;
    bf16x8 Qf[4][4], Kf[4][4];
    { const bf16_t* qn0 = gdn_qkvn_row(P.ws, row0 + fr) + h * 128 + 8 * fq;
#pragma unroll
      for (int it = 0; it < 4; ++it)
#pragma unroll
        for (int s4 = 0; s4 < 4; ++s4) { Qf[it][s4] = *(const bf16x8*)(qn0 + (size_t)it * 16 * 1536 + 32 * s4); Kf[it][s4] = *(const bf16x8*)(qn0 + 512 + (size_t)it * 16 * 1536 + 32 * s4); } }
    { const int tok = dir ? 63 - lane : lane;
      const float* gr = (const float*)(P.ws + WS_GATE) + (size_t)(row0 + tok) * 32;
      const float av = gr[16 + dir * 4 + h], bbv = gr[24 + dir * 4 + h];
      const float la = -fexp(P.gdn_a_log[(l * 2 + dir) * 4 + h]) * softplus_f(av + P.gdn_dt_bias[(l * 2 + dir) * 4 + h]);
      const float beta = sigmoid_f(bbv);
      float g = la;
#pragma unroll
      for (int o = 1; o < 64; o <<= 1) { const float t = wshfl_up(g, o); if (lane >= o) g += t; }
      const float gl = wshfl(g, 63);
      gb[tok] = g; gb[64 + tok] = beta;
      float* sc = (float*)(item + 16384);
      sc[tok] = fexp(g); sc[64 + tok] = fexp(gl - g); sc[128 + tok] = beta; sc[192 + tok] = fexp(gl); }
    wave_sync();
    float gi[4][4], bi[4][4], gjv[4];
#pragma unroll
    for (int it = 0; it < 4; ++it) { const f32x4 gv = *(const LAS f32x4*)(gb + 16 * it + 4 * fq), bv = *(const LAS f32x4*)(gb + 64 + 16 * it + 4 * fq);
#pragma unroll
        for (int r = 0; r < 4; ++r) { gi[it][r] = gv[r]; bi[it][r] = bv[r]; } }
#pragma unroll
    for (int jt = 0; jt < 4; ++jt) gjv[jt] = gb[16 * jt + fr];
#pragma unroll
    for (int it = 0; it < 4; ++it)
#pragma unroll
        for (int jt = 0; jt < 4; ++jt) {
            f32x4 c = {0.f, 0.f, 0.f, 0.f};
            if (dir ? jt >= it : jt <= it) {
#pragma unroll
            for (int s4 = 0; s4 < 4; ++s4) c = mfma16(Qf[it][s4], Kf[jt][s4], c);
            }
            const int j = 16 * jt + fr; const float gj = gjv[jt];
#pragma unroll
            for (int r = 0; r < 4; ++r) { const int i = 16 * it + 4 * fq + r; const bool keep = dir ? j >= i : j <= i;
                const float v = c[r] * fexp(fminf(gi[it][r] - gj, 0.f)) * (keep ? 1.f : 0.f);
                *(LAS bf16_t*)(slot + (i * 64 + j) * 2) = (bf16_t)f2bf(v); }
        }
    wave_sync();
#pragma unroll 1
    for (int q = 0; q < 8; ++q) { const int off = (lane + 64 * q) * 16; *(u32x4*)(item + 8192 + off) = *(const LAS u32x4*)(slot + off); }
    wave_sync();
    LAS float* W = (LAS float*)slot;
#pragma unroll
    for (int it = 0; it < 4; ++it)
#pragma unroll
        for (int jt = 0; jt < 4; ++jt) {
            f32x4 c = {0.f, 0.f, 0.f, 0.f};
            if (dir ? jt >= it : jt <= it) {
#pragma unroll
            for (int s4 = 0; s4 < 4; ++s4) c = mfma16(Kf[it][s4], Kf[jt][s4], c);
            }
            const int j = 16 * jt + fr, jp = dir ? 63 - j : j; const float gj = gjv[jt];
#pragma unroll
            for (int r = 0; r < 4; ++r) { const int i = 16 * it + 4 * fq + r, ip = dir ? 63 - i : i;
                W[jp * 64 + ip] = bi[it][r] * c[r] * fexp(fminf(gi[it][r] - gj, 0.f)) * (jp < ip ? 1.f : 0.f); }
        }
    wave_sync();
    const int nj = dir ? 63 - lane : lane;
#pragma unroll 1
    for (int bk = 0; bk < 8; ++bk) {
        float sacc[8];
#pragma unroll
        for (int e = 0; e < 8; ++e) sacc[e] = (8 * bk + e == lane) ? 1.f : 0.f;
#pragma unroll 8
        for (int m = 0; m < 8 * bk; ++m) {
            const float xm = lane <= m ? W[m * 64 + lane] : 0.f;
            const f32x4 l0 = *(const LAS f32x4*)(W + m * 64 + 8 * bk), l1 = *(const LAS f32x4*)(W + m * 64 + 8 * bk + 4);
#pragma unroll
            for (int e = 0; e < 4; ++e) { sacc[e] -= l0[e] * xm; sacc[4 + e] -= l1[e] * xm; }
        }
        float xb[8];
#pragma unroll
        for (int e = 0; e < 8; ++e) {
            float v = sacc[e];
#pragma unroll
            for (int m = 0; m < e; ++m) v -= W[(8 * bk + m) * 64 + 8 * bk + e] * xb[m];
            xb[e] = v;
        }
#pragma unroll
        for (int e = 0; e < 8; ++e) if (lane <= 8 * bk + e) W[(8 * bk + e) * 64 + lane] = xb[e];
    }
    float x[64];
#pragma unroll
    for (int i = 0; i < 64; ++i) x[i] = lane <= i ? W[i * 64 + lane] : 0.f;
    wave_sync();
#pragma unroll
    for (int i = 0; i < 64; ++i) { const int ni = dir ? 63 - i : i; *(LAS bf16_t*)(slot + (ni * 64 + nj) * 2) = (bf16_t)f2bf(x[i]); }
    wave_sync();
#pragma unroll 1
    for (int q = 0; q < 8; ++q) { const int off = (lane + 64 * q) * 16; *(u32x4*)(item + off) = *(const LAS u32x4*)(slot + off); }
    wave_sync();
}
constexpr int PREP_CW = 0, PREP_SLOT0 = 18432, PREP_SLOT_STRIDE = 17408;
constexpr size_t CTL_QUEUE_OFS = 20480;
DEV int queue_pull(const Params& P, int inst, int vb, int first, int total, int lane) {
    unsigned* head = (unsigned*)(P.ws + WS_CTL + CTL_QUEUE_OFS + (size_t)(inst * 8 + (vb & 7)) * 256);
    unsigned k = 0;
#ifndef EMU
    if (lane == 0) k = __hip_atomic_fetch_add(head, 1u, __ATOMIC_RELAXED, __HIP_MEMORY_SCOPE_AGENT);
    k = (unsigned)__builtin_amdgcn_readfirstlane((int)k);
#else
    if (lane == 0) k = __atomic_fetch_add(head, 1u, __ATOMIC_SEQ_CST);
    k = __builtin_bit_cast(unsigned, wshfl(__builtin_bit_cast(float, k), 0));
#endif
    const long u = (long)first + (vb & 7) + 8l * k;
    return u < total ? (int)u : -1;
}
DEV void phase_prep_a(const Params& P, LAS unsigned char* lds, int l, int vb, int nvb) {
    const int tid = tidx(), wave = uniform_i(tid >> 6), lane = tid & 63;
    LAS float* cwl = (LAS float*)(lds + PREP_CW);
    { float tmp[9];
#pragma unroll
      for (int u = 0; u < 9; ++u) tmp[u] = P.gdn_conv_w[(size_t)l * 3 * 1536 + tid + u * NT];
#pragma unroll
      for (int u = 0; u < 9; ++u) cwl[tid + u * NT] = tmp[u]; }
    block_sync();
#pragma unroll 1
    for (int it = vb * NWAVE + wave; it >= 0 && it < NCH * 12; it = queue_pull(P, 2 * l, vb, nvb * NWAVE, NCH * 12, lane)) { const int part = it % 3, gh = it / 3; gdn_conv_unit(P, cwl, l, gh >> 2, gh & 3, part, opaque_i(lane)); }
    block_sync();
    if (l == 1) convert_weights(P, lds, vb, nvb, 1);
}
DEV void phase_prep_b(const Params& P, LAS unsigned char* lds, int l, int vb, int nvb) {
    const int tid = tidx(), wave = uniform_i(tid >> 6), lane = tid & 63;
    LAS unsigned char* slot = lds + wave * PREP_SLOT_STRIDE;
#pragma unroll 1
    for (int it = vb * NWAVE + wave; it >= 0 && it < NCH * 8; it = queue_pull(P, 2 * l + 1, vb, nvb * NWAVE, NCH * 8, lane)) gdn_mat_unit(P, slot, (LAS float*)(slot + 16384), l, it >> 3, (it >> 1) & 3, it & 1, opaque_i(lane));
    block_sync();
}

DEV int swz128(int row, int chunk16) { return row * 128 + (((chunk16) ^ ((row >> 1) & 7)) << 4); }
DEV bf16x8 pack_bf8(const f32x4& a, const f32x4& b) {
    u32x4 w; w.x = pk2(a[0], a[1]); w.y = pk2(a[2], a[3]); w.z = pk2(b[0], b[1]); w.w = pk2(b[2], b[3]); return __builtin_bit_cast(bf16x8, w);
}
DEV bf16x8 join_s4(const s16x4& a, const s16x4& b) { return (bf16x8){a[0], a[1], a[2], a[3], b[0], b[1], b[2], b[3]}; }
DEV bf16x8 afrag_pi256(const LAS unsigned char* tile, int row, int s, int fq) {
    const u32x2 lo = *(const LAS u32x2*)(tile + swz256(row, 4 * s + (fq >> 1)) + (fq & 1) * 8);
    const u32x2 hi = *(const LAS u32x2*)(tile + swz256(row, 4 * s + 2 + (fq >> 1)) + (fq & 1) * 8);
    return __builtin_bit_cast(bf16x8, (u32x4){lo.x, lo.y, hi.x, hi.y});
}
DEV bf16x8 afrag_pi128(const LAS unsigned char* tile, int row, int s, int fq) {
    const u32x2 lo = *(const LAS u32x2*)(tile + swz128(row, 4 * s + (fq >> 1)) + (fq & 1) * 8);
    const u32x2 hi = *(const LAS u32x2*)(tile + swz128(row, 4 * s + 2 + (fq >> 1)) + (fq & 1) * 8);
    return __builtin_bit_cast(bf16x8, (u32x4){lo.x, lo.y, hi.x, hi.y});
}
constexpr int GDN_ITEMS = NB * 16, GLA_ITEMS = NB * 8;
constexpr int GB_K = 0, GB_Q = 16384, GB_T = 32768, GB_AQ = 40960, GB_V = 49152, GB_SC = 57344, GB_SIZE = 58368;

DEV void gdn_chunk_of_step(int b, int dir, int s, int& gc) {
    if (s < NCC) { const int c = dir ? NCC - 1 - s : s; gc = RL / 64 + b * NCC + c; }
    else { const int c2 = s - NCC; const int c = dir ? NCL - 1 - c2 : c2; gc = b * NCL + c; }
}
DEV void gdn_issue_loads(const Params& P, LAS unsigned char* buf, int lw, int lane, int gc, int h, int dir, int dvh);
DEV void gdn_issue_loads(const Params& P, LAS unsigned char* buf, int lw, int lane, int gc, int h, int dir, int dvh) {
    const int row0 = gc * 64;
    const unsigned char* item = P.ws + T_TAQK + (size_t)((gc * 4 + h) * 2 + dir) * TAQK_ITEM;
#pragma unroll
    for (int jj = 0; jj < 4; ++jj) { const int j = 4 * jj + lw, r = 4 * j + (lane >> 4), ch = (lane & 15) ^ (r & 15);
        const bf16_t* rp = gdn_qkvn_row(P.ws, row0 + r) + h * 128 + ch * 8;
        pg8::glds16(rp, buf + GB_Q + 1024 * j); pg8::glds16(rp + 512, buf + GB_K + 1024 * j); }
#pragma unroll
    for (int jj = 0; jj < 2; ++jj) { const int j = 4 * jj + lw, r = 8 * j + (lane >> 3), pos = lane & 7, ch = pos ^ ((r >> 1) & 7);
        pg8::glds16(item + (r * 64 + ch * 8) * 2, buf + GB_T + 1024 * j); pg8::glds16(item + 8192 + (r * 64 + ch * 8) * 2, buf + GB_AQ + 1024 * j);
        pg8::glds16(gdn_qkvn_row(P.ws, row0 + r) + 1024 + h * 128 + dvh * 64 + pos * 8, buf + GB_V + 1024 * j); }
    if (lw == 0) pg8::glds16(item + 16384 + lane * 16, buf + GB_SC);
}
DEV void gdn_scan_item(const Params& P, LAS unsigned char* lds, int item, bool ctx_out) {
    const int tid = tidx(), wave = uniform_i(tid >> 6), lane0 = tid & 63;
    const int b = item % NB, rest = item / NB, h = rest >> 2, dir = (rest >> 1) & 1, dvh = rest & 1;
    constexpr int NS = NCC + NCL;
    const bool loader = wave >= 4; const int lw = wave - 4;
    int gc;
    if (loader) { gdn_chunk_of_step(b, dir, 0, gc); gdn_issue_loads(P, lds, lw, lane0, gc, h, dir, dvh); }
    f32x4 S[8];
#pragma unroll
    for (int i = 0; i < 8; ++i) S[i] = (f32x4){0.f, 0.f, 0.f, 0.f};
    if (loader) VM_DRAIN();
    RAW_BAR();
    for (int s = 0; s < NS; ++s) {
        LAS unsigned char* buf = lds + (s & 1) * GB_SIZE;
        if (loader) {
            if (s + 1 < NS) { gdn_chunk_of_step(b, dir, s + 1, gc); gdn_issue_loads(P, lds + ((s + 1) & 1) * GB_SIZE, lw, opaque_i(lane0), gc, h, dir, dvh); }
        } else {
            gdn_chunk_of_step(b, dir, s, gc);
            const int row0 = gc * 64, n0 = 16 * wave;
            const int lane = opaque_i(lane0), fr = lane & 15, fq = lane >> 4;
            const LAS float* SC = (const LAS float*)(buf + GB_SC);
            bf16x8 Sb[4];
#pragma unroll
            for (int k = 0; k < 4; ++k) Sb[k] = pack_bf8(S[2 * k], S[2 * k + 1]);
            f32x4 rr[4];
            { bf16x8 Af[4][4];
#pragma unroll
              for (int mt = 0; mt < 4; ++mt)
#pragma unroll
                for (int k = 0; k < 4; ++k) Af[mt][k] = afrag_pi256(buf + GB_K, 16 * mt + fr, k, fq);
              f32x4 acc[4];
#pragma unroll
              for (int mt = 0; mt < 4; ++mt) acc[mt] = (f32x4){0.f, 0.f, 0.f, 0.f};
#pragma unroll
              for (int k = 0; k < 4; ++k)
#pragma unroll
                for (int mt = 0; mt < 4; ++mt) acc[mt] = mfma16(Af[mt][k], Sb[k], acc[mt]);
#pragma unroll
              for (int mt = 0; mt < 4; ++mt) {
                const f32x4 eg = *(const LAS f32x4*)(SC + 16 * mt + 4 * fq), be = *(const LAS f32x4*)(SC + 128 + 16 * mt + 4 * fq);
#pragma unroll
                for (int j = 0; j < 4; ++j) { const float v = bf2f(*(const LAS bf16_t*)(buf + GB_V + (16 * mt + 4 * fq + j) * 128 + (n0 + fr) * 2)); rr[mt][j] = be[j] * (v - eg[j] * acc[mt][j]); }
              } }
            SCHED_FENCE();
            bf16x8 Rb[2] = {pack_bf8(rr[0], rr[1]), pack_bf8(rr[2], rr[3])};
            f32x4 dl[4];
            { bf16x8 Tf[4][2];
#pragma unroll
              for (int it = 0; it < 4; ++it)
#pragma unroll
                for (int k = 0; k < 2; ++k) Tf[it][k] = afrag_pi128(buf + GB_T, 16 * it + fr, k, fq);
#pragma unroll
              for (int it = 0; it < 4; ++it) dl[it] = (f32x4){0.f, 0.f, 0.f, 0.f};
#pragma unroll
              for (int k = 0; k < 2; ++k)
#pragma unroll
                for (int it = 0; it < 4; ++it) dl[it] = mfma16(Tf[it][k], Rb[k], dl[it]); }
            SCHED_FENCE();
            bf16x8 Db[2] = {pack_bf8(dl[0], dl[1]), pack_bf8(dl[2], dl[3])};
            { f32x4 ds[4];
#pragma unroll
              for (int mt = 0; mt < 4; ++mt) { const f32x4 el = *(const LAS f32x4*)(SC + 64 + 16 * mt + 4 * fq); ds[mt] = dl[mt] * el; }
              bf16x8 Dp[2] = {pack_bf8(ds[0], ds[1]), pack_bf8(ds[2], ds[3])};
              const float ach = SC[192];
#pragma unroll
              for (int dkt = 0; dkt < 8; ++dkt) S[dkt] = S[dkt] * ach;
#pragma unroll
              for (int hf = 0; hf < 2; ++hf) {
                  bf16x8 Kt[4][2];
#pragma unroll
                  for (int d4 = 0; d4 < 4; ++d4)
#pragma unroll
                    for (int k = 0; k < 2; ++k) {
                        const int dkt = 4 * hf + d4;
                        const int row = 32 * k + 4 * fq + ((lane >> 2) & 3), ch = 2 * dkt + ((lane & 3) >> 1), off = (lane & 1) * 8;
                        Kt[d4][k] = join_s4(lds_tr16(buf + GB_K + swz256(row, ch) + off), lds_tr16(buf + GB_K + swz256(row + 16, ch) + off));
                    }
#pragma unroll
                  for (int k = 0; k < 2; ++k)
#pragma unroll
                    for (int d4 = 0; d4 < 4; ++d4) S[4 * hf + d4] = mfma16(Kt[d4][k], Dp[k], S[4 * hf + d4]);
                  SCHED_FENCE();
              } }
            SCHED_FENCE();
            const bool want_o = ctx_out || row0 < RL;
            if (want_o) {
                LAS unsigned char* ost = lds + 2 * GB_SIZE + wave * 2048;
                f32x4 oa[4];
                { bf16x8 Qf[4][4];
#pragma unroll
                  for (int it = 0; it < 4; ++it)
#pragma unroll
                    for (int k = 0; k < 4; ++k) Qf[it][k] = afrag_pi256(buf + GB_Q, 16 * it + fr, k, fq);
#pragma unroll
                  for (int it = 0; it < 4; ++it) oa[it] = (f32x4){0.f, 0.f, 0.f, 0.f};
#pragma unroll
                  for (int k = 0; k < 4; ++k)
#pragma unroll
                    for (int it = 0; it < 4; ++it) oa[it] = mfma16(Qf[it][k], Sb[k], oa[it]); }
                SCHED_FENCE();
                { bf16x8 Gf[4][2];
#pragma unroll
                  for (int it = 0; it < 4; ++it)
#pragma unroll
                    for (int k = 0; k < 2; ++k) Gf[it][k] = afrag_pi128(buf + GB_AQ, 16 * it + fr, k, fq);
#pragma unroll
                  for (int it = 0; it < 4; ++it) oa[it] = oa[it] * *(const LAS f32x4*)(SC + 16 * it + 4 * fq);
#pragma unroll
                  for (int k = 0; k < 2; ++k)
#pragma unroll
                    for (int it = 0; it < 4; ++it) oa[it] = mfma16(Gf[it][k], Db[k], oa[it]); }
#pragma unroll
                for (int it = 0; it < 4; ++it)
#pragma unroll
                    for (int j = 0; j < 4; ++j) *(LAS bf16_t*)(ost + (16 * it + 4 * fq + j) * 32 + fr * 2) = (bf16_t)f2bf(oa[it][j]);
                wave_sync();
                bf16_t* og = (bf16_t*)(P.ws + T_OGDN) + ((size_t)dir * ROWS + row0) * 512 + h * 128 + dvh * 64 + n0;
#pragma unroll
                for (int i = 0; i < 2; ++i) { const int c = lane + 64 * i, row = c >> 1, half = c & 1;
                    *(u32x4*)(og + (size_t)row * 512 + half * 8) = *(const LAS u32x4*)(ost + row * 32 + half * 16); }
            }
        }
        if (loader) VM_DRAIN(); else LGKM_DRAIN();
        RAW_BAR();
    }
    VM_DRAIN(); block_sync();
}

constexpr int GL_RAW = 0, GL_RA = 32768, GL_V = 40960, GL_QK = 73728, GL_P = 106496, GL_VEC = 114688, GL_OST = 116736;
struct GlaDmaOff { unsigned qk[2], v[4], ra; };
DEV void gla_dma_offsets(GlaDmaOff& o, int pw, int lane) {
#pragma unroll
    for (int jj = 0; jj < 2; ++jj) { const int j = 4 * jj + pw, r = 8 * j + (lane >> 3), ch = (lane & 7) ^ ((r >> 1) & 7); o.qk[jj] = (unsigned)(r * 512 + ch * 8) * 2u; }
#pragma unroll
    for (int jj = 0; jj < 4; ++jj) { const int j = 4 * jj + pw, r = 4 * j + (lane >> 4), ch = (lane & 15) ^ (r & 15); o.v[jj] = (unsigned)(r * 512 + ch * 8) * 2u; }
    { const int idx = pw * 64 + lane, r = idx >> 2, c4 = idx & 3; o.ra = (unsigned)(r * 32 + c4 * 4) * 4u; }
}
DEV void gla_issue_raw(const Params& P, LAS unsigned char* lds, int slot, int pw, const GlaDmaOff& o, int gc, int h) {
    const size_t row0 = (size_t)gc * 64;
    const unsigned char* qk = P.ws + T_PGLAQK + (row0 * 512 + h * 64) * 2;
    LAS unsigned char* dst = lds + GL_RAW + slot * 16384;
#pragma unroll
    for (int jj = 0; jj < 2; ++jj) { const int j = 4 * jj + pw; pg8::glds16(qk + o.qk[jj], dst + 1024 * j); pg8::glds16(qk + 512 + o.qk[jj], dst + 8192 + 1024 * j); }
    pg8::glds16(P.ws + WS_GATE + row0 * 128 + o.ra, lds + GL_RA + slot * 4096 + 1024 * pw);
}
DEV void gla_issue_v(const Params& P, LAS unsigned char* lds, int slot, int pw, const GlaDmaOff& o, int gc, int h) {
    const unsigned char* vp = P.ws + T_PGLAV + ((size_t)gc * 64 * 512 + h * 128) * 2;
#pragma unroll
    for (int jj = 0; jj < 4; ++jj) { const int j = 4 * jj + pw; pg8::glds16(vp + o.v[jj], lds + GL_V + slot * 16384 + 1024 * j); }
}
template <bool BARB, int DIRC>
DEV void gla_alpha(LAS unsigned char* lds, int rslot, int oslot, int pw, int lane, const float (&wb)[4], float blr, const int (&offr)[4]) {
    constexpr int dir = DIRC, mtstep = DIRC ? -2048 : 2048;
    const int c = lane & 15, g = lane >> 4, dk = 16 * pw + c;
    const LAS float* RA = (const LAS float*)(lds + GL_RA + rslot * 4096);
    float bcs[4][4]; float toff = 0.f, bmid = 0.f;
    const int ra0 = (dir ? 63 - c : c) * 16 + g, rastep = dir ? -256 : 256;
#pragma unroll
    for (int mt = 0; mt < 4; ++mt) {
        f32x4 acc = {0.f, 0.f, 0.f, 0.f};
#pragma unroll
        for (int kk = 0; kk < 4; ++kk) acc = mfma4f32(RA[ra0 + mt * rastep + 4 * kk], wb[kk], acc);
        float run = 0.f;
#pragma unroll
        for (int r = 0; r < 4; ++r) { const float x = acc[r] + blr; run += (fminf(x, 0.f) - flog_raw(1.f + fexp_raw(-fabsf(x)))) * (1.0f / 16.0f); bcs[mt][r] = run; }
        const float t0 = wshfl(run, c), t1 = wshfl(run, c + 16), t2 = wshfl(run, c + 32), t3 = wshfl(run, c + 48);
        const float goff = (g > 0 ? t0 : 0.f) + (g > 1 ? t1 : 0.f) + (g > 2 ? t2 : 0.f);
#pragma unroll
        for (int r = 0; r < 4; ++r) bcs[mt][r] += toff + goff;
        toff += (t0 + t1) + (t2 + t3);
        if (mt == 1) bmid = toff;
    }
    const float blast = toff;
    if (BARB) { LGKM_DRAIN(); PROF_B(10); RAW_BAR(); PROF_E(10); }
    const LAS unsigned char* rq = lds + GL_RAW + rslot * 16384; LAS unsigned char* oq = lds + GL_QK + oslot * 16384;
    bf16_t qr[4][4], kr[4][4];
#pragma unroll
    for (int mt = 0; mt < 4; ++mt)
#pragma unroll
        for (int r = 0; r < 4; ++r) { const int off = offr[r] + mt * mtstep; qr[mt][r] = *(const LAS bf16_t*)(rq + off); kr[mt][r] = *(const LAS bf16_t*)(rq + 8192 + off); }
#pragma unroll
    for (int mt = 0; mt < 4; ++mt)
#pragma unroll
        for (int r = 0; r < 4; ++r) { const float bb = bcs[mt][r];
            const int off = offr[r] + mt * mtstep;
            const float ef = fexp_raw(bb - bmid), eb = frcp(ef);
            const float qv = bf2f(qr[mt][r]) * 0.125f * ef, kv = bf2f(kr[mt][r]) * eb;
            const unsigned pr = pk2(qv, kv);
            *(LAS bf16_t*)(oq + off) = (bf16_t)(pr & 0xffffu); *(LAS bf16_t*)(oq + 8192 + off) = (bf16_t)(pr >> 16); }
    if (g == 0) { LAS float* VEC = (LAS float*)(lds + GL_VEC + oslot * 1024); VEC[dk] = fexp_raw(bmid); VEC[64 + dk] = fexp_raw(blast - bmid); VEC[128 + dk] = fexp_raw(blast); }
}
DEV void gla_scan_item(const Params& P, LAS unsigned char* lds, int l, int item, bool ctx_out) {
    const int tid = tidx(), wave = uniform_i(tid >> 6), lane0 = tid & 63;
    const int b = item % NB, rest = item / NB, h = rest >> 1, dir = rest & 1;
    constexpr int NS = NCC + NCL;
    const bool producer = wave >= 4; const int pw = wave - 4, cw = wave;
    int gc;
    if (producer) {
        float wl[4];
        { const int dk = 16 * pw + (lane0 & 15);
#pragma unroll
          for (int kk = 0; kk < 4; ++kk) wl[kk] = P.gla_w_lr[(((size_t)l * 2 + dir) * 16 + 4 * kk + (lane0 >> 4)) * 256 + h * 64 + dk]; }
        const float blr = P.gla_b_lr[((size_t)l * 2 + dir) * 256 + h * 64 + 16 * pw + (lane0 & 15)];
        int offr[4];
        { const int dk = 16 * pw + (lane0 & 15), g = lane0 >> 4;
#pragma unroll
          for (int r = 0; r < 4; ++r) { const int ip = 4 * g + r, tok = dir ? 63 - ip : ip; offr[r] = swz128(tok, dk >> 3) + (dk & 7) * 2; } }
        GlaDmaOff dmo; gla_dma_offsets(dmo, pw, lane0);
        gdn_chunk_of_step(b, dir, 0, gc); gla_issue_raw(P, lds, 0, pw, dmo, gc, h); gla_issue_v(P, lds, 0, pw, dmo, gc, h);
        if (NS > 1) { gdn_chunk_of_step(b, dir, 1, gc); gla_issue_raw(P, lds, 1, pw, dmo, gc, h); }
        VM_DRAIN(); RAW_BAR();
        if (dir) gla_alpha<false, 1>(lds, 0, 0, pw, lane0, wl, blr, offr); else gla_alpha<false, 0>(lds, 0, 0, pw, lane0, wl, blr, offr);
        LGKM_DRAIN(); RAW_BAR();
#pragma unroll 1
        for (int s = 0; s < NS; ++s) {
            const int lane = opaque_i(lane0);
            if (s + 2 < NS) { gdn_chunk_of_step(b, dir, s + 2, gc); gla_issue_raw(P, lds, s & 1, pw, dmo, gc, h); }
            if (s + 1 < NS) { gdn_chunk_of_step(b, dir, s + 1, gc); gla_issue_v(P, lds, (s + 1) & 1, pw, dmo, gc, h);
                if (dir) gla_alpha<true, 1>(lds, (s + 1) & 1, (s + 1) & 1, pw, lane, wl, blr, offr); else gla_alpha<true, 0>(lds, (s + 1) & 1, (s + 1) & 1, pw, lane, wl, blr, offr); }
            else { RAW_BAR(); }
            PROF_B(12); VM_DRAIN(); PROF_E(12); LGKM_DRAIN(); PROF_B(11); RAW_BAR(); PROF_E(11);
        }
    } else {
        f32x4 S[4][2];
#pragma unroll
        for (int i = 0; i < 4; ++i) { S[i][0] = (f32x4){0.f, 0.f, 0.f, 0.f}; S[i][1] = (f32x4){0.f, 0.f, 0.f, 0.f}; }
        RAW_BAR(); RAW_BAR();
#pragma unroll 1
        for (int s = 0; s < NS; ++s) {
            const int lane = opaque_i(lane0), fr = lane & 15, fq = lane >> 4;
            gdn_chunk_of_step(b, dir, s, gc); const int row0 = gc * 64;
            const LAS unsigned char* QT = lds + GL_QK + (s & 1) * 16384; const LAS unsigned char* KT = QT + 8192;
            const LAS unsigned char* VT = lds + GL_V + (s & 1) * 16384; const LAS float* VEC = (const LAS float*)(lds + GL_VEC + (s & 1) * 1024);
            { const int it = cw;
              bf16x8 qa[2] = {*(const LAS bf16x8*)(QT + swz128(16 * it + fr, fq)), *(const LAS bf16x8*)(QT + swz128(16 * it + fr, 4 + fq))};
              bf16x8 kb[4][2];
#pragma unroll
              for (int jt = 0; jt < 4; ++jt)
#pragma unroll
                  for (int k = 0; k < 2; ++k) kb[jt][k] = *(const LAS bf16x8*)(KT + swz128(16 * jt + fr, 4 * k + fq));
              f32x4 pa[4];
#pragma unroll
              for (int jt = 0; jt < 4; ++jt) { pa[jt] = (f32x4){0.f, 0.f, 0.f, 0.f};
#pragma unroll
                  for (int k = 0; k < 2; ++k) pa[jt] = mfma16(qa[k], kb[jt][k], pa[jt]); }
#pragma unroll
              for (int jt = 0; jt < 4; ++jt)
#pragma unroll
                  for (int r = 0; r < 4; ++r) { const int i = 16 * it + 4 * fq + r, j = 16 * jt + fr; const bool keep = dir ? j >= i : j <= i;
                      *(LAS bf16_t*)(lds + GL_P + swz128(i, j >> 3) + (j & 7) * 2) = (bf16_t)f2bf(keep ? pa[jt][r] : 0.f); }
            }
            LGKM_DRAIN(); PROF_B(20); RAW_BAR(); PROF_E(20);
            bf16x8 Vb[2][2], Sb[2][2];
#pragma unroll
            for (int nt = 0; nt < 2; ++nt)
#pragma unroll
                for (int k = 0; k < 2; ++k) { const int row = 32 * k + 8 * fq + ((lane >> 2) & 3), ch = 4 * cw + 2 * nt + ((lane & 3) >> 1), off = (lane & 1) * 8;
                    Vb[nt][k] = join_s4(lds_tr16(VT + swz256(row, ch) + off), lds_tr16(VT + swz256(row + 4, ch) + off)); }
#pragma unroll
            for (int nt = 0; nt < 2; ++nt)
#pragma unroll
                for (int k = 0; k < 2; ++k) { const f32x4 e0 = *(const LAS f32x4*)(VEC + 32 * k + 4 * fq), e1 = *(const LAS f32x4*)(VEC + 32 * k + 16 + 4 * fq);
                    Sb[nt][k] = pack_bf8(S[2 * k][nt] * e0, S[2 * k + 1][nt] * e1); }
            if (ctx_out || row0 < RL) {
                LAS unsigned char* ost = lds + GL_OST + cw * 4096;
                f32x4 oacc[4][2];
#pragma unroll
                for (int it = 0; it < 4; ++it) {
                    const bf16x8 pf0 = *(const LAS bf16x8*)(lds + GL_P + swz128(16 * it + fr, fq)), pf1 = *(const LAS bf16x8*)(lds + GL_P + swz128(16 * it + fr, 4 + fq));
                    const bf16x8 qp0 = afrag_pi128(QT, 16 * it + fr, 0, fq), qp1 = afrag_pi128(QT, 16 * it + fr, 1, fq);
#pragma unroll
                    for (int nt = 0; nt < 2; ++nt) { f32x4 a = {0.f, 0.f, 0.f, 0.f};
                        a = mfma16(pf0, Vb[nt][0], a); a = mfma16(pf1, Vb[nt][1], a); a = mfma16(qp0, Sb[nt][0], a); a = mfma16(qp1, Sb[nt][1], a);
                        oacc[it][nt] = a; }
                }
#pragma unroll
                for (int it = 0; it < 4; ++it)
#pragma unroll
                    for (int nt = 0; nt < 2; ++nt)
#pragma unroll
                        for (int j = 0; j < 4; ++j) *(LAS bf16_t*)(ost + (16 * it + 4 * fq + j) * 64 + (16 * nt + fr) * 2) = (bf16_t)f2bf(oacc[it][nt][j]);
                wave_sync();
                bf16_t* og = (bf16_t*)(P.ws + T_OGLA) + ((size_t)dir * ROWS + row0) * 512 + h * 128 + 32 * cw;
#pragma unroll
                for (int i = 0; i < 4; ++i) { const int c = lane + 64 * i, row = c >> 2, q4 = c & 3;
                    *(u32x4*)(og + (size_t)row * 512 + q4 * 8) = *(const LAS u32x4*)(ost + row * 64 + q4 * 16); }
            }
#pragma unroll
            for (int dkt = 0; dkt < 4; ++dkt) {
                bf16x8 kt[2];
#pragma unroll
                for (int k = 0; k < 2; ++k) { const int row = 32 * k + 8 * fq + ((lane >> 2) & 3), ch = 2 * dkt + ((lane & 3) >> 1), off = (lane & 1) * 8;
                    kt[k] = join_s4(lds_tr16(KT + swz128(row, ch) + off), lds_tr16(KT + swz128(row + 4, ch) + off)); }
                const f32x4 ac = *(const LAS f32x4*)(VEC + 128 + 16 * dkt + 4 * fq), el = *(const LAS f32x4*)(VEC + 64 + 16 * dkt + 4 * fq);
#pragma unroll
                for (int nt = 0; nt < 2; ++nt) { f32x4 a = {0.f, 0.f, 0.f, 0.f};
                    a = mfma16(kt[0], Vb[nt][0], a); a = mfma16(kt[1], Vb[nt][1], a);
                    S[dkt][nt] = S[dkt][nt] * ac + a * el; }
            }
            LGKM_DRAIN(); PROF_B(21); RAW_BAR(); PROF_E(21);
        }
    }
    VM_DRAIN(); block_sync();
}
DEV void phase_scan(const Params& P, LAS unsigned char* lds, int l, int vb, int nvb) {
    const bool ctx_out = (l == 0);
    for (int it = vb; it < GDN_ITEMS + GLA_ITEMS; it += nvb) {
        if (it < GDN_ITEMS) gdn_scan_item(P, lds, it, ctx_out); else gla_scan_item(P, lds, l, it - GDN_ITEMS, ctx_out);
    }
}

DEV void phase_merge(const Params& P, int l, int vb, int nvb) {
    const int tid = tidx(), wave = tid >> 6, lane = tid & 63;
    const int nrows = l == 1 ? M_LAST : ROWS;
    const bool gdn = lane >= 32; const int c0 = 16 * (lane & 31);
    const bf16_t* O = (const bf16_t*)(P.ws + (gdn ? T_OGDN : T_OGLA));
    float ngv[16];
    { const float* ng = (gdn ? P.gdn_norm_g : P.gla_norm_g) + l * 128 + (c0 & 127);
#pragma unroll
      for (int c = 0; c < 16; ++c) ngv[c] = ng[c]; }
    constexpr int RPI = 2;
    for (int rowb = RPI * (vb * NWAVE + wave); rowb < nrows; rowb += RPI * nvb * NWAVE) {
        u32x4 av[RPI][2], bv[RPI][2], gv[RPI][2];
#pragma unroll
        for (int u = 0; u < RPI; ++u) { const int row = rowb + u < nrows ? rowb + u : nrows - 1;
            const bf16_t* gp = (const bf16_t*)(P.ws + T_PG) + (size_t)row * 1024 + 16 * lane;
#pragma unroll
            for (int e = 0; e < 2; ++e) { av[u][e] = *(const u32x4*)(O + (size_t)row * 512 + c0 + 8 * e); bv[u][e] = *(const u32x4*)(O + ((size_t)ROWS + row) * 512 + c0 + 8 * e); gv[u][e] = *(const u32x4*)(gp + 8 * e); } }
#pragma unroll
        for (int u = 0; u < RPI; ++u) { const int row = rowb + u;
            float o[16]; float ssq = 0.f;
#pragma unroll
            for (int e = 0; e < 2; ++e)
#pragma unroll
                for (int j = 0; j < 4; ++j) { const float x0 = bflo(av[u][e][j]) + bflo(bv[u][e][j]), x1 = bfhi(av[u][e][j]) + bfhi(bv[u][e][j]); o[8 * e + 2 * j] = x0; o[8 * e + 2 * j + 1] = x1; ssq += x0 * x0 + x1 * x1; }
            ssq += wshfl_xor(ssq, 1); ssq += wshfl_xor(ssq, 2); ssq += wshfl_xor(ssq, 4);
            const float rs = frsq(ssq * (1.0f / 128.0f) + EPSN);
            if (row < nrows) {
                bf16_t* yp = ((row < RL || !SKIP_CTX_LAST) ? (bf16_t*)(P.ws + T_Y) + (size_t)row * 1024 : (bf16_t*)(P.ws + WS_YC) + (size_t)(row - RL) * 1024) + 16 * lane;
#pragma unroll
                for (int e = 0; e < 2; ++e) { u32x4 w;
#pragma unroll
                    for (int j = 0; j < 4; ++j) { const int c = 8 * e + 2 * j;
                        w[j] = pk2(o[c] * rs * ngv[c] * silu_f(bflo(gv[u][e][j])), o[c + 1] * rs * ngv[c + 1] * silu_f(bfhi(gv[u][e][j]))); }
                    *(u32x4*)(yp + 8 * e) = w; }
            }
        }
    }
}

DEV void phase_final(const Params& P, int vb, int nvb) {
    const int tid = tidx(), wave = tid >> 6, lane = tid & 63;
    const float* ss = (const float*)(P.ws + WS_SUMSQ) + (size_t)4 * ROWS;
    f32x4 g[4];
#pragma unroll
    for (int j = 0; j < 4; ++j) g[j] = *(const f32x4*)(P.final_norm_g + 4 * (64 * j + lane));
    for (int rowb = 2 * (vb * NWAVE + wave); rowb < RL; rowb += 2 * nvb * NWAVE) {
        f32x4 v[2][4]; float sv[2];
#pragma unroll
        for (int u = 0; u < 2; ++u) { const int row = rowb + u < RL ? rowb + u : RL - 1; sv[u] = ss[row + (lane & 0)];
#pragma unroll
            for (int j = 0; j < 4; ++j) v[u][j] = *(const f32x4*)(P.out + (size_t)row * D + 4 * (64 * j + lane)); }
#pragma unroll
        for (int u = 0; u < 2; ++u) { const int row = rowb + u; if (row < RL) { const float rs = frsq(sv[u] * (1.0f / D) + EPSN);
#pragma unroll
            for (int j = 0; j < 4; ++j) *(f32x4*)(P.out + (size_t)row * D + 4 * (64 * j + lane)) = v[u][j] * rs * g[j]; } }
    }
}

constexpr size_t CTL_CTXCNT = 16384;
static_assert(CTL_QUEUE_OFS + 4 * 8 * 256 <= CTL_BYTES && CTL_QUEUE_OFS > CTL_CTXCNT + 256, "control words");
#ifndef EMU
DEV void handoff_publish(unsigned* cnt) {
    asm volatile("s_waitcnt vmcnt(0)" ::: "memory"); __syncthreads();
    if (threadIdx.x == 0) { __builtin_amdgcn_fence(__ATOMIC_RELEASE, "agent"); asm volatile("s_waitcnt vmcnt(0)" ::: "memory"); __hip_atomic_fetch_add(cnt, 1u, __ATOMIC_RELAXED, __HIP_MEMORY_SCOPE_AGENT); }
}
DEV void handoff_wait(unsigned* cnt, unsigned need) {
    if (threadIdx.x == 0) { unsigned sp = 0; while (__hip_atomic_load(cnt, __ATOMIC_RELAXED, __HIP_MEMORY_SCOPE_AGENT) < need) { __builtin_amdgcn_s_sleep(4); if (++sp > (1u << 24)) break; }
        __builtin_amdgcn_fence(__ATOMIC_ACQUIRE, "agent"); asm volatile("s_waitcnt vmcnt(0)" ::: "memory"); }
    __syncthreads();
}
#else
DEV void handoff_publish(unsigned* cnt) { emu_syncthreads(); if (threadIdx.x == 0) __atomic_fetch_add(cnt, 1u, __ATOMIC_SEQ_CST); }
DEV void handoff_wait(unsigned* cnt, unsigned need) { if (threadIdx.x == 0) { while (__atomic_load_n(cnt, __ATOMIC_SEQ_CST) < need) sched_yield(); } emu_syncthreads(); }
#endif
constexpr int N_PHASES = 19;
DEV void run_phase(const Params& P, LAS unsigned char* lds, int ph, int vb, int nvb) {
    float* ss = (float*)(P.ws + WS_SUMSQ); const float* MOD = (const float*)(P.ws + WS_MOD); const float* GS = (const float*)(P.ws + WS_GS);
    if (ph == 0) { phase0a(P, lds, vb, nvb); return; }
    if (ph == 1) { phase0b(P, lds, vb, nvb); return; }
    if (ph == N_PHASES - 1) { phase_final(P, vb, nvb); return; }
    const int l = (ph - 2) / 8, sub = (ph - 2) % 8;
    const int Mx = l == 1 ? M_LAST : ROWS;
    float* xc = (float*)(P.ws + WS_XC);
    constexpr int PML = RL / 256, PMC = RC / 256;
    const bool defer = SKIP_CTX_LAST;
    if (sub == 0) {
        pg8::Gemm g{(const bf16_t*)(P.ws + T_A), (const bf16_t*)(P.ws + WS_WIN + (size_t)l * WIN_BYTES), ROWS, NP, D};
        pg8::EpiIn E{ss + (size_t)(2 * l) * ROWS, (const float*)(P.ws + WS_SHW1) + (size_t)l * NMOD * NP, P.ws};
        if (l == 0 || !defer) {
            pg8::StaticOrder S; S.init(ROWS, NP, nvb, vb);
            pg8::gemm_phase(lds + LDS_RING, g, S, E);
        } else {
            unsigned* cnt = (unsigned*)(P.ws + WS_CTL + CTL_CTXCNT);
            const int nct = PMC * (D / 256), nhb = nct < nvb ? nct : nvb;
            { pg8::Gemm g2{(const bf16_t*)(P.ws + T_HID), (const bf16_t*)(P.ws + WS_WFF2), ROWS, D, FF};
              pg8::SegOrder S; S.init(PML, PMC, D, vb, nvb, 1 << 20);
              pg8::EpiRes E2{P.out, xc, P.out, xc, MOD + 5 * D, GS + (size_t)(2) * NMOD * D, (bf16_t*)(P.ws + T_A), ss + (size_t)2 * ROWS};
              pg8::gemm_phase(lds + LDS_RING, g2, S, E2);
              if (vb < nhb) handoff_publish(cnt); }
            { const int ntot = PML * (NP / 256), nlight = nvb - nhb;
              const int per_light = nlight > 0 ? (ntot + 4 * nhb + nvb - 1) / nvb : 0, per_heavy = per_light > 4 ? per_light - 4 : 0;
              pg8::SegOrder S;
              if (vb >= nhb) S.init(0, PML, NP, vb - nhb, nlight, per_light); else S.init(0, PML, NP, nlight * per_light + vb, nhb, nlight > 0 ? per_heavy : 1 << 20);
              pg8::gemm_phase(lds + LDS_RING, g, S, E); }
            { pg8::SegOrder S; S.init(PML, PMC, NP, nvb - 1 - vb, nvb, 1 << 20);
              pg8::Unit u0; if (S.next(0, u0)) handoff_wait(cnt, (unsigned)nhb);
              pg8::gemm_phase(lds + LDS_RING, g, S, E); }
        }
    } else if (sub == 1) { phase_prep_a(P, lds, l, vb, nvb);
    } else if (sub == 2) { phase_prep_b(P, lds, l, vb, nvb);
    } else if (sub == 3) { phase_scan(P, lds, l, vb, nvb);
    } else if (sub == 4) { phase_merge(P, l, vb, nvb);
    } else if (sub == 5) {
        pg8::Gemm g{(const bf16_t*)(P.ws + T_Y), (const bf16_t*)(P.ws + WS_WOUT), Mx, D, D};
        pg8::EpiRes E{l == 0 ? P.x : P.out, l == 0 ? P.ctx : xc, P.out, xc, MOD + (size_t)l * NMOD * 6 * D + 2 * D, GS + (size_t)(l * 2 + 1) * NMOD * D,
                      (bf16_t*)(P.ws + T_A), ss + (size_t)(2 * l + 1) * ROWS};
        if (l == 0 && defer) { pg8::SegOrder S; S.init(0, PML, D, vb, nvb, 1 << 20); pg8::gemm_phase(lds + LDS_RING, g, S, E); }
        else { pg8::StaticOrder S; S.init(Mx, D, nvb, vb); pg8::gemm_phase(lds + LDS_RING, g, S, E); }
    } else if (sub == 6) {
        pg8::Gemm g{(const bf16_t*)(P.ws + T_A), (const bf16_t*)(P.ws + WS_WFF1), Mx, FF, D};
        pg8::EpiFF1 E{ss + (size_t)(2 * l + 1) * ROWS, (const float*)(P.ws + WS_SHW2) + (size_t)l * NMOD * FF, (bf16_t*)(P.ws + T_HID)};
        if (l == 0 && defer) {
            { pg8::Gemm g2{(const bf16_t*)(P.ws + WS_YC) - (size_t)RL * D, (const bf16_t*)(P.ws + WS_WOUT), ROWS, D, D};
              pg8::EpiRes E2{P.x, P.ctx, P.out, xc, MOD + 2 * D, GS + (size_t)(1) * NMOD * D, (bf16_t*)(P.ws + T_A), ss + (size_t)1 * ROWS};
              pg8::SegOrder S; S.init(PML, PMC, D, nvb - 1 - vb, nvb, 1 << 20); pg8::gemm_phase(lds + LDS_RING, g2, S, E2); }
            { pg8::SegOrder S; S.init(0, PML, FF, vb, nvb, 1 << 20); pg8::gemm_phase(lds + LDS_RING, g, S, E); }
        } else { pg8::StaticOrder S; S.init(Mx, FF, nvb, vb); pg8::gemm_phase(lds + LDS_RING, g, S, E); }
    } else {
        pg8::Gemm g{(const bf16_t*)(P.ws + T_HID), (const bf16_t*)(P.ws + WS_WFF2), Mx, D, FF};
        pg8::EpiRes E{P.out, xc, P.out, xc, MOD + (size_t)l * NMOD * 6 * D + 5 * D, l == 0 ? GS + (size_t)(2) * NMOD * D : nullptr,
                      (bf16_t*)(P.ws + T_A), ss + (size_t)(l == 0 ? 2 : 4) * ROWS};
        if (l == 0 && defer) {
            { pg8::Gemm g2{(const bf16_t*)(P.ws + T_A), (const bf16_t*)(P.ws + WS_WFF1), ROWS, FF, D};
              pg8::EpiFF1 E2{ss + (size_t)1 * ROWS, (const float*)(P.ws + WS_SHW2), (bf16_t*)(P.ws + T_HID)};
              pg8::SegOrder S; S.init(PML, PMC, FF, nvb - 1 - vb, nvb, 1 << 20); pg8::gemm_phase(lds + LDS_RING, g2, S, E2); }
            { pg8::SegOrder S; S.init(0, PML, D, vb, nvb, 1 << 20); pg8::gemm_phase(lds + LDS_RING, g, S, E); }
        } else { pg8::StaticOrder S; S.init(Mx, D, nvb, vb); pg8::gemm_phase(lds + LDS_RING, g, S, E); }
    }
}

#ifndef EMU
#define XB_TMO      128
#define XB_XCNT(j)  (256  + 64 * (j))
#define XB_XSUB(j)  (1280 + 64 * (j))
#define XB_XGEN(j)  (2304 + 64 * (j))
#define XB_TOP      3328
#define XB_TOPGEN   3392
#define XCD_BAR_WORDS 3456
#define XB_SPIN_CAP (1u << 22)
__device__ __forceinline__ unsigned xb_ld(unsigned* p)              { return __hip_atomic_load(p, __ATOMIC_RELAXED, __HIP_MEMORY_SCOPE_AGENT); }
__device__ __forceinline__ unsigned xb_add(unsigned* p, unsigned v) { return __hip_atomic_fetch_add(p, v, __ATOMIC_RELAXED, __HIP_MEMORY_SCOPE_AGENT); }
__device__ __forceinline__ unsigned xb_xcc_id() { return (unsigned)__builtin_amdgcn_s_getreg((3 << 11) | 20) & 0xFu; }
#define XB_SPIN(cond, bar) do { unsigned _sp = 0; while (cond) { __builtin_amdgcn_s_sleep(1); \
    if ((++_sp & 255u) == 0u) { if (xb_ld(&(bar)[XB_TMO])) break; if (_sp > XB_SPIN_CAP) { atomicAdd(&(bar)[XB_TMO], 1u); break; } } } } while (0)
struct XcdBarrier { unsigned* bar; unsigned x; volatile LAS unsigned* st; };
__device__ __forceinline__ XcdBarrier xcd_barrier_post(unsigned* bar, volatile LAS unsigned* st) {
    XcdBarrier b; b.bar = bar; b.x = xb_xcc_id(); b.st = st;
    if (threadIdx.x == 0) (void)xb_add(&bar[XB_XCNT(b.x)], 1u);
    return b;
}
__device__ __forceinline__ void xcd_barrier_complete(unsigned* bar, unsigned x, unsigned& nloc, unsigned& nx) {
    const unsigned G = gridDim.x * gridDim.y * gridDim.z;
    unsigned sum, cnt, mine, sp = 0u;
    for (;;) {
        sum = 0u; cnt = 0u; mine = 0u;
#pragma unroll
        for (unsigned j = 0; j < 16; ++j) { const unsigned c = xb_ld(&bar[XB_XCNT(j)]); sum += c; cnt += (c > 0u) ? 1u : 0u; mine = (j == x) ? c : mine; }
        if (sum == G) break;
        __builtin_amdgcn_s_sleep(1);
        if ((++sp & 255u) == 0u) { if (xb_ld(&bar[XB_TMO])) break; if (sp > XB_SPIN_CAP) { atomicAdd(&bar[XB_TMO], 1u); break; } }
    }
    nloc = mine > 0u ? mine : 1u; nx = cnt > 0u ? cnt : 1u;
}
__device__ __forceinline__ void xcd_barrier(const XcdBarrier& b) {
    asm volatile("s_waitcnt vmcnt(0)" ::: "memory");
    __syncthreads();
    if (threadIdx.x == 0) {
        unsigned* bar = b.bar;
        __builtin_amdgcn_s_waitcnt(0);
        unsigned nloc = b.st[0], nx = b.st[1];
        if (nloc == 0u) { xcd_barrier_complete(bar, b.x, nloc, nx); b.st[0] = nloc; b.st[1] = nx; }
        const unsigned old = xb_add(&bar[XB_XSUB(b.x)], 1u);
        const unsigned gen = old / nloc;
        if (old + 1u == (gen + 1u) * nloc) {
            __builtin_amdgcn_fence(__ATOMIC_RELEASE, "agent");
            asm volatile("s_waitcnt vmcnt(0)" ::: "memory");
            const unsigned og = xb_add(&bar[XB_TOP], 1u);
            const unsigned tg = og / nx;
            if (og + 1u == (tg + 1u) * nx) xb_add(&bar[XB_TOPGEN], 1u);
            else XB_SPIN(xb_ld(&bar[XB_TOPGEN]) == tg, bar);
            __builtin_amdgcn_fence(__ATOMIC_ACQUIRE, "agent");
            xb_add(&bar[XB_XGEN(b.x)], 1u);
            asm volatile("s_waitcnt vmcnt(0)" ::: "memory");
        } else {
            XB_SPIN(xb_ld(&bar[XB_XGEN(b.x)]) == gen, bar);
            __builtin_amdgcn_fence(__ATOMIC_ACQUIRE, "agent");
            asm volatile("s_waitcnt vmcnt(0)" ::: "memory");
        }
    }
    __syncthreads();
}
constexpr int LDS_MISC = 163840 - 256;

__global__ void __launch_bounds__(NT, 2) k_mega(Params P) {
    extern __shared__ __attribute__((aligned(16))) unsigned char lds_raw[];
    LAS unsigned char* lds = (LAS unsigned char*)lds_raw;
    cg::grid_group grid = cg::this_grid();
    if (threadIdx.x < 64) ((LAS unsigned*)(lds + LDS_MISC))[threadIdx.x] = 0u;
    __syncthreads();
    XcdBarrier bar = xcd_barrier_post((unsigned*)(P.ws + WS_CTL), (volatile LAS unsigned*)(lds + LDS_MISC));
    for (int ph = 0; ph < N_PHASES; ++ph) {
        run_phase(P, lds, ph, (int)blockIdx.x, (int)gridDim.x);
        if (ph == 0) grid.sync();
        else if (ph + 1 < N_PHASES) xcd_barrier(bar);
    }
}

extern "C" void kernel_launch(void* const* d_in, const int* in_sizes, int n_in, void* d_out, int out_size, void* d_ws, size_t ws_size, hipStream_t stream) {
    static int grid = 0;
    if (grid == 0) {
        int dev = 0, cus = 0, per_cu = 0;
        (void)hipGetDevice(&dev); (void)hipDeviceGetAttribute(&cus, hipDeviceAttributeMultiprocessorCount, dev);
        (void)hipFuncSetAttribute((const void*)k_mega, hipFuncAttributeMaxDynamicSharedMemorySize, LDS_BYTES);
        (void)hipOccupancyMaxActiveBlocksPerMultiprocessor(&per_cu, (const void*)k_mega, NT, LDS_BYTES);
        if (per_cu < 1) { fprintf(stderr, "kernel_launch: occupancy query says %d blocks per CU\n", per_cu); per_cu = 1; }
        if (per_cu > 1) per_cu = 1;
        grid = (cus > 0 ? cus : 256) * per_cu;
        if (ws_size < WS_END) { fprintf(stderr, "kernel_launch: workspace too small: %zu < %zu\n", ws_size, (size_t)WS_END); grid = -1; }
    }
    if (grid < 0) return;
    Params P{};
    const float** pp = (const float**)&P;
    for (int i = 0; i < 20; ++i) pp[i] = (const float*)d_in[i];
    P.out = (float*)d_out; P.ws = (unsigned char*)d_ws;
    (void)hipMemsetAsync((char*)d_ws + WS_CTL, 0, CTL_BYTES, stream);
    void* args[] = {&P};
    hipError_t e = hipLaunchCooperativeKernel((const void*)k_mega, dim3(grid), dim3(NT), args, LDS_BYTES, stream);
    if (e != hipSuccess) fprintf(stderr, "cooperative launch failed: %s (grid %d)\n", hipGetErrorString(e), grid);
}
#endif
```

```cpp
#ifndef EMU
#include <hip/hip_runtime.h>
#include <hip/hip_cooperative_groups.h>
#include <cstdio>
#include <cstdint>
namespace cg = cooperative_groups;
typedef short bf16x8 __attribute__((ext_vector_type(8)));
typedef short s16x4 __attribute__((ext_vector_type(4)));
typedef float f32x4 __attribute__((ext_vector_type(4)));
typedef float f32x2 __attribute__((ext_vector_type(2)));
typedef unsigned u32x4 __attribute__((ext_vector_type(4)));
typedef unsigned u32x2 __attribute__((ext_vector_type(2)));
#define LAS __attribute__((address_space(3)))
#define DEV __device__ __forceinline__
#define MDEV __device__ __forceinline__
#else
#define LAS
#define DEV static inline __attribute__((always_inline))
#define MDEV inline __attribute__((always_inline))
#endif
typedef unsigned short bf16_t;

#ifndef CFG_BATCH
#define CFG_BATCH 8
#define CFG_SEQ 4096
#define CFG_CTX 256
#endif
constexpr int D = 1024, NB = CFG_BATCH, SEQ = CFG_SEQ, CTX = CFG_CTX, FF = 4096, NP = 3840, NPROJ = 3616;
constexpr int RL = NB * SEQ, RC = NB * CTX, ROWS = RL + RC;
constexpr int NCL = SEQ / 64, NCC = CTX / 64, NCH = ROWS / 64;
constexpr int NMOD = NB + 1;
constexpr bool SKIP_CTX_LAST = (RL % 256 == 0);
constexpr int M_LAST = SKIP_CTX_LAST ? RL : ROWS;
constexpr float EPSN = 1e-6f;
static_assert(ROWS % 256 == 0 && SEQ % 64 == 0 && CTX % 64 == 0, "shape");
constexpr int NT = 512, NWAVE = 8;

constexpr size_t al256(size_t x) { return (x + 255) & ~(size_t)255; }
constexpr size_t WS_CTL = 0;                                   constexpr size_t CTL_BYTES = 65536;
constexpr size_t WS_MOD = WS_CTL + CTL_BYTES;                  constexpr size_t MOD_BYTES = al256((size_t)2 * NMOD * 6 * D * 4);
constexpr size_t WS_GS = WS_MOD + MOD_BYTES;                   constexpr size_t GS_BYTES = al256((size_t)2 * 2 * NMOD * D * 4);
constexpr size_t WS_SHW1 = WS_GS + GS_BYTES;                   constexpr size_t SHW1_BYTES = al256((size_t)2 * NMOD * NP * 4);
constexpr size_t WS_SHW2 = WS_SHW1 + SHW1_BYTES;               constexpr size_t SHW2_BYTES = al256((size_t)2 * NMOD * FF * 4);
constexpr size_t WS_SUMSQ = WS_SHW2 + SHW2_BYTES;              constexpr size_t SUMSQ_BYTES = al256((size_t)5 * ROWS * 4);
constexpr size_t WS_GATE = WS_SUMSQ + SUMSQ_BYTES;             constexpr size_t GATE_BYTES = al256((size_t)ROWS * 32 * 4);
constexpr size_t WS_XC = WS_GATE + GATE_BYTES;                 constexpr size_t XC_BYTES = al256((size_t)RC * D * 4);
constexpr size_t WS_WIN = WS_XC + XC_BYTES;                    constexpr size_t WIN_BYTES = al256((size_t)NP * D * 2);
constexpr size_t WS_WOUT = WS_WIN + 2 * WIN_BYTES;             constexpr size_t WOUT_BYTES = al256((size_t)D * D * 2);
constexpr size_t WS_WFF1 = WS_WOUT + WOUT_BYTES;               constexpr size_t WFF1_BYTES = al256((size_t)FF * D * 2);
constexpr size_t WS_WFF2 = WS_WFF1 + WFF1_BYTES;               constexpr size_t WFF2_BYTES = al256((size_t)D * FF * 2);
constexpr size_t WS_QKVNC = WS_WFF2 + WFF2_BYTES;              constexpr size_t QKVNC_BYTES = al256((size_t)RC * 1536 * 2);
constexpr size_t WS_YC = WS_QKVNC + QKVNC_BYTES;               constexpr size_t YC_BYTES = al256((size_t)RC * D * 2);
constexpr size_t WS_TEMP = WS_YC + YC_BYTES;
constexpr size_t SZA = (size_t)ROWS * D * 2;
constexpr size_t TAQK_ITEM = 8192 + 8192 + 1024;
constexpr size_t T_A = WS_TEMP;
constexpr size_t T_PG = WS_TEMP + SZA;
constexpr size_t T_PGLAQK = WS_TEMP + 2 * SZA;
constexpr size_t T_PGLAV = T_PGLAQK + SZA / 2;
constexpr size_t T_PGDN = WS_TEMP + 3 * SZA;
constexpr size_t T_TAQK = T_PGDN + SZA + SZA / 2;
constexpr size_t TAQK_BYTES = al256((size_t)NCH * 8 * TAQK_ITEM);
constexpr size_t T_OGDN = T_TAQK + TAQK_BYTES;
constexpr size_t T_OGLA = T_A;
constexpr size_t T_Y = T_PGLAQK;
constexpr size_t T_HID = T_PG;
constexpr size_t WS_END = T_OGDN + SZA;
static_assert(T_HID + (size_t)ROWS * FF * 2 <= WS_END, "hid fits");
static_assert(WS_END <= (size_t)512 * 1024 * 1024, "workspace budget (512 MiB)");

constexpr int LDS_BYTES = 163840;
constexpr int LDS_RING = 0;

#ifndef EMU
DEV f32x4 mfma16(bf16x8 a, bf16x8 b, f32x4 c) { return __builtin_amdgcn_mfma_f32_16x16x32_bf16(a, b, c, 0, 0, 0); }
DEV f32x4 mfma4f32(float a, float b, f32x4 c) { return __builtin_amdgcn_mfma_f32_16x16x4f32(a, b, c, 0, 0, 0); }
DEV void block_sync() { __syncthreads(); }
DEV float wshfl_xor(float v, int m) { return __shfl_xor(v, m); }
DEV float wshfl_up(float v, int d) { return __shfl_up(v, d); }
DEV float wshfl(float v, int l) { return __shfl(v, l); }
DEV s16x4 lds_tr16(const LAS unsigned char* p) { return __builtin_amdgcn_ds_read_tr16_b64_v4i16((LAS s16x4*)p); }
DEV void atomic_addf(float* p, float v) { atomicAdd(p, v); }
DEV float fexp(float x) { return __builtin_amdgcn_exp2f(x * 1.4426950408889634f); }
DEV float flog(float x) { return __builtin_amdgcn_logf(x) * 0.6931471805599453f; }
DEV float frcp(float x) { return __builtin_amdgcn_rcpf(x); }
DEV float frsq(float x) { return __builtin_amdgcn_rsqf(x); }
DEV float fexp_raw(float x) { return __builtin_amdgcn_exp2f(x * 1.4426950408889634f); }
DEV float flog_raw(float x) { return __builtin_amdgcn_logf(x) * 0.6931471805599453f; }
DEV int uniform_i(int x) { return __builtin_amdgcn_readfirstlane(x); }
DEV int opaque_i(int x) { asm volatile("" : "+v"(x)); return x; }
DEV void wave_sync() { asm volatile("s_waitcnt lgkmcnt(0)" ::: "memory"); __builtin_amdgcn_wave_barrier(); }
DEV int tidx() { return opaque_i((int)threadIdx.x); }
#else
DEV f32x4 mfma16(bf16x8 a, bf16x8 b, f32x4 c) { return emu_mfma16(a, b, c); }
DEV f32x4 mfma4f32(float a, float b, f32x4 c) { return emu_mfma4f32(a, b, c); }
DEV void block_sync() { emu_syncthreads(); }
DEV float wshfl_xor(float v, int m) { return emu_shfl_xor(v, m); }
DEV float wshfl_up(float v, int d) { return emu_shfl_up(v, d); }
DEV float wshfl(float v, int l) { return emu_shfl(v, l); }
DEV s16x4 lds_tr16(const unsigned char* p) { return emu_ds_read_tr16(p); }
DEV void atomic_addf(float* p, float v) { emu_atomic_add(p, v); }
DEV float fexp(float x) { return expf(x); }
DEV float flog(float x) { return logf(x); }
DEV float frcp(float x) { return 1.0f / x; }
DEV float frsq(float x) { return 1.0f / sqrtf(x); }
DEV float fexp_raw(float x) { return expf(x); }
DEV float flog_raw(float x) { return logf(x); }
DEV int uniform_i(int x) { return x; }
DEV int opaque_i(int x) { return x; }
DEV void wave_sync() { int z = 0; (void)emu_wave_exchange(&z, 4); }
DEV int tidx() { return (int)threadIdx.x; }
#endif
#ifndef EMU
#define VM_DRAIN() asm volatile("s_waitcnt vmcnt(0)" ::: "memory")
#define LGKM_DRAIN() asm volatile("s_waitcnt lgkmcnt(0)" ::: "memory")
#define RAW_BAR() __builtin_amdgcn_s_barrier()
#define SCHED_FENCE() __builtin_amdgcn_sched_barrier(0)
#else
#define VM_DRAIN()
#define LGKM_DRAIN()
#define RAW_BAR() emu_syncthreads()
#define SCHED_FENCE()
#endif
DEV unsigned f2bf(float f) { unsigned u = __builtin_bit_cast(unsigned, f); return (u + 0x7fffu + ((u >> 16) & 1u)) >> 16; }
#ifndef EMU
typedef __bf16 hwbf16x2 __attribute__((ext_vector_type(2)));
DEV unsigned pk2(float lo, float hi) { const f32x2 f = {lo, hi}; return __builtin_bit_cast(unsigned, __builtin_convertvector(f, hwbf16x2)); }
#else
DEV unsigned pk2(float lo, float hi) { return f2bf(lo) | (f2bf(hi) << 16); }
#endif
DEV float bf2f(unsigned short s) { return __builtin_bit_cast(float, (unsigned)s << 16); }
DEV float bflo(unsigned u) { return __builtin_bit_cast(float, u << 16); }
DEV float bfhi(unsigned u) { return __builtin_bit_cast(float, u & 0xffff0000u); }
DEV float silu_f(float x) { return x * frcp(1.f + fexp(-x)); }
DEV float sigmoid_f(float x) { return frcp(1.f + fexp(-x)); }
DEV float logsigmoid_f(float x) { return fminf(x, 0.f) - flog(1.f + fexp(-fabsf(x))); }
DEV float softplus_f(float x) { return fmaxf(x, 0.f) + log1pf(fexp(-fabsf(x))); }
DEV float wave_sum(float v) {
#pragma unroll
    for (int o = 1; o < 64; o <<= 1) v += wshfl_xor(v, o);
    return v;
}
DEV int mod_of_row(int row) { return row < RL ? row / SEQ : NB; }
DEV int win_src_col(int n) {
    if (n < 1536) return n;
    if (n < 3584) return n + 16;
    if (n < 3600) return n - 3584 + 1536;
    if (n < 3616) return n;
    return -1;
}

#define PROF_B(t)
#define PROF_E(t)
struct Params {
    const float *x, *c, *ctx, *c_ctx, *w_ada, *b_ada, *norm1_g, *norm2_g, *w_in, *gla_w_lr, *gla_b_lr, *gdn_conv_w, *gdn_a_log, *gdn_dt_bias,
        *gla_norm_g, *gdn_norm_g, *w_out, *w_ff1, *w_ff2, *final_norm_g;
    float* out; unsigned char* ws;
};

template <class VecFn, class ColFn>
DEV void gemv_item(LAS unsigned char* lds, VecFn vecfn, const float* W, int ldw, ColFn colfn, int n0, const float* bias, float* out, int ldo) {
    LAS float* vec = (LAS float*)lds;
    LAS float* red = (LAS float*)(lds + NMOD * D * 4);
    const int tid = tidx(), wave = tid >> 6, lane = tid & 63;
    static_assert((NMOD * D) % NT == 0, "vec staging");
    { float tmp[NMOD * D / NT];
#pragma unroll
      for (int u = 0; u < NMOD * D / NT; ++u) { const int i = tid + u * NT; tmp[u] = vecfn(i / D, i % D); }
#pragma unroll
      for (int u = 0; u < NMOD * D / NT; ++u) vec[tid + u * NT] = tmp[u]; }
    block_sync();
    const int sc = colfn(n0 + lane);
    float acc[NMOD];
#pragma unroll
    for (int b = 0; b < NMOD; ++b) acc[b] = 0.f;
    const int k0 = wave * (D / 8);
    const float* wp = W + (sc >= 0 ? sc : 0);
    const float wm = sc >= 0 ? 1.f : 0.f;
#pragma unroll 1
    for (int k = k0; k < k0 + D / 8; k += 32) {
        float w[32];
#pragma unroll
        for (int u = 0; u < 32; ++u) w[u] = wp[(size_t)(k + u) * ldw];
#pragma unroll
        for (int u = 0; u < 32; ++u) { const float wv = w[u] * wm;
#pragma unroll
            for (int b = 0; b < NMOD; ++b) acc[b] += vec[b * D + k + u] * wv; }
    }
#pragma unroll
    for (int b = 0; b < NMOD; ++b) red[(wave * NMOD + b) * 64 + lane] = acc[b];
    block_sync();
    for (int i = tid; i < NMOD * 64; i += NT) {
        const int b = i >> 6, ln = i & 63; float s = 0.f;
#pragma unroll
        for (int w = 0; w < 8; ++w) s += red[(w * NMOD + b) * 64 + ln];
        const int sc2 = colfn(n0 + ln);
        if (bias && sc2 >= 0) s += bias[sc2];
        out[(size_t)b * ldo + n0 + ln] = s;
    }
    block_sync();
}
template <class ColFn>
DEV void transpose_item(const float* W, int K, int ldw, bf16_t* WT, int nblk, ColFn colfn, LAS float* scr, int item, int lane) {
    const int kb = item / nblk, nb = item % nblk, k0 = 64 * kb, n0 = 64 * nb;
    const int c4 = lane & 15, kr = lane >> 4;
    const int sc = colfn(n0 + 4 * c4);
    { f32x4 tv[16]; const float* wp = W + (sc >= 0 ? sc : 0); const float wm = sc >= 0 ? 1.f : 0.f;
#pragma unroll
      for (int i = 0; i < 16; ++i) tv[i] = *(const f32x4*)(wp + (size_t)(k0 + kr + 4 * i) * ldw);
#pragma unroll
      for (int i = 0; i < 16; ++i) { LAS float* d = scr + (kr + 4 * i) * 65 + 4 * c4; const f32x4 v = tv[i] * wm; d[0] = v[0]; d[1] = v[1]; d[2] = v[2]; d[3] = v[3]; } }
    wave_sync();
    const int c = lane & 7;
#pragma unroll
    for (int j = 0; j < 8; ++j) { const int n = (lane >> 3) + 8 * j; const LAS float* sp = scr + (8 * c) * 65 + n;
        u32x4 o; o.x = pk2(sp[0 * 65], sp[1 * 65]); o.y = pk2(sp[2 * 65], sp[3 * 65]); o.z = pk2(sp[4 * 65], sp[5 * 65]); o.w = pk2(sp[6 * 65], sp[7 * 65]);
        *(u32x4*)(WT + (size_t)(n0 + n) * K + k0 + 8 * c) = o; }
    wave_sync();
}
struct ColId { MDEV int operator()(int n) const { return n; } };
struct ColWin { MDEV int operator()(int n) const { return win_src_col(n); } };

DEV void convert_weights(const Params& P, LAS unsigned char* lds, int vb, int nvb, int layer_set) {
    const int tid = tidx(), wave = tid >> 6, lane = tid & 63;
    LAS float* scr = (LAS float*)(lds + wave * 16896);
    const int gw = vb * NWAVE + wave, NGW = nvb * NWAVE;
    constexpr int I_IN = (D / 64) * (NP / 64), I_OUT = (D / 64) * (D / 64), I_F1 = (D / 64) * (FF / 64), I_F2 = (FF / 64) * (D / 64);
    bf16_t* win0 = (bf16_t*)(P.ws + WS_WIN); bf16_t* win1 = (bf16_t*)(P.ws + WS_WIN + WIN_BYTES);
    bf16_t* wout = (bf16_t*)(P.ws + WS_WOUT); bf16_t* wff1 = (bf16_t*)(P.ws + WS_WFF1); bf16_t* wff2 = (bf16_t*)(P.ws + WS_WFF2);
    const int l = layer_set;
    const int nitems = (l == 0 ? 2 * I_IN : 0) + I_OUT + I_F1 + I_F2;
    for (int it = gw; it < nitems; it += NGW) {
        int r = it;
        if (l == 0) {
            if (r < I_IN) { transpose_item(P.w_in, D, NPROJ, win0, NP / 64, ColWin(), scr, r, lane); continue; } r -= I_IN;
            if (r < I_IN) { transpose_item(P.w_in + (size_t)D * NPROJ, D, NPROJ, win1, NP / 64, ColWin(), scr, r, lane); continue; } r -= I_IN;
        }
        if (r < I_OUT) { transpose_item(P.w_out + (size_t)l * D * D, D, D, wout, D / 64, ColId(), scr, r, lane); continue; } r -= I_OUT;
        if (r < I_F1) { transpose_item(P.w_ff1 + (size_t)l * D * FF, D, FF, wff1, FF / 64, ColId(), scr, r, lane); continue; } r -= I_F1;
        transpose_item(P.w_ff2 + (size_t)l * FF * D, FF, D, wff2, D / 64, ColId(), scr, r, lane);
    }
}

DEV void phase0a(const Params& P, LAS unsigned char* lds, int vb, int nvb) {
    const int tid = tidx();
    { float* ss = (float*)(P.ws + WS_SUMSQ); for (size_t i = (size_t)vb * NT + tid; i < (size_t)5 * ROWS; i += (size_t)nvb * NT) ss[i] = 0.f; }
    float* MOD = (float*)(P.ws + WS_MOD);
    constexpr int NBLK = 6 * D / 64;
    for (int it = vb; it < 2 * NBLK; it += nvb) {
        const int l = it / NBLK, nb = it % NBLK;
        auto vf = [&](int b, int k) { const float v = b < NB ? P.c[(size_t)b * D + k] : P.c_ctx[k]; return silu_f(v); };
        gemv_item(lds, vf, P.w_ada + (size_t)l * D * 6 * D, 6 * D, ColId(), nb * 64, P.b_ada + (size_t)l * 6 * D, MOD + (size_t)l * NMOD * 6 * D, 6 * D);
    }
    block_sync();
    convert_weights(P, lds, vb, nvb, 0);
}

DEV void phase0b(const Params& P, LAS unsigned char* lds, int vb, int nvb) {
    const int tid = tidx(), wave = tid >> 6, lane = tid & 63;
    const float* MOD = (const float*)(P.ws + WS_MOD);
    { float* GS = (float*)(P.ws + WS_GS);
      for (int i = vb * NT + tid; i < 2 * 2 * NMOD * D; i += nvb * NT) {
          const int k = i % D, b = (i / D) % NMOD, wh = (i / (D * NMOD)) & 1, l = i / (D * NMOD * 2);
          const float g = (wh ? P.norm2_g : P.norm1_g)[l * D + k];
          GS[i] = g * (1.f + MOD[((size_t)l * NMOD + b) * 6 * D + (wh ? 4 : 1) * D + k]);
      } }
    constexpr int NB1 = NP / 64, NB2 = FF / 64;
    for (int it = vb; it < 2 * (NB1 + NB2); it += nvb) {
        const int l = it / (NB1 + NB2), r = it % (NB1 + NB2);
        if (r < NB1) {
            auto vf = [&](int b, int k) { return MOD[((size_t)l * NMOD + b) * 6 * D + 0 * D + k]; };
            gemv_item(lds, vf, P.w_in + (size_t)l * D * NPROJ, NPROJ, ColWin(), r * 64, nullptr, (float*)(P.ws + WS_SHW1) + (size_t)l * NMOD * NP, NP);
        } else {
            auto vf = [&](int b, int k) { return MOD[((size_t)l * NMOD + b) * 6 * D + 3 * D + k]; };
            gemv_item(lds, vf, P.w_ff1 + (size_t)l * D * FF, FF, ColId(), (r - NB1) * 64, nullptr, (float*)(P.ws + WS_SHW2) + (size_t)l * NMOD * FF, FF);
        }
    }
    bf16_t* A = (bf16_t*)(P.ws + T_A); float* ss = (float*)(P.ws + WS_SUMSQ);
    for (int row0 = 2 * (vb * NWAVE + wave); row0 < ROWS; row0 += 2 * nvb * NWAVE) {
        f32x4 v[2][4]; const float* scp[2];
#pragma unroll
        for (int u = 0; u < 2; ++u) { const int row = row0 + u; const int b9 = mod_of_row(row);
            const float* xr = row < RL ? P.x + (size_t)row * D : P.ctx + (size_t)(row - RL) * D;
            scp[u] = MOD + (size_t)b9 * 6 * D + 1 * D;
#pragma unroll
            for (int j = 0; j < 4; ++j) v[u][j] = *(const f32x4*)(xr + 4 * (64 * j + lane)); }
#pragma unroll
        for (int u = 0; u < 2; ++u) { const int row = row0 + u; float s = 0.f;
#pragma unroll
            for (int j = 0; j < 4; ++j) {
                const int col = 4 * (64 * j + lane);
                const f32x4 x = v[u][j]; const f32x4 g = *(const f32x4*)(P.norm1_g + col); const f32x4 c = *(const f32x4*)(scp[u] + col);
                s += (x[0] * x[0] + x[1] * x[1]) + (x[2] * x[2] + x[3] * x[3]);
                u32x2 o; o.x = pk2(x[0] * g[0] * (1.f + c[0]), x[1] * g[1] * (1.f + c[1])); o.y = pk2(x[2] * g[2] * (1.f + c[2]), x[3] * g[3] * (1.f + c[3]));
                *(u32x2*)(A + (size_t)row * D + col) = o;
            }
            s = wave_sum(s);
            if (lane == 0) ss[row] = s; }
    }
}

namespace pg8 {
constexpr int BM = 256, BK = 64, HALF = 128, HTB = HALF * BK * 2, STAGE_BYTES = 8 * HTB, NXCD = 8, WGM = 8;
DEV int lds_byte(int r, int c) { const int st = (r >> 4) * 2 + (c >> 5), rr = r & 15, cc = c & 31, ob = rr * 64 + cc * 2; return st * 1024 + (ob ^ (((ob >> 9) & 1) << 5)); }
DEV void stage_rc(int b, int& R, int& C) { const int st = b / 1024, sb = b % 1024, swz = sb ^ (((sb >> 9) & 1) << 5); R = (st >> 1) * 16 + swz / 64; C = (st & 1) * 32 + (swz % 64) / 2; }
DEV int perm32(int rho) { const int n = rho >> 4, i = rho & 15; return 8 * (i >> 2) + 4 * n + (i & 3); }
struct Unit { int pm, pn; };
struct Gemm { const bf16_t* A; const bf16_t* Bt; int M, N, K; };
struct StaticOrder {
    int nM, nN, nwg, G, c;
    MDEV void init(int M, int N, int G_, int c_) { nM = M / BM; nN = N / BM; nwg = nM * nN; G = G_; c = c_; }
    MDEV void tile_of(long L, Unit& u) const {
        int wgid = (int)L; { const int q = nwg / NXCD, r = nwg % NXCD, xcd = wgid % NXCD, off = wgid / NXCD; wgid = (xcd < r ? xcd * (q + 1) : r * (q + 1) + (xcd - r) * q) + off; }
        const int nig = WGM * nN, gid = wgid / nig, fm = gid * WGM, gsz = (nM - fm) < WGM ? (nM - fm) : WGM;
        u.pm = fm + ((wgid % nig) % gsz); u.pn = (wgid % nig) / gsz;
    }
    MDEV bool next(int i, Unit& u) const { const long L = (long)i * G + c; if (L >= nwg) return false; tile_of(L, u); return true; }
};
struct SegOrder {
    StaticOrder so; int pm0, l0, lstride, lcount;
    MDEV void init(int pm0_, int npm, int N, int l0_, int lstride_, int lcount_) { so.init(npm * BM, N, 1, 0); pm0 = pm0_; l0 = l0_; lstride = lstride_; lcount = lcount_; }
    MDEV bool next(int i, Unit& u) const { if (i >= lcount) return false; const long L = (long)l0 + (long)i * lstride; if (L >= so.nwg) return false; so.tile_of(L, u); u.pm += pm0; return true; }
};
#ifndef EMU
DEV unsigned cvt_pk_bf16(float lo, float hi) { return pk2(lo, hi); }
DEV void glds16(const void* g, LAS unsigned char* l) { __builtin_amdgcn_global_load_lds((const unsigned*)g, (LAS unsigned*)l, 16, 0, 0); }
#define PG8_WAIT_V(n) asm volatile("s_waitcnt vmcnt(" #n ")" ::: "memory")
#define PG8_WAIT_L(n) asm volatile("s_waitcnt lgkmcnt(" #n ")" ::: "memory")
#define PG8_BAR __builtin_amdgcn_s_barrier()
#define PG8_SCHED __builtin_amdgcn_sched_barrier(0)
#define PG8_PRIO(x) __builtin_amdgcn_s_setprio(x)
#else
DEV unsigned cvt_pk_bf16(float lo, float hi) { return pk2(lo, hi); }
DEV void glds16(const void* g, unsigned char* l) { memcpy(l + (threadIdx.x & 63) * 16, g, 16); }
#define PG8_WAIT_V(n)
#define PG8_WAIT_L(n)
#define PG8_BAR emu_syncthreads()
#define PG8_SCHED
#define PG8_PRIO(x)
#endif

template <class Epi, class Sched>
DEV void gemm_phase(LAS unsigned char* lds, const Gemm g, const Sched& S, const Epi& E) {
    const int tid = tidx(), wid = uniform_i(tid >> 6), lane = tid & 63, wr = wid >> 2, wc = wid & 3, fr = lane & 15, fq = lane >> 4;
    const int K = g.K, nt = K / BK;
    unsigned voffA[2], voffB[2];
#pragma unroll
    for (int i = 0; i < 2; ++i) { int R, C; stage_rc(tid * 16 + i * 8192, R, C); const int Rb = Epi::PERM ? ((R & ~31) + perm32(R & 31)) : R;
        voffA[i] = (unsigned)(R * K + C) * 2u; voffB[i] = (unsigned)(Rb * K + C) * 2u; }
    const size_t kstep = (size_t)(BK * 2);
    const size_t hstep = (size_t)HALF * K * 2;
    const size_t tstep = 2 * hstep;
    const unsigned ldsw = (unsigned)wid * 1024u;
    const int aoff = lds_byte(wr * 64 + fr, fq * 8), boff = lds_byte(wc * 32 + fr, fq * 8);
#define PG8_SA(b, h) (((b) * 2 + (h)) * HTB)
#define PG8_SB(b, h) ((4 + (b) * 2 + (h)) * HTB)
#define PG8_STAGE(bufoff, gbase, voff) do { _Pragma("unroll") for (int _i = 0; _i < 2; ++_i) \
        glds16((const char*)(gbase) + (voff)[_i], lds + (bufoff) + ldsw + _i * 8192); } while (0)
#define PG8_LDA(dst, b, h) do { _Pragma("unroll") for (int m = 0; m < 4; ++m) _Pragma("unroll") for (int k = 0; k < 2; ++k) dst[m][k] = *(const LAS bf16x8*)(lds + PG8_SA(b, h) + aoff + m * 2048 + k * 1024); } while (0)
#define PG8_LDB(dst, b, h) do { _Pragma("unroll") for (int n = 0; n < 2; ++n) _Pragma("unroll") for (int k = 0; k < 2; ++k) dst[n][k] = *(const LAS bf16x8*)(lds + PG8_SB(b, h) + boff + n * 2048 + k * 1024); } while (0)
#define PG8_MMA(ai, bj, At, Bt) do { PG8_PRIO(1); _Pragma("unroll") for (int m = 0; m < 4; ++m) _Pragma("unroll") for (int n = 0; n < 2; ++n) _Pragma("unroll") for (int k = 0; k < 2; ++k) \
        acc[ai][bj][m][n] = mfma16(Bt[n][k], At[m][k], acc[ai][bj][m][n]); PG8_PRIO(0); } while (0)
    Unit cur, nxt; int ui = 0;
    if (!S.next(0, cur)) return;
    f32x4 acc[2][2][4][2];
#pragma unroll
    for (int a = 0; a < 2; ++a)
#pragma unroll
        for (int b = 0; b < 2; ++b)
#pragma unroll
            for (int m = 0; m < 4; ++m)
#pragma unroll
                for (int n = 0; n < 2; ++n) acc[a][b][m][n] = (f32x4){0.f, 0.f, 0.f, 0.f};
    bf16x8 At[4][2], B0[2][2], B1[2][2];
    const char* cA = (const char*)g.A + (size_t)cur.pm * tstep; const char* cB = (const char*)g.Bt + (size_t)cur.pn * tstep;
    PG8_STAGE(PG8_SB(0, 0), cB, voffB); PG8_STAGE(PG8_SB(0, 1), cB + hstep, voffB); PG8_STAGE(PG8_SA(0, 0), cA, voffA); PG8_STAGE(PG8_SA(0, 1), cA + hstep, voffA);
    if (wr == 1) PG8_BAR;
    PG8_WAIT_V(2); PG8_BAR;
    PG8_STAGE(PG8_SB(1, 0), cB + kstep, voffB); PG8_STAGE(PG8_SA(1, 0), cA + kstep, voffA); PG8_STAGE(PG8_SB(1, 1), cB + hstep + kstep, voffB);
    PG8_WAIT_V(6); PG8_BAR;
    for (;;) {
        const bool has_next = S.next(ui + 1, nxt);
        const char* nA = has_next ? (const char*)g.A + (size_t)nxt.pm * tstep : cA; const char* nB = has_next ? (const char*)g.Bt + (size_t)nxt.pn * tstep : cB;
        for (int t = 0; t < nt; t += 2) {
            const bool last = (t == nt - 2);
            const char* a1 = cA + (size_t)(t + 1) * kstep;
            const char* a2 = last ? nA : cA + (size_t)(t + 2) * kstep; const char* b2 = last ? nB : cB + (size_t)(t + 2) * kstep;
            const char* a3 = a2 + kstep; const char* b3 = b2 + kstep;
            PG8_LDB(B0, 0, 0); PG8_LDB(B1, 0, 1); PG8_SCHED; PG8_LDA(At, 0, 0); PG8_STAGE(PG8_SA(1, 1), a1 + hstep, voffA);
            PG8_WAIT_V(8); PG8_WAIT_L(0); PG8_BAR; PG8_MMA(0, 0, At, B0); PG8_MMA(0, 1, At, B1); PG8_BAR; PG8_SCHED;
            PG8_LDA(At, 0, 1); PG8_STAGE(PG8_SB(0, 0), b2, voffB); PG8_STAGE(PG8_SB(0, 1), b2 + hstep, voffB); PG8_STAGE(PG8_SA(0, 0), a2, voffA);
            PG8_WAIT_V(8); PG8_WAIT_L(0); PG8_BAR; PG8_MMA(1, 0, At, B0); PG8_MMA(1, 1, At, B1); PG8_BAR; PG8_SCHED;
            PG8_LDB(B0, 1, 0); PG8_LDB(B1, 1, 1); PG8_SCHED; PG8_LDA(At, 1, 0); PG8_STAGE(PG8_SA(0, 1), a2 + hstep, voffA);
            PG8_WAIT_V(8); PG8_WAIT_L(0); PG8_BAR; PG8_MMA(0, 0, At, B0); PG8_MMA(0, 1, At, B1); PG8_BAR; PG8_SCHED;
            PG8_LDA(At, 1, 1); PG8_STAGE(PG8_SB(1, 0), b3, voffB); PG8_STAGE(PG8_SB(1, 1), b3 + hstep, voffB); PG8_STAGE(PG8_SA(1, 0), a3, voffA);
            PG8_WAIT_V(8); PG8_WAIT_L(0); PG8_BAR; PG8_MMA(1, 0, At, B0); PG8_MMA(1, 1, At, B1); PG8_BAR; PG8_SCHED;
        }
        if (wr == 0) PG8_BAR;
        E(acc, cur, wr, wc, fr, fq);
        if (!has_next) break;
#pragma unroll
        for (int a = 0; a < 2; ++a)
#pragma unroll
            for (int b = 0; b < 2; ++b)
#pragma unroll
                for (int m = 0; m < 4; ++m)
#pragma unroll
                    for (int n = 0; n < 2; ++n) acc[a][b][m][n] = (f32x4){0.f, 0.f, 0.f, 0.f};
        cur = nxt; cA = nA; cB = nB; ++ui;
        if (wr == 1) PG8_BAR;
    }
    PG8_WAIT_V(0);
    PG8_BAR;
#undef PG8_SA
#undef PG8_SB
#undef PG8_STAGE
#undef PG8_LDA
#undef PG8_LDB
#undef PG8_MMA
}

struct EpiIn {
    static constexpr bool PERM = true;
    const float* sumsq; const float* shw; unsigned char* ws;
    MDEV void operator()(const f32x4 (&acc)[2][2][4][2], const Unit& u, int wr, int wc, int fr, int fq) const {
        const int pn = u.pn;
        bf16_t* base; int ld, cofs;
        if (pn < 2) { base = (bf16_t*)(ws + T_PGLAQK); ld = 512; cofs = pn * 256; }
        else if (pn < 4) { base = (bf16_t*)(ws + T_PGLAV); ld = 512; cofs = (pn - 2) * 256; }
        else if (pn < 6) { base = (bf16_t*)(ws + T_PG); ld = 1024; cofs = (pn - 4) * 256; }
        else if (pn < 12) { base = (bf16_t*)(ws + T_PGDN); ld = 1536; cofs = (pn - 6) * 256; }
        else if (pn < 14) { base = (bf16_t*)(ws + T_PG); ld = 1024; cofs = 512 + (pn - 12) * 256; }
        else { base = nullptr; ld = 0; cofs = 0; }
        const int lc = wc * 32 + 8 * fq;
        const int r0 = u.pm * BM + wr * 64 + fr;
        const int b9t = mod_of_row(u.pm * BM); const bool uni = b9t == mod_of_row(u.pm * BM + BM - 1);
        float ssv[2][4];
#pragma unroll
        for (int ai = 0; ai < 2; ++ai)
#pragma unroll
            for (int m = 0; m < 4; ++m) ssv[ai][m] = sumsq[r0 + ai * HALF + m * 16];
        f32x4 bv[2][2];
        { const float* sh = shw + (size_t)b9t * NP + pn * BM + lc;
#pragma unroll
          for (int bj = 0; bj < 2; ++bj) { bv[bj][0] = *(const f32x4*)(sh + bj * HALF); bv[bj][1] = *(const f32x4*)(sh + bj * HALF + 4); } }
#pragma unroll
        for (int ai = 0; ai < 2; ++ai)
#pragma unroll
            for (int m = 0; m < 4; ++m) {
                const int row = r0 + ai * HALF + m * 16;
                const float rstd = frsq(ssv[ai][m] * (1.0f / D) + EPSN);
                if (!uni) { const float* sh = shw + (size_t)mod_of_row(row) * NP + pn * BM + lc;
#pragma unroll
                    for (int bj = 0; bj < 2; ++bj) { bv[bj][0] = *(const f32x4*)(sh + bj * HALF); bv[bj][1] = *(const f32x4*)(sh + bj * HALF + 4); } }
                if (base) {
#pragma unroll
                    for (int bj = 0; bj < 2; ++bj) {
                        const f32x4 v0 = acc[ai][bj][m][0] * rstd + bv[bj][0], v1 = acc[ai][bj][m][1] * rstd + bv[bj][1];
                        u32x4 w; w.x = cvt_pk_bf16(v0[0], v0[1]); w.y = cvt_pk_bf16(v0[2], v0[3]); w.z = cvt_pk_bf16(v1[0], v1[1]); w.w = cvt_pk_bf16(v1[2], v1[3]);
                        *(u32x4*)(base + (size_t)row * ld + cofs + lc + bj * HALF) = w;
                    }
                } else if (wc == 0) {
                    float* gp = (float*)(ws + WS_GATE) + (size_t)row * 32 + lc;
                    *(f32x4*)gp = acc[ai][0][m][0] * rstd + bv[0][0]; *(f32x4*)(gp + 4) = acc[ai][0][m][1] * rstd + bv[0][1];
                }
            }
    }
};
struct EpiFF1 {
    static constexpr bool PERM = true;
    const float* sumsq; const float* shw; bf16_t* hid;
    MDEV void operator()(const f32x4 (&acc)[2][2][4][2], const Unit& u, int wr, int wc, int fr, int fq) const {
        const int c0 = u.pn * BM + wc * 32 + 8 * fq;
        const int r0 = u.pm * BM + wr * 64 + fr;
        const int b9t = mod_of_row(u.pm * BM); const bool uni = b9t == mod_of_row(u.pm * BM + BM - 1);
        float ssv[2][4];
#pragma unroll
        for (int ai = 0; ai < 2; ++ai)
#pragma unroll
            for (int m = 0; m < 4; ++m) ssv[ai][m] = sumsq[r0 + ai * HALF + m * 16];
        f32x4 bv[2][2];
        { const float* sh = shw + (size_t)b9t * FF + c0;
#pragma unroll
          for (int bj = 0; bj < 2; ++bj) { bv[bj][0] = *(const f32x4*)(sh + bj * HALF); bv[bj][1] = *(const f32x4*)(sh + bj * HALF + 4); } }
#pragma unroll
        for (int ai = 0; ai < 2; ++ai)
#pragma unroll
            for (int m = 0; m < 4; ++m) {
                const int row = r0 + ai * HALF + m * 16;
                const float rstd = frsq(ssv[ai][m] * (1.0f / D) + EPSN);
                if (!uni) { const float* sh = shw + (size_t)mod_of_row(row) * FF + c0;
#pragma unroll
                    for (int bj = 0; bj < 2; ++bj) { bv[bj][0] = *(const f32x4*)(sh + bj * HALF); bv[bj][1] = *(const f32x4*)(sh + bj * HALF + 4); } }
#pragma unroll
                for (int bj = 0; bj < 2; ++bj) {
                    f32x4 v0 = acc[ai][bj][m][0] * rstd + bv[bj][0], v1 = acc[ai][bj][m][1] * rstd + bv[bj][1];
#pragma unroll
                    for (int e = 0; e < 4; ++e) { const float a = fmaxf(v0[e], 0.f), b = fmaxf(v1[e], 0.f); v0[e] = a * a; v1[e] = b * b; }
                    u32x4 w; w.x = cvt_pk_bf16(v0[0], v0[1]); w.y = cvt_pk_bf16(v0[2], v0[3]); w.z = cvt_pk_bf16(v1[0], v1[1]); w.w = cvt_pk_bf16(v1[2], v1[3]);
                    *(u32x4*)(hid + (size_t)row * FF + c0 + bj * HALF) = w;
                }
            }
    }
};
struct EpiRes {
    static constexpr bool PERM = false;
    const float* res_lat; const float* res_ctx;
    float* out_lat; float* out_ctx;
    const float* gt;
    const float* gsn;
    bf16_t* anext; float* ssn;
    MDEV void operator()(const f32x4 (&acc)[2][2][4][2], const Unit& u, int wr, int wc, int fr, int fq) const {
        const int c0 = u.pn * BM + wc * 32 + 4 * fq;
        float part[2][4];
        const int b9t = mod_of_row(u.pm * BM); const bool uni = b9t == mod_of_row(u.pm * BM + BM - 1);
        f32x4 gtv[2][2], gsv[2][2];
#pragma unroll
        for (int bj = 0; bj < 2; ++bj)
#pragma unroll
            for (int n = 0; n < 2; ++n) { const int col = c0 + bj * HALF + n * 16;
                gtv[bj][n] = *(const f32x4*)(gt + (size_t)b9t * 6 * D + col); gsv[bj][n] = gsn ? *(const f32x4*)(gsn + (size_t)b9t * D + col) : (f32x4){0.f, 0.f, 0.f, 0.f}; }
#pragma unroll
        for (int aim = 0; aim < 4; ++aim) {
            const int ai = aim >> 1;
            f32x4 rv[2][2][2];
#pragma unroll
            for (int m2 = 0; m2 < 2; ++m2) { const int m = 2 * (aim & 1) + m2; const int row = u.pm * BM + ai * HALF + wr * 64 + m * 16 + fr;
                const float* rp = row < RL ? res_lat + (size_t)row * D : res_ctx + (size_t)(row - RL) * D;
#pragma unroll
                for (int bj = 0; bj < 2; ++bj)
#pragma unroll
                    for (int n = 0; n < 2; ++n) rv[m2][bj][n] = *(const f32x4*)(rp + c0 + bj * HALF + n * 16); }
#pragma unroll
            for (int m2 = 0; m2 < 2; ++m2) {
                const int m = 2 * (aim & 1) + m2;
                const int row = u.pm * BM + ai * HALF + wr * 64 + m * 16 + fr;
                float* op = row < RL ? out_lat + (size_t)row * D : out_ctx + (size_t)(row - RL) * D;
                if (!uni) { const int b9 = mod_of_row(row);
#pragma unroll
                    for (int bj = 0; bj < 2; ++bj)
#pragma unroll
                        for (int n = 0; n < 2; ++n) { const int col = c0 + bj * HALF + n * 16;
                            gtv[bj][n] = *(const f32x4*)(gt + (size_t)b9 * 6 * D + col); if (gsn) gsv[bj][n] = *(const f32x4*)(gsn + (size_t)b9 * D + col); } }
                float s = 0.f;
#pragma unroll
                for (int bj = 0; bj < 2; ++bj)
#pragma unroll
                    for (int n = 0; n < 2; ++n) {
                        const int col = c0 + bj * HALF + n * 16;
                        const f32x4 xn = rv[m2][bj][n] + gtv[bj][n] * acc[ai][bj][m][n];
                        *(f32x4*)(op + col) = xn;
                        s += (xn[0] * xn[0] + xn[1] * xn[1]) + (xn[2] * xn[2] + xn[3] * xn[3]);
                        if (gsn) { const f32x4 gs = gsv[bj][n]; u32x2 w; w.x = cvt_pk_bf16(xn[0] * gs[0], xn[1] * gs[1]); w.y = cvt_pk_bf16(xn[2] * gs[2], xn[3] * gs[3]);
                            *(u32x2*)(anext + (size_t)row * D + col) = w; }
                    }
                part[ai][m] = s;
            }
        }
        if (ssn) {
#pragma unroll
            for (int ai = 0; ai < 2; ++ai) {
                float v[4];
#pragma unroll
                for (int m = 0; m < 4; ++m) { float s = part[ai][m]; s += wshfl_xor(s, 16); s += wshfl_xor(s, 32); v[m] = s; }
                const float mine = fq == 0 ? v[0] : fq == 1 ? v[1] : fq == 2 ? v[2] : v[3];
                atomic_addf(ssn + u.pm * BM + ai * HALF + wr * 64 + fq * 16 + fr, mine);
            }
        }
    }
};
}

DEV int swz256(int row, int chunk16) { return row * 256 + (((chunk16) ^ (row & 15)) << 4); }
DEV bf16_t* gdn_qkvn_row(unsigned char* ws, int row) {
    return row < RL ? (bf16_t*)(ws + T_PGDN) + (size_t)row * 1536 : (bf16_t*)(ws + WS_QKVNC) + (size_t)(row - RL) * 1536;
}
#ifndef EMU
DEV unsigned row_ror1(unsigned v) { return (unsigned)__builtin_amdgcn_update_dpp(0, (int)v, 0x121, 0xf, 0xf, false); }
DEV unsigned row_ror15(unsigned v) { return (unsigned)__builtin_amdgcn_update_dpp(0, (int)v, 0x12f, 0xf, 0xf, false); }
#else
DEV unsigned row_ror1(unsigned v) { const int l = threadIdx.x & 63; return __builtin_bit_cast(unsigned, emu_shfl(__builtin_bit_cast(float, v), (l & ~15) | ((l - 1) & 15))); }
DEV unsigned row_ror15(unsigned v) { const int l = threadIdx.x & 63; return __builtin_bit_cast(unsigned, emu_shfl(__builtin_bit_cast(float, v), (l & ~15) | ((l + 1) & 15))); }
#endif
DEV u32x4 ror1x4(const u32x4 v) { const unsigned a = v.x, b = v.y, c = v.z, d = v.w; u32x4 r; r.x = row_ror1(a); r.y = row_ror1(b); r.z = row_ror1(c); r.w = row_ror1(d); return r; }
DEV u32x4 ror15x4(const u32x4 v) { const unsigned a = v.x, b = v.y, c = v.z, d = v.w; u32x4 r; r.x = row_ror15(a); r.y = row_ror15(b); r.z = row_ror15(c); r.w = row_ror15(d); return r; }
DEV u32x4 shfl4(const u32x4 v, int src) {
    const unsigned a = v.x, b = v.y, c = v.z, d = v.w;
    u32x4 r;
    r.x = __builtin_bit_cast(unsigned, wshfl(__builtin_bit_cast(float, a), src));
    r.y = __builtin_bit_cast(unsigned, wshfl(__builtin_bit_cast(float, b), src));
    r.z = __builtin_bit_cast(unsigned, wshfl(__builtin_bit_cast(float, c), src));
    r.w = __builtin_bit_cast(unsigned, wshfl(__builtin_bit_cast(float, d), src));
    return r;
}
DEV void gdn_conv_unit(const Params& P, const LAS float* cwl, int l, int gc, int h, int part, int lane) {
    const int fr = lane & 15, fq = lane >> 4;
    const int row0 = gc * 64; const bool is_ctx = row0 >= RL;
    const bf16_t* raw = (const bf16_t*)(P.ws + T_PGDN) + part * 512 + h * 128 + 8 * fq;
    u32x4 c0[4][4], hp[4], hn[4];
#pragma unroll
    for (int it = 0; it < 4; ++it)
#pragma unroll
        for (int s4 = 0; s4 < 4; ++s4) c0[it][s4] = *(const u32x4*)(raw + (size_t)(row0 + 16 * it + fr) * 1536 + 32 * s4);
    { bool hasp = false, hasn = false;
      if (is_ctx) { const int pos0 = (row0 - RL) % CTX; hasp = pos0 > 0; hasn = pos0 + 64 < CTX; }
      const unsigned mp = hasp ? 0xffffffffu : 0u, mn = hasn ? 0xffffffffu : 0u;
      const bf16_t* rp = raw + (size_t)(hasp ? row0 - 1 : row0) * 1536; const bf16_t* rn = raw + (size_t)(hasn ? row0 + 64 : row0) * 1536;
#pragma unroll
      for (int s4 = 0; s4 < 4; ++s4) { hp[s4] = *(const u32x4*)(rp + 32 * s4) & mp; hn[s4] = *(const u32x4*)(rn + 32 * s4) & mn; } }
    const LAS float* cwp = cwl + part * 512 + h * 128 + 8 * fq;
#pragma unroll
    for (int it = 0; it < 4; ++it) {
        float y[4][8]; float ssq = 0.f;
#pragma unroll
        for (int s4 = 0; s4 < 4; ++s4) {
            const u32x4 up = ror1x4(c0[it][s4]), dn = ror15x4(c0[it][s4]);
            u32x4 upb, dnb;
            if (it > 0) upb = ror1x4(c0[it > 0 ? it - 1 : 0][s4]); else upb = hp[s4];
            if (it < 3) dnb = ror15x4(c0[it < 3 ? it + 1 : 3][s4]); else dnb = hn[s4];
            const u32x4 cm = fr > 0 ? up : upb, cp = fr < 15 ? dn : dnb, cc = c0[it][s4];
            const LAS float* cw = cwp + 32 * s4;
            f32x4 w0[2], w1[2], w2[2];
#pragma unroll
            for (int e = 0; e < 2; ++e) { w0[e] = *(const LAS f32x4*)(cw + 4 * e); w1[e] = *(const LAS f32x4*)(cw + 1536 + 4 * e); w2[e] = *(const LAS f32x4*)(cw + 3072 + 4 * e); }
#pragma unroll
            for (int j = 0; j < 4; ++j) {
                const int e = j >> 1, o = (j & 1) * 2;
                const float a = w0[e][o] * bflo(cm[j]) + w1[e][o] * bflo(cc[j]) + w2[e][o] * bflo(cp[j]);
                const float b = w0[e][o + 1] * bfhi(cm[j]) + w1[e][o + 1] * bfhi(cc[j]) + w2[e][o + 1] * bfhi(cp[j]);
                const float sa = silu_f(a), sb = silu_f(b);
                y[s4][2 * j] = sa; y[s4][2 * j + 1] = sb; ssq += sa * sa + sb * sb;
            }
        }
        float scale = 1.f;
        if (part < 2) { ssq += wshfl_xor(ssq, 16); ssq += wshfl_xor(ssq, 32); scale = 1.0f / sqrtf(ssq + EPSN); if (part == 0) scale *= 0.08838834764831845f; }
        bf16_t* orow = gdn_qkvn_row(P.ws, row0 + 16 * it + fr) + part * 512 + h * 128 + 8 * fq;
#pragma unroll
        for (int s4 = 0; s4 < 4; ++s4) { u32x4 w;
#pragma unroll
            for (int j = 0; j < 4; ++j) w[j] = pk2(y[s4][2 * j] * scale, y[s4][2 * j + 1] * scale);
            *(u32x4*)(orow + 32 * s4) = w; }
        SCHED_FENCE();
    }
}
DEV void gdn_mat_unit(const Params& P, LAS unsigned char* slot, LAS float* gb, int l, int gc, int h, int dir, int lane) {
    const int fr = lane & 15, fq = lane >> 4;
    const int row0 = gc * 64;
    unsigned char* item = P.ws + T_TAQK + (size_t)((gc * 4 + h) * 2 + dir) * TAQK_ITEM;
    bf16x8 Qf[4][4], Kf[4][4];
    { const bf16_t* qn0 = gdn_qkvn_row(P.ws, row0 + fr) + h * 128 + 8 * fq;
#pragma unroll
      for (int it = 0; it < 4; ++it)
#pragma unroll
        for (int s4 = 0; s4 < 4; ++s4) { Qf[it][s4] = *(const bf16x8*)(qn0 + (size_t)it * 16 * 1536 + 32 * s4); Kf[it][s4] = *(const bf16x8*)(qn0 + 512 + (size_t)it * 16 * 1536 + 32 * s4); } }
    { const int tok = dir ? 63 - lane : lane;
      const float* gr = (const float*)(P.ws + WS_GATE) + (size_t)(row0 + tok) * 32;
      const float av = gr[16 + dir * 4 + h], bbv = gr[24 + dir * 4 + h];
      const float la = -fexp(P.gdn_a_log[(l * 2 + dir) * 4 + h]) * softplus_f(av + P.gdn_dt_bias[(l * 2 + dir) * 4 + h]);
      const float beta = sigmoid_f(bbv);
      float g = la;
#pragma unroll
      for (int o = 1; o < 64; o <<= 1) { const float t = wshfl_up(g, o); if (lane >= o) g += t; }
      const float gl = wshfl(g, 63);
      gb[tok] = g; gb[64 + tok] = beta;
      float* sc = (float*)(item + 16384);
      sc[tok] = fexp(g); sc[64 + tok] = fexp(gl - g); sc[128 + tok] = beta; sc[192 + tok] = fexp(gl); }
    wave_sync();
    float gi[4][4], bi[4][4], gjv[4];
#pragma unroll
    for (int it = 0; it < 4; ++it) { const f32x4 gv = *(const LAS f32x4*)(gb + 16 * it + 4 * fq), bv = *(const LAS f32x4*)(gb + 64 + 16 * it + 4 * fq);
#pragma unroll
        for (int r = 0; r < 4; ++r) { gi[it][r] = gv[r]; bi[it][r] = bv[r]; } }
#pragma unroll
    for (int jt = 0; jt < 4; ++jt) gjv[jt] = gb[16 * jt + fr];
#pragma unroll
    for (int it = 0; it < 4; ++it)
#pragma unroll
        for (int jt = 0; jt < 4; ++jt) {
            f32x4 c = {0.f, 0.f, 0.f, 0.f};
            if (dir ? jt >= it : jt <= it) {
#pragma unroll
            for (int s4 = 0; s4 < 4; ++s4) c = mfma16(Qf[it][s4], Kf[jt][s4], c);
            }
            const int j = 16 * jt + fr; const float gj = gjv[jt];
#pragma unroll
            for (int r = 0; r < 4; ++r) { const int i = 16 * it + 4 * fq + r; const bool keep = dir ? j >= i : j <= i;
                const float v = c[r] * fexp(fminf(gi[it][r] - gj, 0.f)) * (keep ? 1.f : 0.f);
                *(LAS bf16_t*)(slot + (i * 64 + j) * 2) = (bf16_t)f2bf(v); }
        }
    wave_sync();
#pragma unroll 1
    for (int q = 0; q < 8; ++q) { const int off = (lane + 64 * q) * 16; *(u32x4*)(item + 8192 + off) = *(const LAS u32x4*)(slot + off); }
    wave_sync();
    LAS float* W = (LAS float*)slot;
#pragma unroll
    for (int it = 0; it < 4; ++it)
#pragma unroll
        for (int jt = 0; jt < 4; ++jt) {
            f32x4 c = {0.f, 0.f, 0.f, 0.f};
            if (dir ? jt >= it : jt <= it) {
#pragma unroll
            for (int s4 = 0; s4 < 4; ++s4) c = mfma16(Kf[it][s4], Kf[jt][s4], c);
            }
            const int j = 16 * jt + fr, jp = dir ? 63 - j : j; const float gj = gjv[jt];
#pragma unroll
            for (int r = 0; r < 4; ++r) { const int i = 16 * it + 4 * fq + r, ip = dir ? 63 - i : i;
                W[jp * 64 + ip] = bi[it][r] * c[r] * fexp(fminf(gi[it][r] - gj, 0.f)) * (jp < ip ? 1.f : 0.f); }
        }
    wave_sync();
    const int nj = dir ? 63 - lane : lane;
#pragma unroll 1
    for (int bk = 0; bk < 8; ++bk) {
        float sacc[8];
#pragma unroll
        for (int e = 0; e < 8; ++e) sacc[e] = (8 * bk + e == lane) ? 1.f : 0.f;
#pragma unroll 8
        for (int m = 0; m < 8 * bk; ++m) {
            const float xm = lane <= m ? W[m * 64 + lane] : 0.f;
            const f32x4 l0 = *(const LAS f32x4*)(W + m * 64 + 8 * bk), l1 = *(const LAS f32x4*)(W + m * 64 + 8 * bk + 4);
#pragma unroll
            for (int e = 0; e < 4; ++e) { sacc[e] -= l0[e] * xm; sacc[4 + e] -= l1[e] * xm; }
        }
        float xb[8];
#pragma unroll
        for (int e = 0; e < 8; ++e) {
            float v = sacc[e];
#pragma unroll
            for (int m = 0; m < e; ++m) v -= W[(8 * bk + m) * 64 + 8 * bk + e] * xb[m];
            xb[e] = v;
        }
#pragma unroll
        for (int e = 0; e < 8; ++e) if (lane <= 8 * bk + e) W[(8 * bk + e) * 64 + lane] = xb[e];
    }
    float x[64];
#pragma unroll
    for (int i = 0; i < 64; ++i) x[i] = lane <= i ? W[i * 64 + lane] : 0.f;
    wave_sync();
#pragma unroll
    for (int i = 0; i < 64; ++i) { const int ni = dir ? 63 - i : i; *(LAS bf16_t*)(slot + (ni * 64 + nj) * 2) = (bf16_t)f2bf(x[i]); }
    wave_sync();
#pragma unroll 1
    for (int q = 0; q < 8; ++q) { const int off = (lane + 64 * q) * 16; *(u32x4*)(item + off) = *(const LAS u32x4*)(slot + off); }
    wave_sync();
}
constexpr int PREP_CW = 0, PREP_SLOT0 = 18432, PREP_SLOT_STRIDE = 17408;
constexpr size_t CTL_QUEUE_OFS = 20480;
DEV int queue_pull(const Params& P, int inst, int vb, int first, int total, int lane) {
    unsigned* head = (unsigned*)(P.ws + WS_CTL + CTL_QUEUE_OFS + (size_t)(inst * 8 + (vb & 7)) * 256);
    unsigned k = 0;
#ifndef EMU
    if (lane == 0) k = __hip_atomic_fetch_add(head, 1u, __ATOMIC_RELAXED, __HIP_MEMORY_SCOPE_AGENT);
    k = (unsigned)__builtin_amdgcn_readfirstlane((int)k);
#else
    if (lane == 0) k = __atomic_fetch_add(head, 1u, __ATOMIC_SEQ_CST);
    k = __builtin_bit_cast(unsigned, wshfl(__builtin_bit_cast(float, k), 0));
#endif
    const long u = (long)first + (vb & 7) + 8l * k;
    return u < total ? (int)u : -1;
}
DEV void phase_prep_a(const Params& P, LAS unsigned char* lds, int l, int vb, int nvb) {
    const int tid = tidx(), wave = uniform_i(tid >> 6), lane = tid & 63;
    LAS float* cwl = (LAS float*)(lds + PREP_CW);
    { float tmp[9];
#pragma unroll
      for (int u = 0; u < 9; ++u) tmp[u] = P.gdn_conv_w[(size_t)l * 3 * 1536 + tid + u * NT];
#pragma unroll
      for (int u = 0; u < 9; ++u) cwl[tid + u * NT] = tmp[u]; }
    block_sync();
#pragma unroll 1
    for (int it = vb * NWAVE + wave; it >= 0 && it < NCH * 12; it = queue_pull(P, 2 * l, vb, nvb * NWAVE, NCH * 12, lane)) { const int part = it % 3, gh = it / 3; gdn_conv_unit(P, cwl, l, gh >> 2, gh & 3, part, opaque_i(lane)); }
    block_sync();
    if (l == 1) convert_weights(P, lds, vb, nvb, 1);
}
DEV void phase_prep_b(const Params& P, LAS unsigned char* lds, int l, int vb, int nvb) {
    const int tid = tidx(), wave = uniform_i(tid >> 6), lane = tid & 63;
    LAS unsigned char* slot = lds + wave * PREP_SLOT_STRIDE;
#pragma unroll 1
    for (int it = vb * NWAVE + wave; it >= 0 && it < NCH * 8; it = queue_pull(P, 2 * l + 1, vb, nvb * NWAVE, NCH * 8, lane)) gdn_mat_unit(P, slot, (LAS float*)(slot + 16384), l, it >> 3, (it >> 1) & 3, it & 1, opaque_i(lane));
    block_sync();
}

DEV int swz128(int row, int chunk16) { return row * 128 + (((chunk16) ^ ((row >> 1) & 7)) << 4); }
DEV bf16x8 pack_bf8(const f32x4& a, const f32x4& b) {
    u32x4 w; w.x = pk2(a[0], a[1]); w.y = pk2(a[2], a[3]); w.z = pk2(b[0], b[1]); w.w = pk2(b[2], b[3]); return __builtin_bit_cast(bf16x8, w);
}
DEV bf16x8 join_s4(const s16x4& a, const s16x4& b) { return (bf16x8){a[0], a[1], a[2], a[3], b[0], b[1], b[2], b[3]}; }
DEV bf16x8 afrag_pi256(const LAS unsigned char* tile, int row, int s, int fq) {
    const u32x2 lo = *(const LAS u32x2*)(tile + swz256(row, 4 * s + (fq >> 1)) + (fq & 1) * 8);
    const u32x2 hi = *(const LAS u32x2*)(tile + swz256(row, 4 * s + 2 + (fq >> 1)) + (fq & 1) * 8);
    return __builtin_bit_cast(bf16x8, (u32x4){lo.x, lo.y, hi.x, hi.y});
}
DEV bf16x8 afrag_pi128(const LAS unsigned char* tile, int row, int s, int fq) {
    const u32x2 lo = *(const LAS u32x2*)(tile + swz128(row, 4 * s + (fq >> 1)) + (fq & 1) * 8);
    const u32x2 hi = *(const LAS u32x2*)(tile + swz128(row, 4 * s + 2 + (fq >> 1)) + (fq & 1) * 8);
    return __builtin_bit_cast(bf16x8, (u32x4){lo.x, lo.y, hi.x, hi.y});
}
constexpr int GDN_ITEMS = NB * 16, GLA_ITEMS = NB * 8;
constexpr int GB_K = 0, GB_Q = 16384, GB_T = 32768, GB_AQ = 40960, GB_V = 49152, GB_SC = 57344, GB_SIZE = 58368;

DEV void gdn_chunk_of_step(int b, int dir, int s, int& gc) {
    if (s < NCC) { const int c = dir ? NCC - 1 - s : s; gc = RL / 64 + b * NCC + c; }
    else { const int c2 = s - NCC; const int c = dir ? NCL - 1 - c2 : c2; gc = b * NCL + c; }
}
DEV void gdn_issue_loads(const Params& P, LAS unsigned char* buf, int lw, int lane, int gc, int h, int dir, int dvh);
DEV void gdn_issue_loads(const Params& P, LAS unsigned char* buf, int lw, int lane, int gc, int h, int dir, int dvh) {
    const int row0 = gc * 64;
    const unsigned char* item = P.ws + T_TAQK + (size_t)((gc * 4 + h) * 2 + dir) * TAQK_ITEM;
#pragma unroll
    for (int jj = 0; jj < 4; ++jj) { const int j = 4 * jj + lw, r = 4 * j + (lane >> 4), ch = (lane & 15) ^ (r & 15);
        const bf16_t* rp = gdn_qkvn_row(P.ws, row0 + r) + h * 128 + ch * 8;
        pg8::glds16(rp, buf + GB_Q + 1024 * j); pg8::glds16(rp + 512, buf + GB_K + 1024 * j); }
#pragma unroll
    for (int jj = 0; jj < 2; ++jj) { const int j = 4 * jj + lw, r = 8 * j + (lane >> 3), pos = lane & 7, ch = pos ^ ((r >> 1) & 7);
        pg8::glds16(item + (r * 64 + ch * 8) * 2, buf + GB_T + 1024 * j); pg8::glds16(item + 8192 + (r * 64 + ch * 8) * 2, buf + GB_AQ + 1024 * j);
        pg8::glds16(gdn_qkvn_row(P.ws, row0 + r) + 1024 + h * 128 + dvh * 64 + pos * 8, buf + GB_V + 1024 * j); }
    if (lw == 0) pg8::glds16(item + 16384 + lane * 16, buf + GB_SC);
}
DEV void gdn_scan_item(const Params& P, LAS unsigned char* lds, int item, bool ctx_out) {
    const int tid = tidx(), wave = uniform_i(tid >> 6), lane0 = tid & 63;
    const int b = item % NB, rest = item / NB, h = rest >> 2, dir = (rest >> 1) & 1, dvh = rest & 1;
    constexpr int NS = NCC + NCL;
    const bool loader = wave >= 4; const int lw = wave - 4;
    int gc;
    if (loader) { gdn_chunk_of_step(b, dir, 0, gc); gdn_issue_loads(P, lds, lw, lane0, gc, h, dir, dvh); }
    f32x4 S[8];
#pragma unroll
    for (int i = 0; i < 8; ++i) S[i] = (f32x4){0.f, 0.f, 0.f, 0.f};
    if (loader) VM_DRAIN();
    RAW_BAR();
    for (int s = 0; s < NS; ++s) {
        LAS unsigned char* buf = lds + (s & 1) * GB_SIZE;
        if (loader) {
            if (s + 1 < NS) { gdn_chunk_of_step(b, dir, s + 1, gc); gdn_issue_loads(P, lds + ((s + 1) & 1) * GB_SIZE, lw, opaque_i(lane0), gc, h, dir, dvh); }
        } else {
            gdn_chunk_of_step(b, dir, s, gc);
            const int row0 = gc * 64, n0 = 16 * wave;
            const int lane = opaque_i(lane0), fr = lane & 15, fq = lane >> 4;
            const LAS float* SC = (const LAS float*)(buf + GB_SC);
            bf16x8 Sb[4];
#pragma unroll
            for (int k = 0; k < 4; ++k) Sb[k] = pack_bf8(S[2 * k], S[2 * k + 1]);
            f32x4 rr[4];
            { bf16x8 Af[4][4];
#pragma unroll
              for (int mt = 0; mt < 4; ++mt)
#pragma unroll
                for (int k = 0; k < 4; ++k) Af[mt][k] = afrag_pi256(buf + GB_K, 16 * mt + fr, k, fq);
              f32x4 acc[4];
#pragma unroll
              for (int mt = 0; mt < 4; ++mt) acc[mt] = (f32x4){0.f, 0.f, 0.f, 0.f};
#pragma unroll
              for (int k = 0; k < 4; ++k)
#pragma unroll
                for (int mt = 0; mt < 4; ++mt) acc[mt] = mfma16(Af[mt][k], Sb[k], acc[mt]);
#pragma unroll
              for (int mt = 0; mt < 4; ++mt) {
                const f32x4 eg = *(const LAS f32x4*)(SC + 16 * mt + 4 * fq), be = *(const LAS f32x4*)(SC + 128 + 16 * mt + 4 * fq);
#pragma unroll
                for (int j = 0; j < 4; ++j) { const float v = bf2f(*(const LAS bf16_t*)(buf + GB_V + (16 * mt + 4 * fq + j) * 128 + (n0 + fr) * 2)); rr[mt][j] = be[j] * (v - eg[j] * acc[mt][j]); }
              } }
            SCHED_FENCE();
            bf16x8 Rb[2] = {pack_bf8(rr[0], rr[1]), pack_bf8(rr[2], rr[3])};
            f32x4 dl[4];
            { bf16x8 Tf[4][2];
#pragma unroll
              for (int it = 0; it < 4; ++it)
#pragma unroll
                for (int k = 0; k < 2; ++k) Tf[it][k] = afrag_pi128(buf + GB_T, 16 * it + fr, k, fq);
#pragma unroll
              for (int it = 0; it < 4; ++it) dl[it] = (f32x4){0.f, 0.f, 0.f, 0.f};
#pragma unroll
              for (int k = 0; k < 2; ++k)
#pragma unroll
                for (int it = 0; it < 4; ++it) dl[it] = mfma16(Tf[it][k], Rb[k], dl[it]); }
            SCHED_FENCE();
            bf16x8 Db[2] = {pack_bf8(dl[0], dl[1]), pack_bf8(dl[2], dl[3])};
            { f32x4 ds[4];
#pragma unroll
              for (int mt = 0; mt < 4; ++mt) { const f32x4 el = *(const LAS f32x4*)(SC + 64 + 16 * mt + 4 * fq); ds[mt] = dl[mt] * el; }
              bf16x8 Dp[2] = {pack_bf8(ds[0], ds[1]), pack_bf8(ds[2], ds[3])};
              const float ach = SC[192];
#pragma unroll
              for (int dkt = 0; dkt < 8; ++dkt) S[dkt] = S[dkt] * ach;
#pragma unroll
              for (int hf = 0; hf < 2; ++hf) {
                  bf16x8 Kt[4][2];
#pragma unroll
                  for (int d4 = 0; d4 < 4; ++d4)
#pragma unroll
                    for (int k = 0; k < 2; ++k) {
                        const int dkt = 4 * hf + d4;
                        const int row = 32 * k + 4 * fq + ((lane >> 2) & 3), ch = 2 * dkt + ((lane & 3) >> 1), off = (lane & 1) * 8;
                        Kt[d4][k] = join_s4(lds_tr16(buf + GB_K + swz256(row, ch) + off), lds_tr16(buf + GB_K + swz256(row + 16, ch) + off));
                    }
#pragma unroll
                  for (int k = 0; k < 2; ++k)
#pragma unroll
                    for (int d4 = 0; d4 < 4; ++d4) S[4 * hf + d4] = mfma16(Kt[d4][k], Dp[k], S[4 * hf + d4]);
                  SCHED_FENCE();
              } }
            SCHED_FENCE();
            const bool want_o = ctx_out || row0 < RL;
            if (want_o) {
                LAS unsigned char* ost = lds + 2 * GB_SIZE + wave * 2048;
                f32x4 oa[4];
                { bf16x8 Qf[4][4];
#pragma unroll
                  for (int it = 0; it < 4; ++it)
#pragma unroll
                    for (int k = 0; k < 4; ++k) Qf[it][k] = afrag_pi256(buf + GB_Q, 16 * it + fr, k, fq);
#pragma unroll
                  for (int it = 0; it < 4; ++it) oa[it] = (f32x4){0.f, 0.f, 0.f, 0.f};
#pragma unroll
                  for (int k = 0; k < 4; ++k)
#pragma unroll
                    for (int it = 0; it < 4; ++it) oa[it] = mfma16(Qf[it][k], Sb[k], oa[it]); }
                SCHED_FENCE();
                { bf16x8 Gf[4][2];
#pragma unroll
                  for (int it = 0; it < 4; ++it)
#pragma unroll
                    for (int k = 0; k < 2; ++k) Gf[it][k] = afrag_pi128(buf + GB_AQ, 16 * it + fr, k, fq);
#pragma unroll
                  for (int it = 0; it < 4; ++it) oa[it] = oa[it] * *(const LAS f32x4*)(SC + 16 * it + 4 * fq);
#pragma unroll
                  for (int k = 0; k < 2; ++k)
#pragma unroll
                    for (int it = 0; it < 4; ++it) oa[it] = mfma16(Gf[it][k], Db[k], oa[it]); }
#pragma unroll
                for (int it = 0; it < 4; ++it)
#pragma unroll
                    for (int j = 0; j < 4; ++j) *(LAS bf16_t*)(ost + (16 * it + 4 * fq + j) * 32 + fr * 2) = (bf16_t)f2bf(oa[it][j]);
                wave_sync();
                bf16_t* og = (bf16_t*)(P.ws + T_OGDN) + ((size_t)dir * ROWS + row0) * 512 + h * 128 + dvh * 64 + n0;
#pragma unroll
                for (int i = 0; i < 2; ++i) { const int c = lane + 64 * i, row = c >> 1, half = c & 1;
                    *(u32x4*)(og + (size_t)row * 512 + half * 8) = *(const LAS u32x4*)(ost + row * 32 + half * 16); }
            }
        }
        if (loader) VM_DRAIN(); else LGKM_DRAIN();
        RAW_BAR();
    }
    VM_DRAIN(); block_sync();
}

constexpr int GL_RAW = 0, GL_RA = 32768, GL_V = 40960, GL_QK = 73728, GL_P = 106496, GL_VEC = 114688, GL_OST = 116736;
struct GlaDmaOff { unsigned qk[2], v[4], ra; };
DEV void gla_dma_offsets(GlaDmaOff& o, int pw, int lane) {
#pragma unroll
    for (int jj = 0; jj < 2; ++jj) { const int j = 4 * jj + pw, r = 8 * j + (lane >> 3), ch = (lane & 7) ^ ((r >> 1) & 7); o.qk[jj] = (unsigned)(r * 512 + ch * 8) * 2u; }
#pragma unroll
    for (int jj = 0; jj < 4; ++jj) { const int j = 4 * jj + pw, r = 4 * j + (lane >> 4), ch = (lane & 15) ^ (r & 15); o.v[jj] = (unsigned)(r * 512 + ch * 8) * 2u; }
    { const int idx = pw * 64 + lane, r = idx >> 2, c4 = idx & 3; o.ra = (unsigned)(r * 32 + c4 * 4) * 4u; }
}
DEV void gla_issue_raw(const Params& P, LAS unsigned char* lds, int slot, int pw, const GlaDmaOff& o, int gc, int h) {
    const size_t row0 = (size_t)gc * 64;
    const unsigned char* qk = P.ws + T_PGLAQK + (row0 * 512 + h * 64) * 2;
    LAS unsigned char* dst = lds + GL_RAW + slot * 16384;
#pragma unroll
    for (int jj = 0; jj < 2; ++jj) { const int j = 4 * jj + pw; pg8::glds16(qk + o.qk[jj], dst + 1024 * j); pg8::glds16(qk + 512 + o.qk[jj], dst + 8192 + 1024 * j); }
    pg8::glds16(P.ws + WS_GATE + row0 * 128 + o.ra, lds + GL_RA + slot * 4096 + 1024 * pw);
}
DEV void gla_issue_v(const Params& P, LAS unsigned char* lds, int slot, int pw, const GlaDmaOff& o, int gc, int h) {
    const unsigned char* vp = P.ws + T_PGLAV + ((size_t)gc * 64 * 512 + h * 128) * 2;
#pragma unroll
    for (int jj = 0; jj < 4; ++jj) { const int j = 4 * jj + pw; pg8::glds16(vp + o.v[jj], lds + GL_V + slot * 16384 + 1024 * j); }
}
template <bool BARB, int DIRC>
DEV void gla_alpha(LAS unsigned char* lds, int rslot, int oslot, int pw, int lane, const float (&wb)[4], float blr, const int (&offr)[4]) {
    constexpr int dir = DIRC, mtstep = DIRC ? -2048 : 2048;
    const int c = lane & 15, g = lane >> 4, dk = 16 * pw + c;
    const LAS float* RA = (const LAS float*)(lds + GL_RA + rslot * 4096);
    float bcs[4][4]; float toff = 0.f, bmid = 0.f;
    const int ra0 = (dir ? 63 - c : c) * 16 + g, rastep = dir ? -256 : 256;
#pragma unroll
    for (int mt = 0; mt < 4; ++mt) {
        f32x4 acc = {0.f, 0.f, 0.f, 0.f};
#pragma unroll
        for (int kk = 0; kk < 4; ++kk) acc = mfma4f32(RA[ra0 + mt * rastep + 4 * kk], wb[kk], acc);
        float run = 0.f;
#pragma unroll
        for (int r = 0; r < 4; ++r) { const float x = acc[r] + blr; run += (fminf(x, 0.f) - flog_raw(1.f + fexp_raw(-fabsf(x)))) * (1.0f / 16.0f); bcs[mt][r] = run; }
        const float t0 = wshfl(run, c), t1 = wshfl(run, c + 16), t2 = wshfl(run, c + 32), t3 = wshfl(run, c + 48);
        const float goff = (g > 0 ? t0 : 0.f) + (g > 1 ? t1 : 0.f) + (g > 2 ? t2 : 0.f);
#pragma unroll
        for (int r = 0; r < 4; ++r) bcs[mt][r] += toff + goff;
        toff += (t0 + t1) + (t2 + t3);
        if (mt == 1) bmid = toff;
    }
    const float blast = toff;
    if (BARB) { LGKM_DRAIN(); PROF_B(10); RAW_BAR(); PROF_E(10); }
    const LAS unsigned char* rq = lds + GL_RAW + rslot * 16384; LAS unsigned char* oq = lds + GL_QK + oslot * 16384;
    bf16_t qr[4][4], kr[4][4];
#pragma unroll
    for (int mt = 0; mt < 4; ++mt)
#pragma unroll
        for (int r = 0; r < 4; ++r) { const int off = offr[r] + mt * mtstep; qr[mt][r] = *(const LAS bf16_t*)(rq + off); kr[mt][r] = *(const LAS bf16_t*)(rq + 8192 + off); }
#pragma unroll
    for (int mt = 0; mt < 4; ++mt)
#pragma unroll
        for (int r = 0; r < 4; ++r) { const float bb = bcs[mt][r];
            const int off = offr[r] + mt * mtstep;
            const float ef = fexp_raw(bb - bmid), eb = frcp(ef);
            const float qv = bf2f(qr[mt][r]) * 0.125f * ef, kv = bf2f(kr[mt][r]) * eb;
            const unsigned pr = pk2(qv, kv);
            *(LAS bf16_t*)(oq + off) = (bf16_t)(pr & 0xffffu); *(LAS bf16_t*)(oq + 8192 + off) = (bf16_t)(pr >> 16); }
    if (g == 0) { LAS float* VEC = (LAS float*)(lds + GL_VEC + oslot * 1024); VEC[dk] = fexp_raw(bmid); VEC[64 + dk] = fexp_raw(blast - bmid); VEC[128 + dk] = fexp_raw(blast); }
}
DEV void gla_scan_item(const Params& P, LAS unsigned char* lds, int l, int item, bool ctx_out) {
    const int tid = tidx(), wave = uniform_i(tid >> 6), lane0 = tid & 63;
    const int b = item % NB, rest = item / NB, h = rest >> 1, dir = rest & 1;
    constexpr int NS = NCC + NCL;
    const bool producer = wave >= 4; const int pw = wave - 4, cw = wave;
    int gc;
    if (producer) {
        float wl[4];
        { const int dk = 16 * pw + (lane0 & 15);
#pragma unroll
          for (int kk = 0; kk < 4; ++kk) wl[kk] = P.gla_w_lr[(((size_t)l * 2 + dir) * 16 + 4 * kk + (lane0 >> 4)) * 256 + h * 64 + dk]; }
        const float blr = P.gla_b_lr[((size_t)l * 2 + dir) * 256 + h * 64 + 16 * pw + (lane0 & 15)];
        int offr[4];
        { const int dk = 16 * pw + (lane0 & 15), g = lane0 >> 4;
#pragma unroll
          for (int r = 0; r < 4; ++r) { const int ip = 4 * g + r, tok = dir ? 63 - ip : ip; offr[r] = swz128(tok, dk >> 3) + (dk & 7) * 2; } }
        GlaDmaOff dmo; gla_dma_offsets(dmo, pw, lane0);
        gdn_chunk_of_step(b, dir, 0, gc); gla_issue_raw(P, lds, 0, pw, dmo, gc, h); gla_issue_v(P, lds, 0, pw, dmo, gc, h);
        if (NS > 1) { gdn_chunk_of_step(b, dir, 1, gc); gla_issue_raw(P, lds, 1, pw, dmo, gc, h); }
        VM_DRAIN(); RAW_BAR();
        if (dir) gla_alpha<false, 1>(lds, 0, 0, pw, lane0, wl, blr, offr); else gla_alpha<false, 0>(lds, 0, 0, pw, lane0, wl, blr, offr);
        LGKM_DRAIN(); RAW_BAR();
#pragma unroll 1
        for (int s = 0; s < NS; ++s) {
            const int lane = opaque_i(lane0);
            if (s + 2 < NS) { gdn_chunk_of_step(b, dir, s + 2, gc); gla_issue_raw(P, lds, s & 1, pw, dmo, gc, h); }
            if (s + 1 < NS) { gdn_chunk_of_step(b, dir, s + 1, gc); gla_issue_v(P, lds, (s + 1) & 1, pw, dmo, gc, h);
                if (dir) gla_alpha<true, 1>(lds, (s + 1) & 1, (s + 1) & 1, pw, lane, wl, blr, offr); else gla_alpha<true, 0>(lds, (s + 1) & 1, (s + 1) & 1, pw, lane, wl, blr, offr); }
            else { RAW_BAR(); }
            PROF_B(12); VM_DRAIN(); PROF_E(12); LGKM_DRAIN(); PROF_B(11); RAW_BAR(); PROF_E(11);
        }
    } else {
        f32x4 S[4][2];
#pragma unroll
        for (int i = 0; i < 4; ++i) { S[i][0] = (f32x4){0.f, 0.f, 0.f, 0.f}; S[i][1] = (f32x4){0.f, 0.f, 0.f, 0.f}; }
        RAW_BAR(); RAW_BAR();
#pragma unroll 1
        for (int s = 0; s < NS; ++s) {
            const int lane = opaque_i(lane0), fr = lane & 15, fq = lane >> 4;
            gdn_chunk_of_step(b, dir, s, gc); const int row0 = gc * 64;
            const LAS unsigned char* QT = lds + GL_QK + (s & 1) * 16384; const LAS unsigned char* KT = QT + 8192;
            const LAS unsigned char* VT = lds + GL_V + (s & 1) * 16384; const LAS float* VEC = (const LAS float*)(lds + GL_VEC + (s & 1) * 1024);
            { const int it = cw;
              bf16x8 qa[2] = {*(const LAS bf16x8*)(QT + swz128(16 * it + fr, fq)), *(const LAS bf16x8*)(QT + swz128(16 * it + fr, 4 + fq))};
              bf16x8 kb[4][2];
#pragma unroll
              for (int jt = 0; jt < 4; ++jt)
#pragma unroll
                  for (int k = 0; k < 2; ++k) kb[jt][k] = *(const LAS bf16x8*)(KT + swz128(16 * jt + fr, 4 * k + fq));
              f32x4 pa[4];
#pragma unroll
              for (int jt = 0; jt < 4; ++jt) { pa[jt] = (f32x4){0.f, 0.f, 0.f, 0.f};
#pragma unroll
                  for (int k = 0; k < 2; ++k) pa[jt] = mfma16(qa[k], kb[jt][k], pa[jt]); }
#pragma unroll
              for (int jt = 0; jt < 4; ++jt)
#pragma unroll
                  for (int r = 0; r < 4; ++r) { const int i = 16 * it + 4 * fq + r, j = 16 * jt + fr; const bool keep = dir ? j >= i : j <= i;
                      *(LAS bf16_t*)(lds + GL_P + swz128(i, j >> 3) + (j & 7) * 2) = (bf16_t)f2bf(keep ? pa[jt][r] : 0.f); }
            }
            LGKM_DRAIN(); PROF_B(20); RAW_BAR(); PROF_E(20);
            bf16x8 Vb[2][2], Sb[2][2];
#pragma unroll
            for (int nt = 0; nt < 2; ++nt)
#pragma unroll
                for (int k = 0; k < 2; ++k) { const int row = 32 * k + 8 * fq + ((lane >> 2) & 3), ch = 4 * cw + 2 * nt + ((lane & 3) >> 1), off = (lane & 1) * 8;
                    Vb[nt][k] = join_s4(lds_tr16(VT + swz256(row, ch) + off), lds_tr16(VT + swz256(row + 4, ch) + off)); }
#pragma unroll
            for (int nt = 0; nt < 2; ++nt)
#pragma unroll
                for (int k = 0; k < 2; ++k) { const f32x4 e0 = *(const LAS f32x4*)(VEC + 32 * k + 4 * fq), e1 = *(const LAS f32x4*)(VEC + 32 * k + 16 + 4 * fq);
                    Sb[nt][k] = pack_bf8(S[2 * k][nt] * e0, S[2 * k + 1][nt] * e1); }
            if (ctx_out || row0 < RL) {
                LAS unsigned char* ost = lds + GL_OST + cw * 4096;
                f32x4 oacc[4][2];
#pragma unroll
                for (int it = 0; it < 4; ++it) {
                    const bf16x8 pf0 = *(const LAS bf16x8*)(lds + GL_P + swz128(16 * it + fr, fq)), pf1 = *(const LAS bf16x8*)(lds + GL_P + swz128(16 * it + fr, 4 + fq));
                    const bf16x8 qp0 = afrag_pi128(QT, 16 * it + fr, 0, fq), qp1 = afrag_pi128(QT, 16 * it + fr, 1, fq);
#pragma unroll
                    for (int nt = 0; nt < 2; ++nt) { f32x4 a = {0.f, 0.f, 0.f, 0.f};
                        a = mfma16(pf0, Vb[nt][0], a); a = mfma16(pf1, Vb[nt][1], a); a = mfma16(qp0, Sb[nt][0], a); a = mfma16(qp1, Sb[nt][1], a);
                        oacc[it][nt] = a; }
                }
#pragma unroll
                for (int it = 0; it < 4; ++it)
#pragma unroll
                    for (int nt = 0; nt < 2; ++nt)
#pragma unroll
                        for (int j = 0; j < 4; ++j) *(LAS bf16_t*)(ost + (16 * it + 4 * fq + j) * 64 + (16 * nt + fr) * 2) = (bf16_t)f2bf(oacc[it][nt][j]);
                wave_sync();
                bf16_t* og = (bf16_t*)(P.ws + T_OGLA) + ((size_t)dir * ROWS + row0) * 512 + h * 128 + 32 * cw;
#pragma unroll
                for (int i = 0; i < 4; ++i) { const int c = lane + 64 * i, row = c >> 2, q4 = c & 3;
                    *(u32x4*)(og + (size_t)row * 512 + q4 * 8) = *(const LAS u32x4*)(ost + row * 64 + q4 * 16); }
            }
#pragma unroll
            for (int dkt = 0; dkt < 4; ++dkt) {
                bf16x8 kt[2];
#pragma unroll
                for (int k = 0; k < 2; ++k) { const int row = 32 * k + 8 * fq + ((lane >> 2) & 3), ch = 2 * dkt + ((lane & 3) >> 1), off = (lane & 1) * 8;
                    kt[k] = join_s4(lds_tr16(KT + swz128(row, ch) + off), lds_tr16(KT + swz128(row + 4, ch) + off)); }
                const f32x4 ac = *(const LAS f32x4*)(VEC + 128 + 16 * dkt + 4 * fq), el = *(const LAS f32x4*)(VEC + 64 + 16 * dkt + 4 * fq);
#pragma unroll
                for (int nt = 0; nt < 2; ++nt) { f32x4 a = {0.f, 0.f, 0.f, 0.f};
                    a = mfma16(kt[0], Vb[nt][0], a); a = mfma16(kt[1], Vb[nt][1], a);
                    S[dkt][nt] = S[dkt][nt] * ac + a * el; }
            }
            LGKM_DRAIN(); PROF_B(21); RAW_BAR(); PROF_E(21);
        }
    }
    VM_DRAIN(); block_sync();
}
DEV void phase_scan(const Params& P, LAS unsigned char* lds, int l, int vb, int nvb) {
    const bool ctx_out = (l == 0);
    for (int it = vb; it < GDN_ITEMS + GLA_ITEMS; it += nvb) {
        if (it < GDN_ITEMS) gdn_scan_item(P, lds, it, ctx_out); else gla_scan_item(P, lds, l, it - GDN_ITEMS, ctx_out);
    }
}

DEV void phase_merge(const Params& P, int l, int vb, int nvb) {
    const int tid = tidx(), wave = tid >> 6, lane = tid & 63;
    const int nrows = l == 1 ? M_LAST : ROWS;
    const bool gdn = lane >= 32; const int c0 = 16 * (lane & 31);
    const bf16_t* O = (const bf16_t*)(P.ws + (gdn ? T_OGDN : T_OGLA));
    float ngv[16];
    { const float* ng = (gdn ? P.gdn_norm_g : P.gla_norm_g) + l * 128 + (c0 & 127);
#pragma unroll
      for (int c = 0; c < 16; ++c) ngv[c] = ng[c]; }
    constexpr int RPI = 2;
    for (int rowb = RPI * (vb * NWAVE + wave); rowb < nrows; rowb += RPI * nvb * NWAVE) {
        u32x4 av[RPI][2], bv[RPI][2], gv[RPI][2];
#pragma unroll
        for (int u = 0; u < RPI; ++u) { const int row = rowb + u < nrows ? rowb + u : nrows - 1;
            const bf16_t* gp = (const bf16_t*)(P.ws + T_PG) + (size_t)row * 1024 + 16 * lane;
#pragma unroll
            for (int e = 0; e < 2; ++e) { av[u][e] = *(const u32x4*)(O + (size_t)row * 512 + c0 + 8 * e); bv[u][e] = *(const u32x4*)(O + ((size_t)ROWS + row) * 512 + c0 + 8 * e); gv[u][e] = *(const u32x4*)(gp + 8 * e); } }
#pragma unroll
        for (int u = 0; u < RPI; ++u) { const int row = rowb + u;
            float o[16]; float ssq = 0.f;
#pragma unroll
            for (int e = 0; e < 2; ++e)
#pragma unroll
                for (int j = 0; j < 4; ++j) { const float x0 = bflo(av[u][e][j]) + bflo(bv[u][e][j]), x1 = bfhi(av[u][e][j]) + bfhi(bv[u][e][j]); o[8 * e + 2 * j] = x0; o[8 * e + 2 * j + 1] = x1; ssq += x0 * x0 + x1 * x1; }
            ssq += wshfl_xor(ssq, 1); ssq += wshfl_xor(ssq, 2); ssq += wshfl_xor(ssq, 4);
            const float rs = frsq(ssq * (1.0f / 128.0f) + EPSN);
            if (row < nrows) {
                bf16_t* yp = ((row < RL || !SKIP_CTX_LAST) ? (bf16_t*)(P.ws + T_Y) + (size_t)row * 1024 : (bf16_t*)(P.ws + WS_YC) + (size_t)(row - RL) * 1024) + 16 * lane;
#pragma unroll
                for (int e = 0; e < 2; ++e) { u32x4 w;
#pragma unroll
                    for (int j = 0; j < 4; ++j) { const int c = 8 * e + 2 * j;
                        w[j] = pk2(o[c] * rs * ngv[c] * silu_f(bflo(gv[u][e][j])), o[c + 1] * rs * ngv[c + 1] * silu_f(bfhi(gv[u][e][j]))); }
                    *(u32x4*)(yp + 8 * e) = w; }
            }
        }
    }
}

DEV void phase_final(const Params& P, int vb, int nvb) {
    const int tid = tidx(), wave = tid >> 6, lane = tid & 63;
    const float* ss = (const float*)(P.ws + WS_SUMSQ) + (size_t)4 * ROWS;
    f32x4 g[4];
#pragma unroll
    for (int j = 0; j < 4; ++j) g[j] = *(const f32x4*)(P.final_norm_g + 4 * (64 * j + lane));
    for (int rowb = 2 * (vb * NWAVE + wave); rowb < RL; rowb += 2 * nvb * NWAVE) {
        f32x4 v[2][4]; float sv[2];
#pragma unroll
        for (int u = 0; u < 2; ++u) { const int row = rowb + u < RL ? rowb + u : RL - 1; sv[u] = ss[row + (lane & 0)];
#pragma unroll
            for (int j = 0; j < 4; ++j) v[u][j] = *(const f32x4*)(P.out + (size_t)row * D + 4 * (64 * j + lane)); }
#pragma unroll
        for (int u = 0; u < 2; ++u) { const int row = rowb + u; if (row < RL) { const float rs = frsq(sv[u] * (1.0f / D) + EPSN);
#pragma unroll
            for (int j = 0; j < 4; ++j) *(f32x4*)(P.out + (size_t)row * D + 4 * (64 * j + lane)) = v[u][j] * rs * g[j]; } }
    }
}

constexpr size_t CTL_CTXCNT = 16384;
static_assert(CTL_QUEUE_OFS + 4 * 8 * 256 <= CTL_BYTES && CTL_QUEUE_OFS > CTL_CTXCNT + 256, "control words");
#ifndef EMU
DEV void handoff_publish(unsigned* cnt) {
    asm volatile("s_waitcnt vmcnt(0)" ::: "memory"); __syncthreads();
    if (threadIdx.x == 0) { __builtin_amdgcn_fence(__ATOMIC_RELEASE, "agent"); asm volatile("s_waitcnt vmcnt(0)" ::: "memory"); __hip_atomic_fetch_add(cnt, 1u, __ATOMIC_RELAXED, __HIP_MEMORY_SCOPE_AGENT); }
}
DEV void handoff_wait(unsigned* cnt, unsigned need) {
    if (threadIdx.x == 0) { unsigned sp = 0; while (__hip_atomic_load(cnt, __ATOMIC_RELAXED, __HIP_MEMORY_SCOPE_AGENT) < need) { __builtin_amdgcn_s_sleep(4); if (++sp > (1u << 24)) break; }
        __builtin_amdgcn_fence(__ATOMIC_ACQUIRE, "agent"); asm volatile("s_waitcnt vmcnt(0)" ::: "memory"); }
    __syncthreads();
}
#else
DEV void handoff_publish(unsigned* cnt) { emu_syncthreads(); if (threadIdx.x == 0) __atomic_fetch_add(cnt, 1u, __ATOMIC_SEQ_CST); }
DEV void handoff_wait(unsigned* cnt, unsigned need) { if (threadIdx.x == 0) { while (__atomic_load_n(cnt, __ATOMIC_SEQ_CST) < need) sched_yield(); } emu_syncthreads(); }
#endif
constexpr int N_PHASES = 19;
DEV void run_phase(const Params& P, LAS unsigned char* lds, int ph, int vb, int nvb) {
    float* ss = (float*)(P.ws + WS_SUMSQ); const float* MOD = (const float*)(P.ws + WS_MOD); const float* GS = (const float*)(P.ws + WS_GS);
    if (ph == 0) { phase0a(P, lds, vb, nvb); return; }
    if (ph == 1) { phase0b(P, lds, vb, nvb); return; }
    if (ph == N_PHASES - 1) { phase_final(P, vb, nvb); return; }
    const int l = (ph - 2) / 8, sub = (ph - 2) % 8;
    const int Mx = l == 1 ? M_LAST : ROWS;
    float* xc = (float*)(P.ws + WS_XC);
    constexpr int PML = RL / 256, PMC = RC / 256;
    const bool defer = SKIP_CTX_LAST;
    if (sub == 0) {
        pg8::Gemm g{(const bf16_t*)(P.ws + T_A), (const bf16_t*)(P.ws + WS_WIN + (size_t)l * WIN_BYTES), ROWS, NP, D};
        pg8::EpiIn E{ss + (size_t)(2 * l) * ROWS, (const float*)(P.ws + WS_SHW1) + (size_t)l * NMOD * NP, P.ws};
        if (l == 0 || !defer) {
            pg8::StaticOrder S; S.init(ROWS, NP, nvb, vb);
            pg8::gemm_phase(lds + LDS_RING, g, S, E);
        } else {
            unsigned* cnt = (unsigned*)(P.ws + WS_CTL + CTL_CTXCNT);
            const int nct = PMC * (D / 256), nhb = nct < nvb ? nct : nvb;
            { pg8::Gemm g2{(const bf16_t*)(P.ws + T_HID), (const bf16_t*)(P.ws + WS_WFF2), ROWS, D, FF};
              pg8::SegOrder S; S.init(PML, PMC, D, vb, nvb, 1 << 20);
              pg8::EpiRes E2{P.out, xc, P.out, xc, MOD + 5 * D, GS + (size_t)(2) * NMOD * D, (bf16_t*)(P.ws + T_A), ss + (size_t)2 * ROWS};
              pg8::gemm_phase(lds + LDS_RING, g2, S, E2);
              if (vb < nhb) handoff_publish(cnt); }
            { const int ntot = PML * (NP / 256), nlight = nvb - nhb;
              const int per_light = nlight > 0 ? (ntot + 4 * nhb + nvb - 1) / nvb : 0, per_heavy = per_light > 4 ? per_light - 4 : 0;
              pg8::SegOrder S;
              if (vb >= nhb) S.init(0, PML, NP, vb - nhb, nlight, per_light); else S.init(0, PML, NP, nlight * per_light + vb, nhb, nlight > 0 ? per_heavy : 1 << 20);
              pg8::gemm_phase(lds + LDS_RING, g, S, E); }
            { pg8::SegOrder S; S.init(PML, PMC, NP, nvb - 1 - vb, nvb, 1 << 20);
              pg8::Unit u0; if (S.next(0, u0)) handoff_wait(cnt, (unsigned)nhb);
              pg8::gemm_phase(lds + LDS_RING, g, S, E); }
        }
    } else if (sub == 1) { phase_prep_a(P, lds, l, vb, nvb);
    } else if (sub == 2) { phase_prep_b(P, lds, l, vb, nvb);
    } else if (sub == 3) { phase_scan(P, lds, l, vb, nvb);
    } else if (sub == 4) { phase_merge(P, l, vb, nvb);
    } else if (sub == 5) {
        pg8::Gemm g{(const bf16_t*)(P.ws + T_Y), (const bf16_t*)(P.ws + WS_WOUT), Mx, D, D};
        pg8::EpiRes E{l == 0 ? P.x : P.out, l == 0 ? P.ctx : xc, P.out, xc, MOD + (size_t)l * NMOD * 6 * D + 2 * D, GS + (size_t)(l * 2 + 1) * NMOD * D,
                      (bf16_t*)(P.ws + T_A), ss + (size_t)(2 * l + 1) * ROWS};
        if (l == 0 && defer) { pg8::SegOrder S; S.init(0, PML, D, vb, nvb, 1 << 20); pg8::gemm_phase(lds + LDS_RING, g, S, E); }
        else { pg8::StaticOrder S; S.init(Mx, D, nvb, vb); pg8::gemm_phase(lds + LDS_RING, g, S, E); }
    } else if (sub == 6) {
        pg8::Gemm g{(const bf16_t*)(P.ws + T_A), (const bf16_t*)(P.ws + WS_WFF1), Mx, FF, D};
        pg8::EpiFF1 E{ss + (size_t)(2 * l + 1) * ROWS, (const float*)(P.ws + WS_SHW2) + (size_t)l * NMOD * FF, (bf16_t*)(P.ws + T_HID)};
        if (l == 0 && defer) {
            { pg8::Gemm g2{(const bf16_t*)(P.ws + WS_YC) - (size_t)RL * D, (const bf16_t*)(P.ws + WS_WOUT), ROWS, D, D};
              pg8::EpiRes E2{P.x, P.ctx, P.out, xc, MOD + 2 * D, GS + (size_t)(1) * NMOD * D, (bf16_t*)(P.ws + T_A), ss + (size_t)1 * ROWS};
              pg8::SegOrder S; S.init(PML, PMC, D, nvb - 1 - vb, nvb, 1 << 20); pg8::gemm_phase(lds + LDS_RING, g2, S, E2); }
            { pg8::SegOrder S; S.init(0, PML, FF, vb, nvb, 1 << 20); pg8::gemm_phase(lds + LDS_RING, g, S, E); }
        } else { pg8::StaticOrder S; S.init(Mx, FF, nvb, vb); pg8::gemm_phase(lds + LDS_RING, g, S, E); }
    } else {
        pg8::Gemm g{(const bf16_t*)(P.ws + T_HID), (const bf16_t*)(P.ws + WS_WFF2), Mx, D, FF};
        pg8::EpiRes E{P.out, xc, P.out, xc, MOD + (size_t)l * NMOD * 6 * D + 5 * D, l == 0 ? GS + (size_t)(2) * NMOD * D : nullptr,
                      (bf16_t*)(P.ws + T_A), ss + (size_t)(l == 0 ? 2 : 4) * ROWS};
        if (l == 0 && defer) {
            { pg8::Gemm g2{(const bf16_t*)(P.ws + T_A), (const bf16_t*)(P.ws + WS_WFF1), ROWS, FF, D};
              pg8::EpiFF1 E2{ss + (size_t)1 * ROWS, (const float*)(P.ws + WS_SHW2), (bf16_t*)(P.ws + T_HID)};
              pg8::SegOrder S; S.init(PML, PMC, FF, nvb - 1 - vb, nvb, 1 << 20); pg8::gemm_phase(lds + LDS_RING, g2, S, E2); }
            { pg8::SegOrder S; S.init(0, PML, D, vb, nvb, 1 << 20); pg8::gemm_phase(lds + LDS_RING, g, S, E); }
        } else { pg8::StaticOrder S; S.init(Mx, D, nvb, vb); pg8::gemm_phase(lds + LDS_RING, g, S, E); }
    }
}

#ifndef EMU
#define XB_TMO      128
#define XB_XCNT(j)  (256  + 64 * (j))
#define XB_XSUB(j)  (1280 + 64 * (j))
#define XB_XGEN(j)  (2304 + 64 * (j))
#define XB_TOP      3328
#define XB_TOPGEN   3392
#define XCD_BAR_WORDS 3456
#define XB_SPIN_CAP (1u << 22)
__device__ __forceinline__ unsigned xb_ld(unsigned* p)              { return __hip_atomic_load(p, __ATOMIC_RELAXED, __HIP_MEMORY_SCOPE_AGENT); }
__device__ __forceinline__ unsigned xb_add(unsigned* p, unsigned v) { return __hip_atomic_fetch_add(p, v, __ATOMIC_RELAXED, __HIP_MEMORY_SCOPE_AGENT); }
__device__ __forceinline__ unsigned xb_xcc_id() { return (unsigned)__builtin_amdgcn_s_getreg((3 << 11) | 20) & 0xFu; }
#define XB_SPIN(cond, bar) do { unsigned _sp = 0; while (cond) { __builtin_amdgcn_s_sleep(1); \
    if ((++_sp & 255u) == 0u) { if (xb_ld(&(bar)[XB_TMO])) break; if (_sp > XB_SPIN_CAP) { atomicAdd(&(bar)[XB_TMO], 1u); break; } } } } while (0)
struct XcdBarrier { unsigned* bar; unsigned x; volatile LAS unsigned* st; };
__device__ __forceinline__ XcdBarrier xcd_barrier_post(unsigned* bar, volatile LAS unsigned* st) {
    XcdBarrier b; b.bar = bar; b.x = xb_xcc_id(); b.st = st;
    if (threadIdx.x == 0) (void)xb_add(&bar[XB_XCNT(b.x)], 1u);
    return b;
}
__device__ __forceinline__ void xcd_barrier_complete(unsigned* bar, unsigned x, unsigned& nloc, unsigned& nx) {
    const unsigned G = gridDim.x * gridDim.y * gridDim.z;
    unsigned sum, cnt, mine, sp = 0u;
    for (;;) {
        sum = 0u; cnt = 0u; mine = 0u;
#pragma unroll
        for (unsigned j = 0; j < 16; ++j) { const unsigned c = xb_ld(&bar[XB_XCNT(j)]); sum += c; cnt += (c > 0u) ? 1u : 0u; mine = (j == x) ? c : mine; }
        if (sum == G) break;
        __builtin_amdgcn_s_sleep(1);
        if ((++sp & 255u) == 0u) { if (xb_ld(&bar[XB_TMO])) break; if (sp > XB_SPIN_CAP) { atomicAdd(&bar[XB_TMO], 1u); break; } }
    }
    nloc = mine > 0u ? mine : 1u; nx = cnt > 0u ? cnt : 1u;
}
__device__ __forceinline__ void xcd_barrier(const XcdBarrier& b) {
    asm volatile("s_waitcnt vmcnt(0)" ::: "memory");
    __syncthreads();
    if (threadIdx.x == 0) {
        unsigned* bar = b.bar;
        __builtin_amdgcn_s_waitcnt(0);
        unsigned nloc = b.st[0], nx = b.st[1];
        if (nloc == 0u) { xcd_barrier_complete(bar, b.x, nloc, nx); b.st[0] = nloc; b.st[1] = nx; }
        const unsigned old = xb_add(&bar[XB_XSUB(b.x)], 1u);
        const unsigned gen = old / nloc;
        if (old + 1u == (gen + 1u) * nloc) {
            __builtin_amdgcn_fence(__ATOMIC_RELEASE, "agent");
            asm volatile("s_waitcnt vmcnt(0)" ::: "memory");
            const unsigned og = xb_add(&bar[XB_TOP], 1u);
            const unsigned tg = og / nx;
            if (og + 1u == (tg + 1u) * nx) xb_add(&bar[XB_TOPGEN], 1u);
            else XB_SPIN(xb_ld(&bar[XB_TOPGEN]) == tg, bar);
            __builtin_amdgcn_fence(__ATOMIC_ACQUIRE, "agent");
            xb_add(&bar[XB_XGEN(b.x)], 1u);
            asm volatile("s_waitcnt vmcnt(0)" ::: "memory");
        } else {
            XB_SPIN(xb_ld(&bar[XB_XGEN(b.x)]) == gen, bar);
            __builtin_amdgcn_fence(__ATOMIC_ACQUIRE, "agent");
            asm volatile("s_waitcnt vmcnt(0)" ::: "memory");
        }
    }
    __syncthreads();
}
constexpr int LDS_MISC = 163840 - 256;

__global__ void __launch_bounds__(NT, 2) k_mega(Params P) {
    extern __shared__ __attribute__((aligned(16))) unsigned char lds_raw[];
    LAS unsigned char* lds = (LAS unsigned char*)lds_raw;
    cg::grid_group grid = cg::this_grid();
    if (threadIdx.x < 64) ((LAS unsigned*)(lds + LDS_MISC))[threadIdx.x] = 0u;
    __syncthreads();
    XcdBarrier bar = xcd_barrier_post((unsigned*)(P.ws + WS_CTL), (volatile LAS unsigned*)(lds + LDS_MISC));
    for (int ph = 0; ph < N_PHASES; ++ph) {
        run_phase(P, lds, ph, (int)blockIdx.x, (int)gridDim.x);
        if (ph == 0) grid.sync();
        else if (ph + 1 < N_PHASES) xcd_barrier(bar);
    }
}

extern "C" void kernel_launch(void* const* d_in, const int* in_sizes, int n_in, void* d_out, int out_size, void* d_ws, size_t ws_size, hipStream_t stream) {
    static int grid = 0;
    if (grid == 0) {
        int dev = 0, cus = 0, per_cu = 0;
        (void)hipGetDevice(&dev); (void)hipDeviceGetAttribute(&cus, hipDeviceAttributeMultiprocessorCount, dev);
        (void)hipFuncSetAttribute((const void*)k_mega, hipFuncAttributeMaxDynamicSharedMemorySize, LDS_BYTES);
        (void)hipOccupancyMaxActiveBlocksPerMultiprocessor(&per_cu, (const void*)k_mega, NT, LDS_BYTES);
        if (per_cu < 1) { fprintf(stderr, "kernel_launch: occupancy query says %d blocks per CU\n", per_cu); per_cu = 1; }
        if (per_cu > 1) per_cu = 1;
        grid = (cus > 0 ? cus : 256) * per_cu;
        if (ws_size < WS_END) { fprintf(stderr, "kernel_launch: workspace too small: %zu < %zu\n", ws_size, (size_t)WS_END); grid = -1; }
    }
    if (grid < 0) return;
    Params P{};
    const float** pp = (const float**)&P;
    for (int i = 0; i < 20; ++i) pp[i] = (const float*)d_in[i];
    P.out = (float*)d_out; P.ws = (unsigned char*)d_ws;
    (void)hipMemsetAsync((char*)d_ws + WS_CTL, 0, CTL_BYTES, stream);
    void* args[] = {&P};
    hipError_t e = hipLaunchCooperativeKernel((const void*)k_mega, dim3(grid), dim3(NT), args, LDS_BYTES, stream);
    if (e != hipSuccess) fprintf(stderr, "cooperative launch failed: %s (grid %d)\n", hipGetErrorString(e), grid);
}
#endif
```

```cpp
#ifndef EMU
#include <hip/hip_runtime.h>
#include <hip/hip_cooperative_groups.h>
#include <cstdio>
#include <cstdint>
namespace cg = cooperative_groups;
typedef short bf16x8 __attribute__((ext_vector_type(8)));
typedef short s16x4 __attribute__((ext_vector_type(4)));
typedef float f32x4 __attribute__((ext_vector_type(4)));
typedef float f32x2 __attribute__((ext_vector_type(2)));
typedef unsigned u32x4 __attribute__((ext_vector_type(4)));
typedef unsigned u32x2 __attribute__((ext_vector_type(2)));
#define LAS __attribute__((address_space(3)))
#define DEV __device__ __forceinline__
#define MDEV __device__ __forceinline__
#else
#define LAS
#define DEV static inline __attribute__((always_inline))
#define MDEV inline __attribute__((always_inline))
#endif
typedef unsigned short bf16_t;

#ifndef CFG_BATCH
#define CFG_BATCH 8
#define CFG_SEQ 4096
#define CFG_CTX 256
#endif
constexpr int D = 1024, NB = CFG_BATCH, SEQ = CFG_SEQ, CTX = CFG_CTX, FF = 4096, NP = 3840, NPROJ = 3616;
constexpr int RL = NB * SEQ, RC = NB * CTX, ROWS = RL + RC;
constexpr int NCL = SEQ / 64, NCC = CTX / 64, NCH = ROWS / 64;
constexpr int NMOD = NB + 1;
constexpr bool SKIP_CTX_LAST = (RL % 256 == 0);
constexpr int M_LAST = SKIP_CTX_LAST ? RL : ROWS;
constexpr float EPSN = 1e-6f;
static_assert(ROWS % 256 == 0 && SEQ % 64 == 0 && CTX % 64 == 0, "shape");
constexpr int NT = 512, NWAVE = 8;

constexpr size_t al256(size_t x) { return (x + 255) & ~(size_t)255; }
constexpr size_t WS_CTL = 0;                                   constexpr size_t CTL_BYTES = 65536;
constexpr size_t WS_MOD = WS_CTL + CTL_BYTES;                  constexpr size_t MOD_BYTES = al256((size_t)2 * NMOD * 6 * D * 4);
constexpr size_t WS_GS = WS_MOD + MOD_BYTES;                   constexpr size_t GS_BYTES = al256((size_t)2 * 2 * NMOD * D * 4);
constexpr size_t WS_SHW1 = WS_GS + GS_BYTES;                   constexpr size_t SHW1_BYTES = al256((size_t)2 * NMOD * NP * 4);
constexpr size_t WS_SHW2 = WS_SHW1 + SHW1_BYTES;               constexpr size_t SHW2_BYTES = al256((size_t)2 * NMOD * FF * 4);
constexpr size_t WS_SUMSQ = WS_SHW2 + SHW2_BYTES;              constexpr size_t SUMSQ_BYTES = al256((size_t)5 * ROWS * 4);
constexpr size_t WS_GATE = WS_SUMSQ + SUMSQ_BYTES;             constexpr size_t GATE_BYTES = al256((size_t)ROWS * 32 * 4);
constexpr size_t WS_XC = WS_GATE + GATE_BYTES;                 constexpr size_t XC_BYTES = al256((size_t)RC * D * 4);
constexpr size_t WS_WIN = WS_XC + XC_BYTES;                    constexpr size_t WIN_BYTES = al256((size_t)NP * D * 2);
constexpr size_t WS_WOUT = WS_WIN + 2 * WIN_BYTES;             constexpr size_t WOUT_BYTES = al256((size_t)D * D * 2);
constexpr size_t WS_WFF1 = WS_WOUT + WOUT_BYTES;               constexpr size_t WFF1_BYTES = al256((size_t)FF * D * 2);
constexpr size_t WS_WFF2 = WS_WFF1 + WFF1_BYTES;               constexpr size_t WFF2_BYTES = al256((size_t)D * FF * 2);
constexpr size_t WS_QKVNC = WS_WFF2 + WFF2_BYTES;              constexpr size_t QKVNC_BYTES = al256((size_t)RC * 1536 * 2);
constexpr size_t WS_YC = WS_QKVNC + QKVNC_BYTES;               constexpr size_t YC_BYTES = al256((size_t)RC * D * 2);
constexpr size_t WS_TEMP = WS_YC + YC_BYTES;
constexpr size_t SZA = (size_t)ROWS * D * 2;
constexpr size_t TAQK_ITEM = 8192 + 8192 + 1024;
constexpr size_t T_A = WS_TEMP;
constexpr size_t T_PG = WS_TEMP + SZA;
constexpr size_t T_PGLAQK = WS_TEMP + 2 * SZA;
constexpr size_t T_PGLAV = T_PGLAQK + SZA / 2;
constexpr size_t T_PGDN = WS_TEMP + 3 * SZA;
constexpr size_t T_TAQK = T_PGDN + SZA + SZA / 2;
constexpr size_t TAQK_BYTES = al256((size_t)NCH * 8 * TAQK_ITEM);
constexpr size_t T_OGDN = T_TAQK + TAQK_BYTES;
constexpr size_t T_OGLA = T_A;
constexpr size_t T_Y = T_PGLAQK;
constexpr size_t T_HID = T_PG;
constexpr size_t WS_END = T_OGDN + SZA;
static_assert(T_HID + (size_t)ROWS * FF * 2 <= WS_END, "hid fits");
static_assert(WS_END <= (size_t)512 * 1024 * 1024, "workspace budget (512 MiB)");

constexpr int LDS_BYTES = 163840;
constexpr int LDS_RING = 0;

#ifndef EMU
DEV f32x4 mfma16(bf16x8 a, bf16x8 b, f32x4 c) { return __builtin_amdgcn_mfma_f32_16x16x32_bf16(a, b, c, 0, 0, 0); }
DEV f32x4 mfma4f32(float a, float b, f32x4 c) { return __builtin_amdgcn_mfma_f32_16x16x4f32(a, b, c, 0, 0, 0); }
DEV void block_sync() { __syncthreads(); }
DEV float wshfl_xor(float v, int m) { return __shfl_xor(v, m); }
DEV float wshfl_up(float v, int d) { return __shfl_up(v, d); }
DEV float wshfl(float v, int l) { return __shfl(v, l); }
DEV s16x4 lds_tr16(const LAS unsigned char* p) { return __builtin_amdgcn_ds_read_tr16_b64_v4i16((LAS s16x4*)p); }
DEV void atomic_addf(float* p, float v) { atomicAdd(p, v); }
DEV float fexp(float x) { return __builtin_amdgcn_exp2f(x * 1.4426950408889634f); }
DEV float flog(float x) { return __builtin_amdgcn_logf(x) * 0.6931471805599453f; }
DEV float frcp(float x) { return __builtin_amdgcn_rcpf(x); }
DEV float frsq(float x) { return __builtin_amdgcn_rsqf(x); }
DEV float fexp_raw(float x) { return __builtin_amdgcn_exp2f(x * 1.4426950408889634f); }
DEV float flog_raw(float x) { return __builtin_amdgcn_logf(x) * 0.6931471805599453f; }
DEV int uniform_i(int x) { return __builtin_amdgcn_readfirstlane(x); }
DEV int opaque_i(int x) { asm volatile("" : "+v"(x)); return x; }
DEV void wave_sync() { asm volatile("s_waitcnt lgkmcnt(0)" ::: "memory"); __builtin_amdgcn_wave_barrier(); }
DEV int tidx() { return opaque_i((int)threadIdx.x); }
#else
DEV f32x4 mfma16(bf16x8 a, bf16x8 b, f32x4 c) { return emu_mfma16(a, b, c); }
DEV f32x4 mfma4f32(float a, float b, f32x4 c) { return emu_mfma4f32(a, b, c); }
DEV void block_sync() { emu_syncthreads(); }
DEV float wshfl_xor(float v, int m) { return emu_shfl_xor(v, m); }
DEV float wshfl_up(float v, int d) { return emu_shfl_up(v, d); }
DEV float wshfl(float v, int l) { return emu_shfl(v, l); }
DEV s16x4 lds_tr16(const unsigned char* p) { return emu_ds_read_tr16(p); }
DEV void atomic_addf(float* p, float v) { emu_atomic_add(p, v); }
DEV float fexp(float x) { return expf(x); }
DEV float flog(float x) { return logf(x); }
DEV float frcp(float x) { return 1.0f / x; }
DEV float frsq(float x) { return 1.0f / sqrtf(x); }
DEV float fexp_raw(float x) { return expf(x); }
DEV float flog_raw(float x) { return logf(x); }
DEV int uniform_i(int x) { return x; }
DEV int opaque_i(int x) { return x; }
DEV void wave_sync() { int z = 0; (void)emu_wave_exchange(&z, 4); }
DEV int tidx() { return (int)threadIdx.x; }
#endif
#ifndef EMU
#define VM_DRAIN() asm volatile("s_waitcnt vmcnt(0)" ::: "memory")
#define LGKM_DRAIN() asm volatile("s_waitcnt lgkmcnt(0)" ::: "memory")
#define RAW_BAR() __builtin_amdgcn_s_barrier()
#define SCHED_FENCE() __builtin_amdgcn_sched_barrier(0)
#else
#define VM_DRAIN()
#define LGKM_DRAIN()
#define RAW_BAR() emu_syncthreads()
#define SCHED_FENCE()
#endif
DEV unsigned f2bf(float f) { unsigned u = __builtin_bit_cast(unsigned, f); return (u + 0x7fffu + ((u >> 16) & 1u)) >> 16; }
#ifndef EMU
typedef __bf16 hwbf16x2 __attribute__((ext_vector_type(2)));
DEV unsigned pk2(float lo, float hi) { const f32x2 f = {lo, hi}; return __builtin_bit_cast(unsigned, __builtin_convertvector(f, hwbf16x2)); }
#else
DEV unsigned pk2(float lo, float hi) { return f2bf(lo) | (f2bf(hi) << 16); }
#endif
DEV float bf2f(unsigned short s) { return __builtin_bit_cast(float, (unsigned)s << 16); }
DEV float bflo(unsigned u) { return __builtin_bit_cast(float, u << 16); }
DEV float bfhi(unsigned u) { return __builtin_bit_cast(float, u & 0xffff0000u); }
DEV float silu_f(float x) { return x * frcp(1.f + fexp(-x)); }
DEV float sigmoid_f(float x) { return frcp(1.f + fexp(-x)); }
DEV float logsigmoid_f(float x) { return fminf(x, 0.f) - flog(1.f + fexp(-fabsf(x))); }
DEV float softplus_f(float x) { return fmaxf(x, 0.f) + log1pf(fexp(-fabsf(x))); }
DEV float wave_sum(float v) {
#pragma unroll
    for (int o = 1; o < 64; o <<= 1) v += wshfl_xor(v, o);
    return v;
}
DEV int mod_of_row(int row) { return row < RL ? row / SEQ : NB; }
DEV int win_src_col(int n) {
    if (n < 1536) return n;
    if (n < 3584) return n + 16;
    if (n < 3600) return n - 3584 + 1536;
    if (n < 3616) return n;
    return -1;
}

#define PROF_B(t)
#define PROF_E(t)
struct Params {
    const float *x, *c, *ctx, *c_ctx, *w_ada, *b_ada, *norm1_g, *norm2_g, *w_in, *gla_w_lr, *gla_b_lr, *gdn_conv_w, *gdn_a_log, *gdn_dt_bias,
        *gla_norm_g, *gdn_norm_g, *w_out, *w_ff1, *w_ff2, *final_norm_g;
    float* out; unsigned char* ws;
};

template <class VecFn, class ColFn>
DEV void gemv_item(LAS unsigned char* lds, VecFn vecfn, const float* W, int ldw, ColFn colfn, int n0, const float* bias, float* out, int ldo) {
    LAS float* vec = (LAS float*)lds;
    LAS float* red = (LAS float*)(lds + NMOD * D * 4);
    const int tid = tidx(), wave = tid >> 6, lane = tid & 63;
    static_assert((NMOD * D) % NT == 0, "vec staging");
    { float tmp[NMOD * D / NT];
#pragma unroll
      for (int u = 0; u < NMOD * D / NT; ++u) { const int i = tid + u * NT; tmp[u] = vecfn(i / D, i % D); }
#pragma unroll
      for (int u = 0; u < NMOD * D / NT; ++u) vec[tid + u * NT] = tmp[u]; }
    block_sync();
    const int sc = colfn(n0 + lane);
    float acc[NMOD];
#pragma unroll
    for (int b = 0; b < NMOD; ++b) acc[b] = 0.f;
    const int k0 = wave * (D / 8);
    const float* wp = W + (sc >= 0 ? sc : 0);
    const float wm = sc >= 0 ? 1.f : 0.f;
#pragma unroll 1
    for (int k = k0; k < k0 + D / 8; k += 32) {
        float w[32];
#pragma unroll
        for (int u = 0; u < 32; ++u) w[u] = wp[(size_t)(k + u) * ldw];
#pragma unroll
        for (int u = 0; u < 32; ++u) { const float wv = w[u] * wm;
#pragma unroll
            for (int b = 0; b < NMOD; ++b) acc[b] += vec[b * D + k + u] * wv; }
    }
#pragma unroll
    for (int b = 0; b < NMOD; ++b) red[(wave * NMOD + b) * 64 + lane] = acc[b];
    block_sync();
    for (int i = tid; i < NMOD * 64; i += NT) {
        const int b = i >> 6, ln = i & 63; float s = 0.f;
#pragma unroll
        for (int w = 0; w < 8; ++w) s += red[(w * NMOD + b) * 64 + ln];
        const int sc2 = colfn(n0 + ln);
        if (bias && sc2 >= 0) s += bias[sc2];
        out[(size_t)b * ldo + n0 + ln] = s;
    }
    block_sync();
}
template <class ColFn>
DEV void transpose_item(const float* W, int K, int ldw, bf16_t* WT, int nblk, ColFn colfn, LAS float* scr, int item, int lane) {
    const int kb = item / nblk, nb = item % nblk, k0 = 64 * kb, n0 = 64 * nb;
    const int c4 = lane & 15, kr = lane >> 4;
    const int sc = colfn(n0 + 4 * c4);
    { f32x4 tv[16]; const float* wp = W + (sc >= 0 ? sc : 0); const float wm = sc >= 0 ? 1.f : 0.f;
#pragma unroll
      for (int i = 0; i < 16; ++i) tv[i] = *(const f32x4*)(wp + (size_t)(k0 + kr + 4 * i) * ldw);
#pragma unroll
      for (int i = 0; i < 16; ++i) { LAS float* d = scr + (kr + 4 * i) * 65 + 4 * c4; const f32x4 v = tv[i] * wm; d[0] = v[0]; d[1] = v[1]; d[2] = v[2]; d[3] = v[3]; } }
    wave_sync();
    const int c = lane & 7;
#pragma unroll
    for (int j = 0; j < 8; ++j) { const int n = (lane >> 3) + 8 * j; const LAS float* sp = scr + (8 * c) * 65 + n;
        u32x4 o; o.x = pk2(sp[0 * 65], sp[1 * 65]); o.y = pk2(sp[2 * 65], sp[3 * 65]); o.z = pk2(sp[4 * 65], sp[5 * 65]); o.w = pk2(sp[6 * 65], sp[7 * 65]);
        *(u32x4*)(WT + (size_t)(n0 + n) * K + k0 + 8 * c) = o; }
    wave_sync();
}
struct ColId { MDEV int operator()(int n) const { return n; } };
struct ColWin { MDEV int operator()(int n) const { return win_src_col(n); } };

DEV void convert_weights(const Params& P, LAS unsigned char* lds, int vb, int nvb, int layer_set) {
    const int tid = tidx(), wave = tid >> 6, lane = tid & 63;
    LAS float* scr = (LAS float*)(lds + wave * 16896);
    const int gw = vb * NWAVE + wave, NGW = nvb * NWAVE;
    constexpr int I_IN = (D / 64) * (NP / 64), I_OUT = (D / 64) * (D / 64), I_F1 = (D / 64) * (FF / 64), I_F2 = (FF / 64) * (D / 64);
    bf16_t* win0 = (bf16_t*)(P.ws + WS_WIN); bf16_t* win1 = (bf16_t*)(P.ws + WS_WIN + WIN_BYTES);
    bf16_t* wout = (bf16_t*)(P.ws + WS_WOUT); bf16_t* wff1 = (bf16_t*)(P.ws + WS_WFF1); bf16_t* wff2 = (bf16_t*)(P.ws + WS_WFF2);
    const int l = layer_set;
    const int nitems = (l == 0 ? 2 * I_IN : 0) + I_OUT + I_F1 + I_F2;
    for (int it = gw; it < nitems; it += NGW) {
        int r = it;
        if (l == 0) {
            if (r < I_IN) { transpose_item(P.w_in, D, NPROJ, win0, NP / 64, ColWin(), scr, r, lane); continue; } r -= I_IN;
            if (r < I_IN) { transpose_item(P.w_in + (size_t)D * NPROJ, D, NPROJ, win1, NP / 64, ColWin(), scr, r, lane); continue; } r -= I_IN;
        }
        if (r < I_OUT) { transpose_item(P.w_out + (size_t)l * D * D, D, D, wout, D / 64, ColId(), scr, r, lane); continue; } r -= I_OUT;
        if (r < I_F1) { transpose_item(P.w_ff1 + (size_t)l * D * FF, D, FF, wff1, FF / 64, ColId(), scr, r, lane); continue; } r -= I_F1;
        transpose_item(P.w_ff2 + (size_t)l * FF * D, FF, D, wff2, D / 64, ColId(), scr, r, lane);
    }
}

DEV void phase0a(const Params& P, LAS unsigned char* lds, int vb, int nvb) {
    const int tid = tidx();
    { float* ss = (float*)(P.ws + WS_SUMSQ); for (size_t i = (size_t)vb * NT + tid; i < (size_t)5 * ROWS; i += (size_t)nvb * NT) ss[i] = 0.f; }
    float* MOD = (float*)(P.ws + WS_MOD);
    constexpr int NBLK = 6 * D / 64;
    for (int it = vb; it < 2 * NBLK; it += nvb) {
        const int l = it / NBLK, nb = it % NBLK;
        auto vf = [&](int b, int k) { const float v = b < NB ? P.c[(size_t)b * D + k] : P.c_ctx[k]; return silu_f(v); };
        gemv_item(lds, vf, P.w_ada + (size_t)l * D * 6 * D, 6 * D, ColId(), nb * 64, P.b_ada + (size_t)l * 6 * D, MOD + (size_t)l * NMOD * 6 * D, 6 * D);
    }
    block_sync();
    convert_weights(P, lds, vb, nvb, 0);
}

DEV void phase0b(const Params& P, LAS unsigned char* lds, int vb, int nvb) {
    const int tid = tidx(), wave = tid >> 6, lane = tid & 63;
    const float* MOD = (const float*)(P.ws + WS_MOD);
    { float* GS = (float*)(P.ws + WS_GS);
      for (int i = vb * NT + tid; i < 2 * 2 * NMOD * D; i += nvb * NT) {
          const int k = i % D, b = (i / D) % NMOD, wh = (i / (D * NMOD)) & 1, l = i / (D * NMOD * 2);
          const float g = (wh ? P.norm2_g : P.norm1_g)[l * D + k];
          GS[i] = g * (1.f + MOD[((size_t)l * NMOD + b) * 6 * D + (wh ? 4 : 1) * D + k]);
      } }
    constexpr int NB1 = NP / 64, NB2 = FF / 64;
    for (int it = vb; it < 2 * (NB1 + NB2); it += nvb) {
        const int l = it / (NB1 + NB2), r = it % (NB1 + NB2);
        if (r < NB1) {
            auto vf = [&](int b, int k) { return MOD[((size_t)l * NMOD + b) * 6 * D + 0 * D + k]; };
            gemv_item(lds, vf, P.w_in + (size_t)l * D * NPROJ, NPROJ, ColWin(), r * 64, nullptr, (float*)(P.ws + WS_SHW1) + (size_t)l * NMOD * NP, NP);
        } else {
            auto vf = [&](int b, int k) { return MOD[((size_t)l * NMOD + b) * 6 * D + 3 * D + k]; };
            gemv_item(lds, vf, P.w_ff1 + (size_t)l * D * FF, FF, ColId(), (r - NB1) * 64, nullptr, (float*)(P.ws + WS_SHW2) + (size_t)l * NMOD * FF, FF);
        }
    }
    bf16_t* A = (bf16_t*)(P.ws + T_A); float* ss = (float*)(P.ws + WS_SUMSQ);
    for (int row0 = 2 * (vb * NWAVE + wave); row0 < ROWS; row0 += 2 * nvb * NWAVE) {
        f32x4 v[2][4]; const float* scp[2];
#pragma unroll
        for (int u = 0; u < 2; ++u) { const int row = row0 + u; const int b9 = mod_of_row(row);
            const float* xr = row < RL ? P.x + (size_t)row * D : P.ctx + (size_t)(row - RL) * D;
            scp[u] = MOD + (size_t)b9 * 6 * D + 1 * D;
#pragma unroll
            for (int j = 0; j < 4; ++j) v[u][j] = *(const f32x4*)(xr + 4 * (64 * j + lane)); }
#pragma unroll
        for (int u = 0; u < 2; ++u) { const int row = row0 + u; float s = 0.f;
#pragma unroll
            for (int j = 0; j < 4; ++j) {
                const int col = 4 * (64 * j + lane);
                const f32x4 x = v[u][j]; const f32x4 g = *(const f32x4*)(P.norm1_g + col); const f32x4 c = *(const f32x4*)(scp[u] + col);
                s += (x[0] * x[0] + x[1] * x[1]) + (x[2] * x[2] + x[3] * x[3]);
                u32x2 o; o.x = pk2(x[0] * g[0] * (1.f + c[0]), x[1] * g[1] * (1.f + c[1])); o.y = pk2(x[2] * g[2] * (1.f + c[2]), x[3] * g[3] * (1.f + c[3]));
                *(u32x2*)(A + (size_t)row * D + col) = o;
            }
            s = wave_sum(s);
            if (lane == 0) ss[row] = s; }
    }
}

namespace pg8 {
constexpr int BM = 256, BK = 64, HALF = 128, HTB = HALF * BK * 2, STAGE_BYTES = 8 * HTB, NXCD = 8, WGM = 8;
DEV int lds_byte(int r, int c) { const int st = (r >> 4) * 2 + (c >> 5), rr = r & 15, cc = c & 31, ob = rr * 64 + cc * 2; return st * 1024 + (ob ^ (((ob >> 9) & 1) << 5)); }
DEV void stage_rc(int b, int& R, int& C) { const int st = b / 1024, sb = b % 1024, swz = sb ^ (((sb >> 9) & 1) << 5); R = (st >> 1) * 16 + swz / 64; C = (st & 1) * 32 + (swz % 64) / 2; }
DEV int perm32(int rho) { const int n = rho >> 4, i = rho & 15; return 8 * (i >> 2) + 4 * n + (i & 3); }
struct Unit { int pm, pn; };
struct Gemm { const bf16_t* A; const bf16_t* Bt; int M, N, K; };
struct StaticOrder {
    int nM, nN, nwg, G, c;
    MDEV void init(int M, int N, int G_, int c_) { nM = M / BM; nN = N / BM; nwg = nM * nN; G = G_; c = c_; }
    MDEV void tile_of(long L, Unit& u) const {
        int wgid = (int)L; { const int q = nwg / NXCD, r = nwg % NXCD, xcd = wgid % NXCD, off = wgid / NXCD; wgid = (xcd < r ? xcd * (q + 1) : r * (q + 1) + (xcd - r) * q) + off; }
        const int nig = WGM * nN, gid = wgid / nig, fm = gid * WGM, gsz = (nM - fm) < WGM ? (nM - fm) : WGM;
        u.pm = fm + ((wgid % nig) % gsz); u.pn = (wgid % nig) / gsz;
    }
    MDEV bool next(int i, Unit& u) const { const long L = (long)i * G + c; if (L >= nwg) return false; tile_of(L, u); return true; }
};
struct SegOrder {
    StaticOrder so; int pm0, l0, lstride, lcount;
    MDEV void init(int pm0_, int npm, int N, int l0_, int lstride_, int lcount_) { so.init(npm * BM, N, 1, 0); pm0 = pm0_; l0 = l0_; lstride = lstride_; lcount = lcount_; }
    MDEV bool next(int i, Unit& u) const { if (i >= lcount) return false; const long L = (long)l0 + (long)i * lstride; if (L >= so.nwg) return false; so.tile_of(L, u); u.pm += pm0; return true; }
};
#ifndef EMU
DEV unsigned cvt_pk_bf16(float lo, float hi) { return pk2(lo, hi); }
DEV void glds16(const void* g, LAS unsigned char* l) { __builtin_amdgcn_global_load_lds((const unsigned*)g, (LAS unsigned*)l, 16, 0, 0); }
#define PG8_WAIT_V(n) asm volatile("s_waitcnt vmcnt(" #n ")" ::: "memory")
#define PG8_WAIT_L(n) asm volatile("s_waitcnt lgkmcnt(" #n ")" ::: "memory")
#define PG8_BAR __builtin_amdgcn_s_barrier()
#define PG8_SCHED __builtin_amdgcn_sched_barrier(0)
#define PG8_PRIO(x) __builtin_amdgcn_s_setprio(x)
#else
DEV unsigned cvt_pk_bf16(float lo, float hi) { return pk2(lo, hi); }
DEV void glds16(const void* g, unsigned char* l) { memcpy(l + (threadIdx.x & 63) * 16, g, 16); }
#define PG8_WAIT_V(n)
#define PG8_WAIT_L(n)
#define PG8_BAR emu_syncthreads()
#define PG8_SCHED
#define PG8_PRIO(x)
#endif

template <class Epi, class Sched>
DEV void gemm_phase(LAS unsigned char* lds, const Gemm g, const Sched& S, const Epi& E) {
    const int tid = tidx(), wid = uniform_i(tid >> 6), lane = tid & 63, wr = wid >> 2, wc = wid & 3, fr = lane & 15, fq = lane >> 4;
    const int K = g.K, nt = K / BK;
    unsigned voffA[2], voffB[2];
#pragma unroll
    for (int i = 0; i < 2; ++i) { int R, C; stage_rc(tid * 16 + i * 8192, R, C); const int Rb = Epi::PERM ? ((R & ~31) + perm32(R & 31)) : R;
        voffA[i] = (unsigned)(R * K + C) * 2u; voffB[i] = (unsigned)(Rb * K + C) * 2u; }
    const size_t kstep = (size_t)(BK * 2);
    const size_t hstep = (size_t)HALF * K * 2;
    const size_t tstep = 2 * hstep;
    const unsigned ldsw = (unsigned)wid * 1024u;
    const int aoff = lds_byte(wr * 64 + fr, fq * 8), boff = lds_byte(wc * 32 + fr, fq * 8);
#define PG8_SA(b, h) (((b) * 2 + (h)) * HTB)
#define PG8_SB(b, h) ((4 + (b) * 2 + (h)) * HTB)
#define PG8_STAGE(bufoff, gbase, voff) do { _Pragma("unroll") for (int _i = 0; _i < 2; ++_i) \
        glds16((const char*)(gbase) + (voff)[_i], lds + (bufoff) + ldsw + _i * 8192); } while (0)
#define PG8_LDA(dst, b, h) do { _Pragma("unroll") for (int m = 0; m < 4; ++m) _Pragma("unroll") for (int k = 0; k < 2; ++k) dst[m][k] = *(const LAS bf16x8*)(lds + PG8_SA(b, h) + aoff + m * 2048 + k * 1024); } while (0)
#define PG8_LDB(dst, b, h) do { _Pragma("unroll") for (int n = 0; n < 2; ++n) _Pragma("unroll") for (int k = 0; k < 2; ++k) dst[n][k] = *(const LAS bf16x8*)(lds + PG8_SB(b, h) + boff + n * 2048 + k * 1024); } while (0)
#define PG8_MMA(ai, bj, At, Bt) do { PG8_PRIO(1); _Pragma("unroll") for (int m = 0; m < 4; ++m) _Pragma("unroll") for (int n = 0; n < 2; ++n) _Pragma("unroll") for (int k = 0; k < 2; ++k) \
        acc[ai][bj][m][n] = mfma16(Bt[n][k], At[m][k], acc[ai][bj][m][n]); PG8_PRIO(0); } while (0)
    Unit cur, nxt; int ui = 0;
    if (!S.next(0, cur)) return;
    f32x4 acc[2][2][4][2];
#pragma unroll
    for (int a = 0; a < 2; ++a)
#pragma unroll
        for (int b = 0; b < 2; ++b)
#pragma unroll
            for (int m = 0; m < 4; ++m)
#pragma unroll
                for (int n = 0; n < 2; ++n) acc[a][b][m][n] = (f32x4){0.f, 0.f, 0.f, 0.f};
    bf16x8 At[4][2], B0[2][2], B1[2][2];
    const char* cA = (const char*)g.A + (size_t)cur.pm * tstep; const char* cB = (const char*)g.Bt + (size_t)cur.pn * tstep;
    PG8_STAGE(PG8_SB(0, 0), cB, voffB); PG8_STAGE(PG8_SB(0, 1), cB + hstep, voffB); PG8_STAGE(PG8_SA(0, 0), cA, voffA); PG8_STAGE(PG8_SA(0, 1), cA + hstep, voffA);
    if (wr == 1) PG8_BAR;
    PG8_WAIT_V(2); PG8_BAR;
    PG8_STAGE(PG8_SB(1, 0), cB + kstep, voffB); PG8_STAGE(PG8_SA(1, 0), cA + kstep, voffA); PG8_STAGE(PG8_SB(1, 1), cB + hstep + kstep, voffB);
    PG8_WAIT_V(6); PG8_BAR;
    for (;;) {
        const bool has_next = S.next(ui + 1, nxt);
        const char* nA = has_next ? (const char*)g.A + (size_t)nxt.pm * tstep : cA; const char* nB = has_next ? (const char*)g.Bt + (size_t)nxt.pn * tstep : cB;
        for (int t = 0; t < nt; t += 2) {
            const bool last = (t == nt - 2);
            const char* a1 = cA + (size_t)(t + 1) * kstep;
            const char* a2 = last ? nA : cA + (size_t)(t + 2) * kstep; const char* b2 = last ? nB : cB + (size_t)(t + 2) * kstep;
            const char* a3 = a2 + kstep; const char* b3 = b2 + kstep;
            PG8_LDB(B0, 0, 0); PG8_LDB(B1, 0, 1); PG8_SCHED; PG8_LDA(At, 0, 0); PG8_STAGE(PG8_SA(1, 1), a1 + hstep, voffA);
            PG8_WAIT_V(8); PG8_WAIT_L(0); PG8_BAR; PG8_MMA(0, 0, At, B0); PG8_MMA(0, 1, At, B1); PG8_BAR; PG8_SCHED;
            PG8_LDA(At, 0, 1); PG8_STAGE(PG8_SB(0, 0), b2, voffB); PG8_STAGE(PG8_SB(0, 1), b2 + hstep, voffB); PG8_STAGE(PG8_SA(0, 0), a2, voffA);
            PG8_WAIT_V(8); PG8_WAIT_L(0); PG8_BAR; PG8_MMA(1, 0, At, B0); PG8_MMA(1, 1, At, B1); PG8_BAR; PG8_SCHED;
            PG8_LDB(B0, 1, 0); PG8_LDB(B1, 1, 1); PG8_SCHED; PG8_LDA(At, 1, 0); PG8_STAGE(PG8_SA(0, 1), a2 + hstep, voffA);
            PG8_WAIT_V(8); PG8_WAIT_L(0); PG8_BAR; PG8_MMA(0, 0, At, B0); PG8_MMA(0, 1, At, B1); PG8_BAR; PG8_SCHED;
            PG8_LDA(At, 1, 1); PG8_STAGE(PG8_SB(1, 0), b3, voffB); PG8_STAGE(PG8_SB(1, 1), b3 + hstep, voffB); PG8_STAGE(PG8_SA(1, 0), a3, voffA);
            PG8_WAIT_V(8); PG8_WAIT_L(0); PG8_BAR; PG8_MMA(1, 0, At, B0); PG8_MMA(1, 1, At, B1); PG8_BAR; PG8_SCHED;
        }
        if (wr == 0) PG8_BAR;
        E(acc, cur, wr, wc, fr, fq);
        if (!has_next) break;
#pragma unroll
        for (int a = 0; a < 2; ++a)
#pragma unroll
            for (int b = 0; b < 2; ++b)
#pragma unroll
                for (int m = 0; m < 4; ++m)
#pragma unroll
                    for (int n = 0; n < 2; ++n) acc[a][b][m][n] = (f32x4){0.f, 0.f, 0.f, 0.f};
        cur = nxt; cA = nA; cB = nB; ++ui;
        if (wr == 1) PG8_BAR;
    }
    PG8_WAIT_V(0);
    PG8_BAR;
#undef PG8_SA
#undef PG8_SB
#undef PG8_STAGE
#undef PG8_LDA
#undef PG8_LDB
#undef PG8_MMA
}

struct EpiIn {
    static constexpr bool PERM = true;
    const float* sumsq; const float* shw; unsigned char* ws;
    MDEV void operator()(const f32x4 (&acc)[2][2][4][2], const Unit& u, int wr, int wc, int fr, int fq) const {
        const int pn = u.pn;
        bf16_t* base; int ld, cofs;
        if (pn < 2) { base = (bf16_t*)(ws + T_PGLAQK); ld = 512; cofs = pn * 256; }
        else if (pn < 4) { base = (bf16_t*)(ws + T_PGLAV); ld = 512; cofs = (pn - 2) * 256; }
        else if (pn < 6) { base = (bf16_t*)(ws + T_PG); ld = 1024; cofs = (pn - 4) * 256; }
        else if (pn < 12) { base = (bf16_t*)(ws + T_PGDN); ld = 1536; cofs = (pn - 6) * 256; }
        else if (pn < 14) { base = (bf16_t*)(ws + T_PG); ld = 1024; cofs = 512 + (pn - 12) * 256; }
        else { base = nullptr; ld = 0; cofs = 0; }
        const int lc = wc * 32 + 8 * fq;
        const int r0 = u.pm * BM + wr * 64 + fr;
        const int b9t = mod_of_row(u.pm * BM); const bool uni = b9t == mod_of_row(u.pm * BM + BM - 1);
        float ssv[2][4];
#pragma unroll
        for (int ai = 0; ai < 2; ++ai)
#pragma unroll
            for (int m = 0; m < 4; ++m) ssv[ai][m] = sumsq[r0 + ai * HALF + m * 16];
        f32x4 bv[2][2];
        { const float* sh = shw + (size_t)b9t * NP + pn * BM + lc;
#pragma unroll
          for (int bj = 0; bj < 2; ++bj) { bv[bj][0] = *(const f32x4*)(sh + bj * HALF); bv[bj][1] = *(const f32x4*)(sh + bj * HALF + 4); } }
#pragma unroll
        for (int ai = 0; ai < 2; ++ai)
#pragma unroll
            for (int m = 0; m < 4; ++m) {
                const int row = r0 + ai * HALF + m * 16;
                const float rstd = frsq(ssv[ai][m] * (1.0f / D) + EPSN);
                if (!uni) { const float* sh = shw + (size_t)mod_of_row(row) * NP + pn * BM + lc;
#pragma unroll
                    for (int bj = 0; bj < 2; ++bj) { bv[bj][0] = *(const f32x4*)(sh + bj * HALF); bv[bj][1] = *(const f32x4*)(sh + bj * HALF + 4); } }
                if (base) {
#pragma unroll
                    for (int bj = 0; bj < 2; ++bj) {
                        const f32x4 v0 = acc[ai][bj][m][0] * rstd + bv[bj][0], v1 = acc[ai][bj][m][1] * rstd + bv[bj][1];
                        u32x4 w; w.x = cvt_pk_bf16(v0[0], v0[1]); w.y = cvt_pk_bf16(v0[2], v0[3]); w.z = cvt_pk_bf16(v1[0], v1[1]); w.w = cvt_pk_bf16(v1[2], v1[3]);
                        *(u32x4*)(base + (size_t)row * ld + cofs + lc + bj * HALF) = w;
                    }
                } else if (wc == 0) {
                    float* gp = (float*)(ws + WS_GATE) + (size_t)row * 32 + lc;
                    *(f32x4*)gp = acc[ai][0][m][0] * rstd + bv[0][0]; *(f32x4*)(gp + 4) = acc[ai][0][m][1] * rstd + bv[0][1];
                }
            }
    }
};
struct EpiFF1 {
    static constexpr bool PERM = true;
    const float* sumsq; const float* shw; bf16_t* hid;
    MDEV void operator()(const f32x4 (&acc)[2][2][4][2], const Unit& u, int wr, int wc, int fr, int fq) const {
        const int c0 = u.pn * BM + wc * 32 + 8 * fq;
        const int r0 = u.pm * BM + wr * 64 + fr;
        const int b9t = mod_of_row(u.pm * BM); const bool uni = b9t == mod_of_row(u.pm * BM + BM - 1);
        float ssv[2][4];
#pragma unroll
        for (int ai = 0; ai < 2; ++ai)
#pragma unroll
            for (int m = 0; m < 4; ++m) ssv[ai][m] = sumsq[r0 + ai * HALF + m * 16];
        f32x4 bv[2][2];
        { const float* sh = shw + (size_t)b9t * FF + c0;
#pragma unroll
          for (int bj = 0; bj < 2; ++bj) { bv[bj][0] = *(const f32x4*)(sh + bj * HALF); bv[bj][1] = *(const f32x4*)(sh + bj * HALF + 4); } }
#pragma unroll
        for (int ai = 0; ai < 2; ++ai)
#pragma unroll
            for (int m = 0; m < 4; ++m) {
                const int row = r0 + ai * HALF + m * 16;
                const float rstd = frsq(ssv[ai][m] * (1.0f / D) + EPSN);
                if (!uni) { const float* sh = shw + (size_t)mod_of_row(row) * FF + c0;
#pragma unroll
                    for (int bj = 0; bj < 2; ++bj) { bv[bj][0] = *(const f32x4*)(sh + bj * HALF); bv[bj][1] = *(const f32x4*)(sh + bj * HALF + 4); } }
#pragma unroll
                for (int bj = 0; bj < 2; ++bj) {
                    f32x4 v0 = acc[ai][bj][m][0] * rstd + bv[bj][0], v1 = acc[ai][bj][m][1] * rstd + bv[bj][1];
#pragma unroll
                    for (int e = 0; e < 4; ++e) { const float a = fmaxf(v0[e], 0.f), b = fmaxf(v1[e], 0.f); v0[e] = a * a; v1[e] = b * b; }
                    u32x4 w; w.x = cvt_pk_bf16(v0[0], v0[1]); w.y = cvt_pk_bf16(v0[2], v0[3]); w.z = cvt_pk_bf16(v1[0], v1[1]); w.w = cvt_pk_bf16(v1[2], v1[3]);
                    *(u32x4*)(hid + (size_t)row * FF + c0 + bj * HALF) = w;
                }
            }
    }
};
struct EpiRes {
    static constexpr bool PERM = false;
    const float* res_lat; const float* res_ctx;
    float* out_lat; float* out_ctx;
    const float* gt;
    const float* gsn;
    bf16_t* anext; float* ssn;
    MDEV void operator()(const f32x4 (&acc)[2][2][4][2], const Unit& u, int wr, int wc, int fr, int fq) const {
        const int c0 = u.pn * BM + wc * 32 + 4 * fq;
        float part[2][4];
        const int b9t = mod_of_row(u.pm * BM); const bool uni = b9t == mod_of_row(u.pm * BM + BM - 1);
        f32x4 gtv[2][2], gsv[2][2];
#pragma unroll
        for (int bj = 0; bj < 2; ++bj)
#pragma unroll
            for (int n = 0; n < 2; ++n) { const int col = c0 + bj * HALF + n * 16;
                gtv[bj][n] = *(const f32x4*)(gt + (size_t)b9t * 6 * D + col); gsv[bj][n] = gsn ? *(const f32x4*)(gsn + (size_t)b9t * D + col) : (f32x4){0.f, 0.f, 0.f, 0.f}; }
#pragma unroll
        for (int aim = 0; aim < 4; ++aim) {
            const int ai = aim >> 1;
            f32x4 rv[2][2][2];
#pragma unroll
            for (int m2 = 0; m2 < 2; ++m2) { const int m = 2 * (aim & 1) + m2; const int row = u.pm * BM + ai * HALF + wr * 64 + m * 16 + fr;
                const float* rp = row < RL ? res_lat + (size_t)row * D : res_ctx + (size_t)(row - RL) * D;
#pragma unroll
                for (int bj = 0; bj < 2; ++bj)
#pragma unroll
                    for (int n = 0; n < 2; ++n) rv[m2][bj][n] = *(const f32x4*)(rp + c0 + bj * HALF + n * 16); }
#pragma unroll
            for (int m2 = 0; m2 < 2; ++m2) {
                const int m = 2 * (aim & 1) + m2;
                const int row = u.pm * BM + ai * HALF + wr * 64 + m * 16 + fr;
                float* op = row < RL ? out_lat + (size_t)row * D : out_ctx + (size_t)(row - RL) * D;
                if (!uni) { const int b9 = mod_of_row(row);
#pragma unroll
                    for (int bj = 0; bj < 2; ++bj)
#pragma unroll
                        for (int n = 0; n < 2; ++n) { const int col = c0 + bj * HALF + n * 16;
                            gtv[bj][n] = *(const f32x4*)(gt + (size_t)b9 * 6 * D + col); if (gsn) gsv[bj][n] = *(const f32x4*)(gsn + (size_t)b9 * D + col); } }
                float s = 0.f;
#pragma unroll
                for (int bj = 0; bj < 2; ++bj)
#pragma unroll
                    for (int n = 0; n < 2; ++n) {
                        const int col = c0 + bj * HALF + n * 16;
                        const f32x4 xn = rv[m2][bj][n] + gtv[bj][n] * acc[ai][bj][m][n];
                        *(f32x4*)(op + col) = xn;
                        s += (xn[0] * xn[0] + xn[1] * xn[1]) + (xn[2] * xn[2] + xn[3] * xn[3]);
                        if (gsn) { const f32x4 gs = gsv[bj][n]; u32x2 w; w.x = cvt_pk_bf16(xn[0] * gs[0], xn[1] * gs[1]); w.y = cvt_pk_bf16(xn[2] * gs[2], xn[3] * gs[3]);
                            *(u32x2*)(anext + (size_t)row * D + col) = w; }
                    }
                part[ai][m] = s;
            }
        }
        if (ssn) {
#pragma unroll
            for (int ai = 0; ai < 2; ++ai) {
                float v[4];
#pragma unroll
                for (int m = 0; m < 4; ++m) { float s = part[ai][m]; s += wshfl_xor(s, 16); s += wshfl_xor(s, 32); v[m] = s; }
                const float mine = fq == 0 ? v[0] : fq == 1 ? v[1] : fq == 2 ? v[2] : v[3];
                atomic_addf(ssn + u.pm * BM + ai * HALF + wr * 64 + fq * 16 + fr, mine);
            }
        }
    }
};
}

DEV int swz256(int row, int chunk16) { return row * 256 + (((chunk16) ^ (row & 15)) << 4); }
DEV bf16_t* gdn_qkvn_row(unsigned char* ws, int row) {
    return row < RL ? (bf16_t*)(ws + T_PGDN) + (size_t)row * 1536 : (bf16_t*)(ws + WS_QKVNC) + (size_t)(row - RL) * 1536;
}
#ifndef EMU
DEV unsigned row_ror1(unsigned v) { return (unsigned)__builtin_amdgcn_update_dpp(0, (int)v, 0x121, 0xf, 0xf, false); }
DEV unsigned row_ror15(unsigned v) { return (unsigned)__builtin_amdgcn_update_dpp(0, (int)v, 0x12f, 0xf, 0xf, false); }
#else
DEV unsigned row_ror1(unsigned v) { const int l = threadIdx.x & 63; return __builtin_bit_cast(unsigned, emu_shfl(__builtin_bit_cast(float, v), (l & ~15) | ((l - 1) & 15))); }
DEV unsigned row_ror15(unsigned v) { const int l = threadIdx.x & 63; return __builtin_bit_cast(unsigned, emu_shfl(__builtin_bit_cast(float, v), (l & ~15) | ((l + 1) & 15))); }
#endif
DEV u32x4 ror1x4(const u32x4 v) { const unsigned a = v.x, b = v.y, c = v.z, d = v.w; u32x4 r; r.x = row_ror1(a); r.y = row_ror1(b); r.z = row_ror1(c); r.w = row_ror1(d); return r; }
DEV u32x4 ror15x4(const u32x4 v) { const unsigned a = v.x, b = v.y, c = v.z, d = v.w; u32x4 r; r.x = row_ror15(a); r.y = row_ror15(b); r.z = row_ror15(c); r.w = row_ror15(d); return r; }
DEV u32x4 shfl4(const u32x4 v, int src) {
    const unsigned a = v.x, b = v.y, c = v.z, d = v.w;
    u32x4 r;
    r.x = __builtin_bit_cast(unsigned, wshfl(__builtin_bit_cast(float, a), src));
    r.y = __builtin_bit_cast(unsigned, wshfl(__builtin_bit_cast(float, b), src));
    r.z = __builtin_bit_cast(unsigned, wshfl(__builtin_bit_cast(float, c), src));
    r.w = __builtin_bit_cast(unsigned, wshfl(__builtin_bit_cast(float, d), src));
    return r;
}
DEV void gdn_conv_unit(const Params& P, const LAS float* cwl, int l, int gc, int h, int part, int lane) {
    const int fr = lane & 15, fq = lane >> 4;
    const int row0 = gc * 64; const bool is_ctx = row0 >= RL;
    const bf16_t* raw = (const bf16_t*)(P.ws + T_PGDN) + part * 512 + h * 128 + 8 * fq;
    u32x4 c0[4][4], hp[4], hn[4];
#pragma unroll
    for (int it = 0; it < 4; ++it)
#pragma unroll
        for (int s4 = 0; s4 < 4; ++s4) c0[it][s4] = *(const u32x4*)(raw + (size_t)(row0 + 16 * it + fr) * 1536 + 32 * s4);
    { bool hasp = false, hasn = false;
      if (is_ctx) { const int pos0 = (row0 - RL) % CTX; hasp = pos0 > 0; hasn = pos0 + 64 < CTX; }
      const unsigned mp = hasp ? 0xffffffffu : 0u, mn = hasn ? 0xffffffffu : 0u;
      const bf16_t* rp = raw + (size_t)(hasp ? row0 - 1 : row0) * 1536; const bf16_t* rn = raw + (size_t)(hasn ? row0 + 64 : row0) * 1536;
#pragma unroll
      for (int s4 = 0; s4 < 4; ++s4) { hp[s4] = *(const u32x4*)(rp + 32 * s4) & mp; hn[s4] = *(const u32x4*)(rn + 32 * s4) & mn; } }
    const LAS float* cwp = cwl + part * 512 + h * 128 + 8 * fq;
#pragma unroll
    for (int it = 0; it < 4; ++it) {
        float y[4][8]; float ssq = 0.f;
#pragma unroll
        for (int s4 = 0; s4 < 4; ++s4) {
            const u32x4 up = ror1x4(c0[it][s4]), dn = ror15x4(c0[it][s4]);
            u32x4 upb, dnb;
            if (it > 0) upb = ror1x4(c0[it > 0 ? it - 1 : 0][s4]); else upb = hp[s4];
            if (it < 3) dnb = ror15x4(c0[it < 3 ? it + 1 : 3][s4]); else dnb = hn[s4];
            const u32x4 cm = fr > 0 ? up : upb, cp = fr < 15 ? dn : dnb, cc = c0[it][s4];
            const LAS float* cw = cwp + 32 * s4;
            f32x4 w0[2], w1[2], w2[2];
#pragma unroll
            for (int e = 0; e < 2; ++e) { w0[e] = *(const LAS f32x4*)(cw + 4 * e); w1[e] = *(const LAS f32x4*)(cw + 1536 + 4 * e); w2[e] = *(const LAS f32x4*)(cw + 3072 + 4 * e); }
#pragma unroll
            for (int j = 0; j < 4; ++j) {
                const int e = j >> 1, o = (j & 1) * 2;
                const float a = w0[e][o] * bflo(cm[j]) + w1[e][o] * bflo(cc[j]) + w2[e][o] * bflo(cp[j]);
                const float b = w0[e][o + 1] * bfhi(cm[j]) + w1[e][o + 1] * bfhi(cc[j]) + w2[e][o + 1] * bfhi(cp[j]);
                const float sa = silu_f(a), sb = silu_f(b);
                y[s4][2 * j] = sa; y[s4][2 * j + 1] = sb; ssq += sa * sa + sb * sb;
            }
        }
        float scale = 1.f;
        if (part < 2) { ssq += wshfl_xor(ssq, 16); ssq += wshfl_xor(ssq, 32); scale = 1.0f / sqrtf(ssq + EPSN); if (part == 0) scale *= 0.08838834764831845f; }
        bf16_t* orow = gdn_qkvn_row(P.ws, row0 + 16 * it + fr) + part * 512 + h * 128 + 8 * fq;
#pragma unroll
        for (int s4 = 0; s4 < 4; ++s4) { u32x4 w;
#pragma unroll
            for (int j = 0; j < 4; ++j) w[j] = pk2(y[s4][2 * j] * scale, y[s4][2 * j + 1] * scale);
            *(u32x4*)(orow + 32 * s4) = w; }
        SCHED_FENCE();
    }
}
DEV void gdn_mat_unit(const Params& P, LAS unsigned char* slot, LAS float* gb, int l, int gc, int h, int dir, int lane) {
    const int fr = lane & 15, fq = lane >> 4;
    const int row0 = gc * 64;
    unsigned char* item = P.ws + T_TAQK + (size_t)((gc * 4 + h) * 2 + dir) * TAQK_ITEM;
    bf16x8 Qf[4][4], Kf[4][4];
    { const bf16_t* qn0 = gdn_qkvn_row(P.ws, row0 + fr) + h * 128 + 8 * fq;
#pragma unroll
      for (int it = 0; it < 4; ++it)
#pragma unroll
        for (int s4 = 0; s4 < 4; ++s4) { Qf[it][s4] = *(const bf16x8*)(qn0 + (size_t)it * 16 * 1536 + 32 * s4); Kf[it][s4] = *(const bf16x8*)(qn0 + 512 + (size_t)it * 16 * 1536 + 32 * s4); } }
    { const int tok = dir ? 63 - lane : lane;
      const float* gr = (const float*)(P.ws + WS_GATE) + (size_t)(row0 + tok) * 32;
      const float av = gr[16 + dir * 4 + h], bbv = gr[24 + dir * 4 + h];
      const float la = -fexp(P.gdn_a_log[(l * 2 + dir) * 4 + h]) * softplus_f(av + P.gdn_dt_bias[(l * 2 + dir) * 4 + h]);
      const float beta = sigmoid_f(bbv);
      float g = la;
#pragma unroll
      for (int o = 1; o < 64; o <<= 1) { const float t = wshfl_up(g, o); if (lane >= o) g += t; }
      const float gl = wshfl(g, 63);
      gb[tok] = g; gb[64 + tok] = beta;
      float* sc = (float*)(item + 16384);
      sc[tok] = fexp(g); sc[64 + tok] = fexp(gl - g); sc[128 + tok] = beta; sc[192 + tok] = fexp(gl); }
    wave_sync();
    float gi[4][4], bi[4][4], gjv[4];
#pragma unroll
    for (int it = 0; it < 4; ++it) { const f32x4 gv = *(const LAS f32x4*)(gb + 16 * it + 4 * fq), bv = *(const LAS f32x4*)(gb + 64 + 16 * it + 4 * fq);
#pragma unroll
        for (int r = 0; r < 4; ++r) { gi[it][r] = gv[r]; bi[it][r] = bv[r]; } }
#pragma unroll
    for (int jt = 0; jt < 4; ++jt) gjv[jt] = gb[16 * jt + fr];
#pragma unroll
    for (int it = 0; it < 4; ++it)
#pragma unroll
        for (int jt = 0; jt < 4; ++jt) {
            f32x4 c = {0.f, 0.f, 0.f, 0.f};
            if (dir ? jt >= it : jt <= it) {
#pragma unroll
            for (int s4 = 0; s4 < 4; ++s4) c = mfma16(Qf[it][s4], Kf[jt][s4], c);
            }
            const int j = 16 * jt + fr; const float gj = gjv[jt];
#pragma unroll
            for (int r = 0; r < 4; ++r) { const int i = 16 * it + 4 * fq + r; const bool keep = dir ? j >= i : j <= i;
                const float v = c[r] * fexp(fminf(gi[it][r] - gj, 0.f)) * (keep ? 1.f : 0.f);
                *(LAS bf16_t*)(slot + (i * 64 + j) * 2) = (bf16_t)f2bf(v); }
        }
    wave_sync();
#pragma unroll 1
    for (int q = 0; q < 8; ++q) { const int off = (lane + 64 * q) * 16; *(u32x4*)(item + 8192 + off) = *(const LAS u32x4*)(slot + off); }
    wave_sync();
    LAS float* W = (LAS float*)slot;
#pragma unroll
    for (int it = 0; it < 4; ++it)
#pragma unroll
        for (int jt = 0; jt < 4; ++jt) {
            f32x4 c = {0.f, 0.f, 0.f, 0.f};
            if (dir ? jt >= it : jt <= it) {
#pragma unroll
            for (int s4 = 0; s4 < 4; ++s4) c = mfma16(Kf[it][s4], Kf[jt][s4], c);
            }
            const int j = 16 * jt + fr, jp = dir ? 63 - j : j; const float gj = gjv[jt];
#pragma unroll
            for (int r = 0; r < 4; ++r) { const int i = 16 * it + 4 * fq + r, ip = dir ? 63 - i : i;
                W[jp * 64 + ip] = bi[it][r] * c[r] * fexp(fminf(gi[it][r] - gj, 0.f)) * (jp < ip ? 1.f : 0.f); }
        }
    wave_sync();
    const int nj = dir ? 63 - lane : lane;
#pragma unroll
    for (int bk = 0; bk < 4; ++bk) {
        if (bk > 0) {
#pragma unroll
            for (int nt = 0; nt < bk; ++nt) {
                f32x4 acc = {0.f, 0.f, 0.f, 0.f};
#pragma unroll
                for (int m0 = 16 * nt; m0 < 16 * bk; m0 += 4) {
                    const int m = m0 + fq;
                    const float av = W[m * 64 + 16 * bk + fr];
                    const float xv = W[m * 64 + 16 * nt + fr];
                    const float bvv = (16 * nt + fr <= m) ? xv : 0.f;
                    acc = mfma4f32(av, bvv, acc);
                }
                wave_sync();
#pragma unroll
                for (int r = 0; r < 4; ++r) W[(16 * bk + 4 * fq + r) * 64 + 16 * nt + fr] = acc[r];
            }
            wave_sync();
        }
        float v[16];
#pragma unroll
        for (int r = 0; r < 16; ++r) { const float a = (bk > 0 && lane < 16 * bk) ? W[(16 * bk + r) * 64 + lane] : 0.f; v[r] = ((16 * bk + r == lane) ? 1.f : 0.f) - a; }
#pragma unroll
        for (int rp = 0; rp < 15; ++rp) {
            const float xp = v[rp];
            const LAS float* lrow = W + (16 * bk + rp) * 64 + 16 * bk;
#pragma unroll
            for (int q4 = (rp + 1) / 4; q4 < 4; ++q4) { const f32x4 lv = *(const LAS f32x4*)(lrow + 4 * q4);
#pragma unroll
                for (int e = 0; e < 4; ++e) if (4 * q4 + e > rp) v[4 * q4 + e] -= lv[e] * xp; }
        }
        wave_sync();
#pragma unroll
        for (int r = 0; r < 16; ++r) if (lane <= 16 * bk + r) W[(16 * bk + r) * 64 + lane] = v[r];
        wave_sync();
    }
    float x[64];
#pragma unroll
    for (int i = 0; i < 64; ++i) x[i] = lane <= i ? W[i * 64 + lane] : 0.f;
    wave_sync();
#pragma unroll
    for (int i = 0; i < 64; ++i) { const int ni = dir ? 63 - i : i; *(LAS bf16_t*)(slot + (ni * 64 + nj) * 2) = (bf16_t)f2bf(x[i]); }
    wave_sync();
#pragma unroll 1
    for (int q = 0; q < 8; ++q) { const int off = (lane + 64 * q) * 16; *(u32x4*)(item + off) = *(const LAS u32x4*)(slot + off); }
    wave_sync();
}
constexpr int PREP_CW = 0, PREP_SLOT0 = 18432, PREP_SLOT_STRIDE = 17408;
constexpr size_t CTL_QUEUE_OFS = 20480;
DEV int queue_pull(const Params& P, int inst, int vb, int first, int total, int lane) {
    unsigned* head = (unsigned*)(P.ws + WS_CTL + CTL_QUEUE_OFS + (size_t)(inst * 8 + (vb & 7)) * 256);
    unsigned k = 0;
#ifndef EMU
    if (lane == 0) k = __hip_atomic_fetch_add(head, 1u, __ATOMIC_RELAXED, __HIP_MEMORY_SCOPE_AGENT);
    k = (unsigned)__builtin_amdgcn_readfirstlane((int)k);
#else
    if (lane == 0) k = __atomic_fetch_add(head, 1u, __ATOMIC_SEQ_CST);
    k = __builtin_bit_cast(unsigned, wshfl(__builtin_bit_cast(float, k), 0));
#endif
    const long u = (long)first + (vb & 7) + 8l * k;
    return u < total ? (int)u : -1;
}
DEV void phase_prep_a(const Params& P, LAS unsigned char* lds, int l, int vb, int nvb) {
    const int tid = tidx(), wave = uniform_i(tid >> 6), lane = tid & 63;
    LAS float* cwl = (LAS float*)(lds + PREP_CW);
    { float tmp[9];
#pragma unroll
      for (int u = 0; u < 9; ++u) tmp[u] = P.gdn_conv_w[(size_t)l * 3 * 1536 + tid + u * NT];
#pragma unroll
      for (int u = 0; u < 9; ++u) cwl[tid + u * NT] = tmp[u]; }
    block_sync();
#pragma unroll 1
    for (int it = vb * NWAVE + wave; it >= 0 && it < NCH * 12; it = queue_pull(P, 2 * l, vb, nvb * NWAVE, NCH * 12, lane)) { const int part = it % 3, gh = it / 3; gdn_conv_unit(P, cwl, l, gh >> 2, gh & 3, part, opaque_i(lane)); }
    block_sync();
    if (l == 1) convert_weights(P, lds, vb, nvb, 1);
}
DEV void phase_prep_b(const Params& P, LAS unsigned char* lds, int l, int vb, int nvb) {
    const int tid = tidx(), wave = uniform_i(tid >> 6), lane = tid & 63;
    LAS unsigned char* slot = lds + wave * PREP_SLOT_STRIDE;
#pragma unroll 1
    for (int it = vb * NWAVE + wave; it >= 0 && it < NCH * 8; it = queue_pull(P, 2 * l + 1, vb, nvb * NWAVE, NCH * 8, lane)) gdn_mat_unit(P, slot, (LAS float*)(slot + 16384), l, it >> 3, (it >> 1) & 3, it & 1, opaque_i(lane));
    block_sync();
}

DEV int swz128(int row, int chunk16) { return row * 128 + (((chunk16) ^ ((row >> 1) & 7)) << 4); }
DEV bf16x8 pack_bf8(const f32x4& a, const f32x4& b) {
    u32x4 w; w.x = pk2(a[0], a[1]); w.y = pk2(a[2], a[3]); w.z = pk2(b[0], b[1]); w.w = pk2(b[2], b[3]); return __builtin_bit_cast(bf16x8, w);
}
DEV bf16x8 join_s4(const s16x4& a, const s16x4& b) { return (bf16x8){a[0], a[1], a[2], a[3], b[0], b[1], b[2], b[3]}; }
DEV bf16x8 afrag_pi256(const LAS unsigned char* tile, int row, int s, int fq) {
    const u32x2 lo = *(const LAS u32x2*)(tile + swz256(row, 4 * s + (fq >> 1)) + (fq & 1) * 8);
    const u32x2 hi = *(const LAS u32x2*)(tile + swz256(row, 4 * s + 2 + (fq >> 1)) + (fq & 1) * 8);
    return __builtin_bit_cast(bf16x8, (u32x4){lo.x, lo.y, hi.x, hi.y});
}
DEV bf16x8 afrag_pi128(const LAS unsigned char* tile, int row, int s, int fq) {
    const u32x2 lo = *(const LAS u32x2*)(tile + swz128(row, 4 * s + (fq >> 1)) + (fq & 1) * 8);
    const u32x2 hi = *(const LAS u32x2*)(tile + swz128(row, 4 * s + 2 + (fq >> 1)) + (fq & 1) * 8);
    return __builtin_bit_cast(bf16x8, (u32x4){lo.x, lo.y, hi.x, hi.y});
}
constexpr int GDN_ITEMS = NB * 16, GLA_ITEMS = NB * 8;
constexpr int GB_K = 0, GB_Q = 16384, GB_T = 32768, GB_AQ = 40960, GB_V = 49152, GB_SC = 57344, GB_SIZE = 58368;

DEV void gdn_chunk_of_step(int b, int dir, int s, int& gc) {
    if (s < NCC) { const int c = dir ? NCC - 1 - s : s; gc = RL / 64 + b * NCC + c; }
    else { const int c2 = s - NCC; const int c = dir ? NCL - 1 - c2 : c2; gc = b * NCL + c; }
}
DEV void gdn_issue_loads(const Params& P, LAS unsigned char* buf, int lw, int lane, int gc, int h, int dir, int dvh);
DEV void gdn_issue_loads(const Params& P, LAS unsigned char* buf, int lw, int lane, int gc, int h, int dir, int dvh) {
    const int row0 = gc * 64;
    const unsigned char* item = P.ws + T_TAQK + (size_t)((gc * 4 + h) * 2 + dir) * TAQK_ITEM;
#pragma unroll
    for (int jj = 0; jj < 4; ++jj) { const int j = 4 * jj + lw, r = 4 * j + (lane >> 4), ch = (lane & 15) ^ (r & 15);
        const bf16_t* rp = gdn_qkvn_row(P.ws, row0 + r) + h * 128 + ch * 8;
        pg8::glds16(rp, buf + GB_Q + 1024 * j); pg8::glds16(rp + 512, buf + GB_K + 1024 * j); }
#pragma unroll
    for (int jj = 0; jj < 2; ++jj) { const int j = 4 * jj + lw, r = 8 * j + (lane >> 3), pos = lane & 7, ch = pos ^ ((r >> 1) & 7);
        pg8::glds16(item + (r * 64 + ch * 8) * 2, buf + GB_T + 1024 * j); pg8::glds16(item + 8192 + (r * 64 + ch * 8) * 2, buf + GB_AQ + 1024 * j);
        pg8::glds16(gdn_qkvn_row(P.ws, row0 + r) + 1024 + h * 128 + dvh * 64 + pos * 8, buf + GB_V + 1024 * j); }
    if (lw == 0) pg8::glds16(item + 16384 + lane * 16, buf + GB_SC);
}
DEV void gdn_scan_item(const Params& P, LAS unsigned char* lds, int item, bool ctx_out) {
    const int tid = tidx(), wave = uniform_i(tid >> 6), lane0 = tid & 63;
    const int b = item % NB, rest = item / NB, h = rest >> 2, dir = (rest >> 1) & 1, dvh = rest & 1;
    constexpr int NS = NCC + NCL;
    const bool loader = wave >= 4; const int lw = wave - 4;
    int gc;
    if (loader) { gdn_chunk_of_step(b, dir, 0, gc); gdn_issue_loads(P, lds, lw, lane0, gc, h, dir, dvh); }
    f32x4 S[8];
#pragma unroll
    for (int i = 0; i < 8; ++i) S[i] = (f32x4){0.f, 0.f, 0.f, 0.f};
    if (loader) VM_DRAIN();
    RAW_BAR();
    for (int s = 0; s < NS; ++s) {
        LAS unsigned char* buf = lds + (s & 1) * GB_SIZE;
        if (loader) {
            if (s + 1 < NS) { gdn_chunk_of_step(b, dir, s + 1, gc); gdn_issue_loads(P, lds + ((s + 1) & 1) * GB_SIZE, lw, opaque_i(lane0), gc, h, dir, dvh); }
        } else {
            gdn_chunk_of_step(b, dir, s, gc);
            const int row0 = gc * 64, n0 = 16 * wave;
            const int lane = opaque_i(lane0), fr = lane & 15, fq = lane >> 4;
            const LAS float* SC = (const LAS float*)(buf + GB_SC);
            bf16x8 Sb[4];
#pragma unroll
            for (int k = 0; k < 4; ++k) Sb[k] = pack_bf8(S[2 * k], S[2 * k + 1]);
            f32x4 rr[4];
            { bf16x8 Af[4][4];
#pragma unroll
              for (int mt = 0; mt < 4; ++mt)
#pragma unroll
                for (int k = 0; k < 4; ++k) Af[mt][k] = afrag_pi256(buf + GB_K, 16 * mt + fr, k, fq);
              f32x4 acc[4];
#pragma unroll
              for (int mt = 0; mt < 4; ++mt) acc[mt] = (f32x4){0.f, 0.f, 0.f, 0.f};
#pragma unroll
              for (int k = 0; k < 4; ++k)
#pragma unroll
                for (int mt = 0; mt < 4; ++mt) acc[mt] = mfma16(Af[mt][k], Sb[k], acc[mt]);
#pragma unroll
              for (int mt = 0; mt < 4; ++mt) {
                const f32x4 eg = *(const LAS f32x4*)(SC + 16 * mt + 4 * fq), be = *(const LAS f32x4*)(SC + 128 + 16 * mt + 4 * fq);
#pragma unroll
                for (int j = 0; j < 4; ++j) { const float v = bf2f(*(const LAS bf16_t*)(buf + GB_V + (16 * mt + 4 * fq + j) * 128 + (n0 + fr) * 2)); rr[mt][j] = be[j] * (v - eg[j] * acc[mt][j]); }
              } }
            SCHED_FENCE();
            bf16x8 Rb[2] = {pack_bf8(rr[0], rr[1]), pack_bf8(rr[2], rr[3])};
            f32x4 dl[4];
            { bf16x8 Tf[4][2];
#pragma unroll
              for (int it = 0; it < 4; ++it)
#pragma unroll
                for (int k = 0; k < 2; ++k) Tf[it][k] = afrag_pi128(buf + GB_T, 16 * it + fr, k, fq);
#pragma unroll
              for (int it = 0; it < 4; ++it) dl[it] = (f32x4){0.f, 0.f, 0.f, 0.f};
#pragma unroll
              for (int k = 0; k < 2; ++k)
#pragma unroll
                for (int it = 0; it < 4; ++it) dl[it] = mfma16(Tf[it][k], Rb[k], dl[it]); }
            SCHED_FENCE();
            bf16x8 Db[2] = {pack_bf8(dl[0], dl[1]), pack_bf8(dl[2], dl[3])};
            { f32x4 ds[4];
#pragma unroll
              for (int mt = 0; mt < 4; ++mt) { const f32x4 el = *(const LAS f32x4*)(SC + 64 + 16 * mt + 4 * fq); ds[mt] = dl[mt] * el; }
              bf16x8 Dp[2] = {pack_bf8(ds[0], ds[1]), pack_bf8(ds[2], ds[3])};
              const float ach = SC[192];
#pragma unroll
              for (int dkt = 0; dkt < 8; ++dkt) S[dkt] = S[dkt] * ach;
#pragma unroll
              for (int hf = 0; hf < 2; ++hf) {
                  bf16x8 Kt[4][2];
#pragma unroll
                  for (int d4 = 0; d4 < 4; ++d4)
#pragma unroll
                    for (int k = 0; k < 2; ++k) {
                        const int dkt = 4 * hf + d4;
                        const int row = 32 * k + 4 * fq + ((lane >> 2) & 3), ch = 2 * dkt + ((lane & 3) >> 1), off = (lane & 1) * 8;
                        Kt[d4][k] = join_s4(lds_tr16(buf + GB_K + swz256(row, ch) + off), lds_tr16(buf + GB_K + swz256(row + 16, ch) + off));
                    }
#pragma unroll
                  for (int k = 0; k < 2; ++k)
#pragma unroll
                    for (int d4 = 0; d4 < 4; ++d4) S[4 * hf + d4] = mfma16(Kt[d4][k], Dp[k], S[4 * hf + d4]);
                  SCHED_FENCE();
              } }
            SCHED_FENCE();
            const bool want_o = ctx_out || row0 < RL;
            if (want_o) {
                LAS unsigned char* ost = lds + 2 * GB_SIZE + wave * 2048;
                f32x4 oa[4];
                { bf16x8 Qf[4][4];
#pragma unroll
                  for (int it = 0; it < 4; ++it)
#pragma unroll
                    for (int k = 0; k < 4; ++k) Qf[it][k] = afrag_pi256(buf + GB_Q, 16 * it + fr, k, fq);
#pragma unroll
                  for (int it = 0; it < 4; ++it) oa[it] = (f32x4){0.f, 0.f, 0.f, 0.f};
#pragma unroll
                  for (int k = 0; k < 4; ++k)
#pragma unroll
                    for (int it = 0; it < 4; ++it) oa[it] = mfma16(Qf[it][k], Sb[k], oa[it]); }
                SCHED_FENCE();
                { bf16x8 Gf[4][2];
#pragma unroll
                  for (int it = 0; it < 4; ++it)
#pragma unroll
                    for (int k = 0; k < 2; ++k) Gf[it][k] = afrag_pi128(buf + GB_AQ, 16 * it + fr, k, fq);
#pragma unroll
                  for (int it = 0; it < 4; ++it) oa[it] = oa[it] * *(const LAS f32x4*)(SC + 16 * it + 4 * fq);
#pragma unroll
                  for (int k = 0; k < 2; ++k)
#pragma unroll
                    for (int it = 0; it < 4; ++it) oa[it] = mfma16(Gf[it][k], Db[k], oa[it]); }
#pragma unroll
                for (int it = 0; it < 4; ++it)
#pragma unroll
                    for (int j = 0; j < 4; ++j) *(LAS bf16_t*)(ost + (16 * it + 4 * fq + j) * 32 + fr * 2) = (bf16_t)f2bf(oa[it][j]);
                wave_sync();
                bf16_t* og = (bf16_t*)(P.ws + T_OGDN) + ((size_t)dir * ROWS + row0) * 512 + h * 128 + dvh * 64 + n0;
#pragma unroll
                for (int i = 0; i < 2; ++i) { const int c = lane + 64 * i, row = c >> 1, half = c & 1;
                    *(u32x4*)(og + (size_t)row * 512 + half * 8) = *(const LAS u32x4*)(ost + row * 32 + half * 16); }
            }
        }
        if (loader) VM_DRAIN(); else LGKM_DRAIN();
        RAW_BAR();
    }
    VM_DRAIN(); block_sync();
}

constexpr int GL_RAW = 0, GL_RA = 32768, GL_V = 40960, GL_QK = 73728, GL_P = 106496, GL_VEC = 114688, GL_OST = 116736;
struct GlaDmaOff { unsigned qk[2], v[4], ra; };
DEV void gla_dma_offsets(GlaDmaOff& o, int pw, int lane) {
#pragma unroll
    for (int jj = 0; jj < 2; ++jj) { const int j = 4 * jj + pw, r = 8 * j + (lane >> 3), ch = (lane & 7) ^ ((r >> 1) & 7); o.qk[jj] = (unsigned)(r * 512 + ch * 8) * 2u; }
#pragma unroll
    for (int jj = 0; jj < 4; ++jj) { const int j = 4 * jj + pw, r = 4 * j + (lane >> 4), ch = (lane & 15) ^ (r & 15); o.v[jj] = (unsigned)(r * 512 + ch * 8) * 2u; }
    { const int idx = pw * 64 + lane, r = idx >> 2, c4 = idx & 3; o.ra = (unsigned)(r * 32 + c4 * 4) * 4u; }
}
DEV void gla_issue_raw(const Params& P, LAS unsigned char* lds, int slot, int pw, const GlaDmaOff& o, int gc, int h) {
    const size_t row0 = (size_t)gc * 64;
    const unsigned char* qk = P.ws + T_PGLAQK + (row0 * 512 + h * 64) * 2;
    LAS unsigned char* dst = lds + GL_RAW + slot * 16384;
#pragma unroll
    for (int jj = 0; jj < 2; ++jj) { const int j = 4 * jj + pw; pg8::glds16(qk + o.qk[jj], dst + 1024 * j); pg8::glds16(qk + 512 + o.qk[jj], dst + 8192 + 1024 * j); }
    pg8::glds16(P.ws + WS_GATE + row0 * 128 + o.ra, lds + GL_RA + slot * 4096 + 1024 * pw);
}
DEV void gla_issue_v(const Params& P, LAS unsigned char* lds, int slot, int pw, const GlaDmaOff& o, int gc, int h) {
    const unsigned char* vp = P.ws + T_PGLAV + ((size_t)gc * 64 * 512 + h * 128) * 2;
#pragma unroll
    for (int jj = 0; jj < 4; ++jj) { const int j = 4 * jj + pw; pg8::glds16(vp + o.v[jj], lds + GL_V + slot * 16384 + 1024 * j); }
}
template <bool BARB, int DIRC>
DEV void gla_alpha(LAS unsigned char* lds, int rslot, int oslot, int pw, int lane, const float (&wb)[4], float blr, const int (&offr)[4]) {
    constexpr int dir = DIRC, mtstep = DIRC ? -2048 : 2048;
    const int c = lane & 15, g = lane >> 4, dk = 16 * pw + c;
    const LAS float* RA = (const LAS float*)(lds + GL_RA + rslot * 4096);
    float bcs[4][4]; float toff = 0.f, bmid = 0.f;
    const int ra0 = (dir ? 63 - c : c) * 16 + g, rastep = dir ? -256 : 256;
#pragma unroll
    for (int mt = 0; mt < 4; ++mt) {
        f32x4 acc = {0.f, 0.f, 0.f, 0.f};
#pragma unroll
        for (int kk = 0; kk < 4; ++kk) acc = mfma4f32(RA[ra0 + mt * rastep + 4 * kk], wb[kk], acc);
        float run = 0.f;
#pragma unroll
        for (int r = 0; r < 4; ++r) { const float x = acc[r] + blr; run += (fminf(x, 0.f) - flog_raw(1.f + fexp_raw(-fabsf(x)))) * (1.0f / 16.0f); bcs[mt][r] = run; }
        const float t0 = wshfl(run, c), t1 = wshfl(run, c + 16), t2 = wshfl(run, c + 32), t3 = wshfl(run, c + 48);
        const float goff = (g > 0 ? t0 : 0.f) + (g > 1 ? t1 : 0.f) + (g > 2 ? t2 : 0.f);
#pragma unroll
        for (int r = 0; r < 4; ++r) bcs[mt][r] += toff + goff;
        toff += (t0 + t1) + (t2 + t3);
        if (mt == 1) bmid = toff;
    }
    const float blast = toff;
    if (BARB) { LGKM_DRAIN(); PROF_B(10); RAW_BAR(); PROF_E(10); }
    const LAS unsigned char* rq = lds + GL_RAW + rslot * 16384; LAS unsigned char* oq = lds + GL_QK + oslot * 16384;
    bf16_t qr[4][4], kr[4][4];
#pragma unroll
    for (int mt = 0; mt < 4; ++mt)
#pragma unroll
        for (int r = 0; r < 4; ++r) { const int off = offr[r] + mt * mtstep; qr[mt][r] = *(const LAS bf16_t*)(rq + off); kr[mt][r] = *(const LAS bf16_t*)(rq + 8192 + off); }
#pragma unroll
    for (int mt = 0; mt < 4; ++mt)
#pragma unroll
        for (int r = 0; r < 4; ++r) { const float bb = bcs[mt][r];
            const int off = offr[r] + mt * mtstep;
            const float ef = fexp_raw(bb - bmid), eb = frcp(ef);
            const float qv = bf2f(qr[mt][r]) * 0.125f * ef, kv = bf2f(kr[mt][r]) * eb;
            const unsigned pr = pk2(qv, kv);
            *(LAS bf16_t*)(oq + off) = (bf16_t)(pr & 0xffffu); *(LAS bf16_t*)(oq + 8192 + off) = (bf16_t)(pr >> 16); }
    if (g == 0) { LAS float* VEC = (LAS float*)(lds + GL_VEC + oslot * 1024); VEC[dk] = fexp_raw(bmid); VEC[64 + dk] = fexp_raw(blast - bmid); VEC[128 + dk] = fexp_raw(blast); }
}
DEV void gla_scan_item(const Params& P, LAS unsigned char* lds, int l, int item, bool ctx_out) {
    const int tid = tidx(), wave = uniform_i(tid >> 6), lane0 = tid & 63;
    const int b = item % NB, rest = item / NB, h = rest >> 1, dir = rest & 1;
    constexpr int NS = NCC + NCL;
    const bool producer = wave >= 4; const int pw = wave - 4, cw = wave;
    int gc;
    if (producer) {
        float wl[4];
        { const int dk = 16 * pw + (lane0 & 15);
#pragma unroll
          for (int kk = 0; kk < 4; ++kk) wl[kk] = P.gla_w_lr[(((size_t)l * 2 + dir) * 16 + 4 * kk + (lane0 >> 4)) * 256 + h * 64 + dk]; }
        const float blr = P.gla_b_lr[((size_t)l * 2 + dir) * 256 + h * 64 + 16 * pw + (lane0 & 15)];
        int offr[4];
        { const int dk = 16 * pw + (lane0 & 15), g = lane0 >> 4;
#pragma unroll
          for (int r = 0; r < 4; ++r) { const int ip = 4 * g + r, tok = dir ? 63 - ip : ip; offr[r] = swz128(tok, dk >> 3) + (dk & 7) * 2; } }
        GlaDmaOff dmo; gla_dma_offsets(dmo, pw, lane0);
        gdn_chunk_of_step(b, dir, 0, gc); gla_issue_raw(P, lds, 0, pw, dmo, gc, h); gla_issue_v(P, lds, 0, pw, dmo, gc, h);
        if (NS > 1) { gdn_chunk_of_step(b, dir, 1, gc); gla_issue_raw(P, lds, 1, pw, dmo, gc, h); }
        VM_DRAIN(); RAW_BAR();
        if (dir) gla_alpha<false, 1>(lds, 0, 0, pw, lane0, wl, blr, offr); else gla_alpha<false, 0>(lds, 0, 0, pw, lane0, wl, blr, offr);
        LGKM_DRAIN(); RAW_BAR();
#pragma unroll 1
        for (int s = 0; s < NS; ++s) {
            const int lane = opaque_i(lane0);
            if (s + 2 < NS) { gdn_chunk_of_step(b, dir, s + 2, gc); gla_issue_raw(P, lds, s & 1, pw, dmo, gc, h); }
            if (s + 1 < NS) { gdn_chunk_of_step(b, dir, s + 1, gc); gla_issue_v(P, lds, (s + 1) & 1, pw, dmo, gc, h);
                if (dir) gla_alpha<true, 1>(lds, (s + 1) & 1, (s + 1) & 1, pw, lane, wl, blr, offr); else gla_alpha<true, 0>(lds, (s + 1) & 1, (s + 1) & 1, pw, lane, wl, blr, offr); }
            else { RAW_BAR(); }
            PROF_B(12); VM_DRAIN(); PROF_E(12); LGKM_DRAIN(); PROF_B(11); RAW_BAR(); PROF_E(11);
        }
    } else {
        f32x4 S[4][2];
#pragma unroll
        for (int i = 0; i < 4; ++i) { S[i][0] = (f32x4){0.f, 0.f, 0.f, 0.f}; S[i][1] = (f32x4){0.f, 0.f, 0.f, 0.f}; }
        RAW_BAR(); RAW_BAR();
#pragma unroll 1
        for (int s = 0; s < NS; ++s) {
            const int lane = opaque_i(lane0), fr = lane & 15, fq = lane >> 4;
            gdn_chunk_of_step(b, dir, s, gc); const int row0 = gc * 64;
            const LAS unsigned char* QT = lds + GL_QK + (s & 1) * 16384; const LAS unsigned char* KT = QT + 8192;
            const LAS unsigned char* VT = lds + GL_V + (s & 1) * 16384; const LAS float* VEC = (const LAS float*)(lds + GL_VEC + (s & 1) * 1024);
            { const int it = cw;
              bf16x8 qa[2] = {*(const LAS bf16x8*)(QT + swz128(16 * it + fr, fq)), *(const LAS bf16x8*)(QT + swz128(16 * it + fr, 4 + fq))};
              bf16x8 kb[4][2];
#pragma unroll
              for (int jt = 0; jt < 4; ++jt)
#pragma unroll
                  for (int k = 0; k < 2; ++k) kb[jt][k] = *(const LAS bf16x8*)(KT + swz128(16 * jt + fr, 4 * k + fq));
              f32x4 pa[4];
#pragma unroll
              for (int jt = 0; jt < 4; ++jt) { pa[jt] = (f32x4){0.f, 0.f, 0.f, 0.f};
#pragma unroll
                  for (int k = 0; k < 2; ++k) pa[jt] = mfma16(qa[k], kb[jt][k], pa[jt]); }
#pragma unroll
              for (int jt = 0; jt < 4; ++jt)
#pragma unroll
                  for (int r = 0; r < 4; ++r) { const int i = 16 * it + 4 * fq + r, j = 16 * jt + fr; const bool keep = dir ? j >= i : j <= i;
                      *(LAS bf16_t*)(lds + GL_P + swz128(i, j >> 3) + (j & 7) * 2) = (bf16_t)f2bf(keep ? pa[jt][r] : 0.f); }
            }
            LGKM_DRAIN(); PROF_B(20); RAW_BAR(); PROF_E(20);
            bf16x8 Vb[2][2], Sb[2][2];
#pragma unroll
            for (int nt = 0; nt < 2; ++nt)
#pragma unroll
                for (int k = 0; k < 2; ++k) { const int row = 32 * k + 8 * fq + ((lane >> 2) & 3), ch = 4 * cw + 2 * nt + ((lane & 3) >> 1), off = (lane & 1) * 8;
                    Vb[nt][k] = join_s4(lds_tr16(VT + swz256(row, ch) + off), lds_tr16(VT + swz256(row + 4, ch) + off)); }
#pragma unroll
            for (int nt = 0; nt < 2; ++nt)
#pragma unroll
                for (int k = 0; k < 2; ++k) { const f32x4 e0 = *(const LAS f32x4*)(VEC + 32 * k + 4 * fq), e1 = *(const LAS f32x4*)(VEC + 32 * k + 16 + 4 * fq);
                    Sb[nt][k] = pack_bf8(S[2 * k][nt] * e0, S[2 * k + 1][nt] * e1); }
            if (ctx_out || row0 < RL) {
                LAS unsigned char* ost = lds + GL_OST + cw * 4096;
                f32x4 oacc[4][2];
#pragma unroll
                for (int it = 0; it < 4; ++it) {
                    const bf16x8 pf0 = *(const LAS bf16x8*)(lds + GL_P + swz128(16 * it + fr, fq)), pf1 = *(const LAS bf16x8*)(lds + GL_P + swz128(16 * it + fr, 4 + fq));
                    const bf16x8 qp0 = afrag_pi128(QT, 16 * it + fr, 0, fq), qp1 = afrag_pi128(QT, 16 * it + fr, 1, fq);
#pragma unroll
                    for (int nt = 0; nt < 2; ++nt) { f32x4 a = {0.f, 0.f, 0.f, 0.f};
                        a = mfma16(pf0, Vb[nt][0], a); a = mfma16(pf1, Vb[nt][1], a); a = mfma16(qp0, Sb[nt][0], a); a = mfma16(qp1, Sb[nt][1], a);
                        oacc[it][nt] = a; }
                }
#pragma unroll
                for (int it = 0; it < 4; ++it)
#pragma unroll
                    for (int nt = 0; nt < 2; ++nt)
#pragma unroll
                        for (int j = 0; j < 4; ++j) *(LAS bf16_t*)(ost + (16 * it + 4 * fq + j) * 64 + (16 * nt + fr) * 2) = (bf16_t)f2bf(oacc[it][nt][j]);
                wave_sync();
                bf16_t* og = (bf16_t*)(P.ws + T_OGLA) + ((size_t)dir * ROWS + row0) * 512 + h * 128 + 32 * cw;
#pragma unroll
                for (int i = 0; i < 4; ++i) { const int c = lane + 64 * i, row = c >> 2, q4 = c & 3;
                    *(u32x4*)(og + (size_t)row * 512 + q4 * 8) = *(const LAS u32x4*)(ost + row * 64 + q4 * 16); }
            }
#pragma unroll
            for (int dkt = 0; dkt < 4; ++dkt) {
                bf16x8 kt[2];
#pragma unroll
                for (int k = 0; k < 2; ++k) { const int row = 32 * k + 8 * fq + ((lane >> 2) & 3), ch = 2 * dkt + ((lane & 3) >> 1), off = (lane & 1) * 8;
                    kt[k] = join_s4(lds_tr16(KT + swz128(row, ch) + off), lds_tr16(KT + swz128(row + 4, ch) + off)); }
                const f32x4 ac = *(const LAS f32x4*)(VEC + 128 + 16 * dkt + 4 * fq), el = *(const LAS f32x4*)(VEC + 64 + 16 * dkt + 4 * fq);
#pragma unroll
                for (int nt = 0; nt < 2; ++nt) { f32x4 a = {0.f, 0.f, 0.f, 0.f};
                    a = mfma16(kt[0], Vb[nt][0], a); a = mfma16(kt[1], Vb[nt][1], a);
                    S[dkt][nt] = S[dkt][nt] * ac + a * el; }
            }
            LGKM_DRAIN(); PROF_B(21); RAW_BAR(); PROF_E(21);
        }
    }
    VM_DRAIN(); block_sync();
}
DEV void phase_scan(const Params& P, LAS unsigned char* lds, int l, int vb, int nvb) {
    const bool ctx_out = (l == 0);
    for (int it = vb; it < GDN_ITEMS + GLA_ITEMS; it += nvb) {
        if (it < GDN_ITEMS) gdn_scan_item(P, lds, it, ctx_out); else gla_scan_item(P, lds, l, it - GDN_ITEMS, ctx_out);
    }
}

DEV void phase_merge(const Params& P, int l, int vb, int nvb) {
    const int tid = tidx(), wave = tid >> 6, lane = tid & 63;
    const int nrows = l == 1 ? M_LAST : ROWS;
    const bool gdn = lane >= 32; const int c0 = 16 * (lane & 31);
    const bf16_t* O = (const bf16_t*)(P.ws + (gdn ? T_OGDN : T_OGLA));
    float ngv[16];
    { const float* ng = (gdn ? P.gdn_norm_g : P.gla_norm_g) + l * 128 + (c0 & 127);
#pragma unroll
      for (int c = 0; c < 16; ++c) ngv[c] = ng[c]; }
    constexpr int RPI = 2;
    for (int rowb = RPI * (vb * NWAVE + wave); rowb < nrows; rowb += RPI * nvb * NWAVE) {
        u32x4 av[RPI][2], bv[RPI][2], gv[RPI][2];
#pragma unroll
        for (int u = 0; u < RPI; ++u) { const int row = rowb + u < nrows ? rowb + u : nrows - 1;
            const bf16_t* gp = (const bf16_t*)(P.ws + T_PG) + (size_t)row * 1024 + 16 * lane;
#pragma unroll
            for (int e = 0; e < 2; ++e) { av[u][e] = *(const u32x4*)(O + (size_t)row * 512 + c0 + 8 * e); bv[u][e] = *(const u32x4*)(O + ((size_t)ROWS + row) * 512 + c0 + 8 * e); gv[u][e] = *(const u32x4*)(gp + 8 * e); } }
#pragma unroll
        for (int u = 0; u < RPI; ++u) { const int row = rowb + u;
            float o[16]; float ssq = 0.f;
#pragma unroll
            for (int e = 0; e < 2; ++e)
#pragma unroll
                for (int j = 0; j < 4; ++j) { const float x0 = bflo(av[u][e][j]) + bflo(bv[u][e][j]), x1 = bfhi(av[u][e][j]) + bfhi(bv[u][e][j]); o[8 * e + 2 * j] = x0; o[8 * e + 2 * j + 1] = x1; ssq += x0 * x0 + x1 * x1; }
            ssq += wshfl_xor(ssq, 1); ssq += wshfl_xor(ssq, 2); ssq += wshfl_xor(ssq, 4);
            const float rs = frsq(ssq * (1.0f / 128.0f) + EPSN);
            if (row < nrows) {
                bf16_t* yp = ((row < RL || !SKIP_CTX_LAST) ? (bf16_t*)(P.ws + T_Y) + (size_t)row * 1024 : (bf16_t*)(P.ws + WS_YC) + (size_t)(row - RL) * 1024) + 16 * lane;
#pragma unroll
                for (int e = 0; e < 2; ++e) { u32x4 w;
#pragma unroll
                    for (int j = 0; j < 4; ++j) { const int c = 8 * e + 2 * j;
                        w[j] = pk2(o[c] * rs * ngv[c] * silu_f(bflo(gv[u][e][j])), o[c + 1] * rs * ngv[c + 1] * silu_f(bfhi(gv[u][e][j]))); }
                    *(u32x4*)(yp + 8 * e) = w; }
            }
        }
    }
}

DEV void phase_final(const Params& P, int vb, int nvb) {
    const int tid = tidx(), wave = tid >> 6, lane = tid & 63;
    const float* ss = (const float*)(P.ws + WS_SUMSQ) + (size_t)4 * ROWS;
    f32x4 g[4];
#pragma unroll
    for (int j = 0; j < 4; ++j) g[j] = *(const f32x4*)(P.final_norm_g + 4 * (64 * j + lane));
    for (int rowb = 2 * (vb * NWAVE + wave); rowb < RL; rowb += 2 * nvb * NWAVE) {
        f32x4 v[2][4]; float sv[2];
#pragma unroll
        for (int u = 0; u < 2; ++u) { const int row = rowb + u < RL ? rowb + u : RL - 1; sv[u] = ss[row + (lane & 0)];
#pragma unroll
            for (int j = 0; j < 4; ++j) v[u][j] = *(const f32x4*)(P.out + (size_t)row * D + 4 * (64 * j + lane)); }
#pragma unroll
        for (int u = 0; u < 2; ++u) { const int row = rowb + u; if (row < RL) { const float rs = frsq(sv[u] * (1.0f / D) + EPSN);
#pragma unroll
            for (int j = 0; j < 4; ++j) *(f32x4*)(P.out + (size_t)row * D + 4 * (64 * j + lane)) = v[u][j] * rs * g[j]; } }
    }
}

constexpr size_t CTL_CTXCNT = 16384;
static_assert(CTL_QUEUE_OFS + 4 * 8 * 256 <= CTL_BYTES && CTL_QUEUE_OFS > CTL_CTXCNT + 256, "control words");
#ifndef EMU
DEV void handoff_publish(unsigned* cnt) {
    asm volatile("s_waitcnt vmcnt(0)" ::: "memory"); __syncthreads();
    if (threadIdx.x == 0) { __builtin_amdgcn_fence(__ATOMIC_RELEASE, "agent"); asm volatile("s_waitcnt vmcnt(0)" ::: "memory"); __hip_atomic_fetch_add(cnt, 1u, __ATOMIC_RELAXED, __HIP_MEMORY_SCOPE_AGENT); }
}
DEV void handoff_wait(unsigned* cnt, unsigned need) {
    if (threadIdx.x == 0) { unsigned sp = 0; while (__hip_atomic_load(cnt, __ATOMIC_RELAXED, __HIP_MEMORY_SCOPE_AGENT) < need) { __builtin_amdgcn_s_sleep(4); if (++sp > (1u << 24)) break; }
        __builtin_amdgcn_fence(__ATOMIC_ACQUIRE, "agent"); asm volatile("s_waitcnt vmcnt(0)" ::: "memory"); }
    __syncthreads();
}
#else
DEV void handoff_publish(unsigned* cnt) { emu_syncthreads(); if (threadIdx.x == 0) __atomic_fetch_add(cnt, 1u, __ATOMIC_SEQ_CST); }
DEV void handoff_wait(unsigned* cnt, unsigned need) { if (threadIdx.x == 0) { while (__atomic_load_n(cnt, __ATOMIC_SEQ_CST) < need) sched_yield(); } emu_syncthreads(); }
#endif
constexpr int N_PHASES = 19;
DEV void run_phase(const Params& P, LAS unsigned char* lds, int ph, int vb, int nvb) {
    float* ss = (float*)(P.ws + WS_SUMSQ); const float* MOD = (const float*)(P.ws + WS_MOD); const float* GS = (const float*)(P.ws + WS_GS);
    if (ph == 0) { phase0a(P, lds, vb, nvb); return; }
    if (ph == 1) { phase0b(P, lds, vb, nvb); return; }
    if (ph == N_PHASES - 1) { phase_final(P, vb, nvb); return; }
    const int l = (ph - 2) / 8, sub = (ph - 2) % 8;
    const int Mx = l == 1 ? M_LAST : ROWS;
    float* xc = (float*)(P.ws + WS_XC);
    constexpr int PML = RL / 256, PMC = RC / 256;
    const bool defer = SKIP_CTX_LAST;
    if (sub == 0) {
        pg8::Gemm g{(const bf16_t*)(P.ws + T_A), (const bf16_t*)(P.ws + WS_WIN + (size_t)l * WIN_BYTES), ROWS, NP, D};
        pg8::EpiIn E{ss + (size_t)(2 * l) * ROWS, (const float*)(P.ws + WS_SHW1) + (size_t)l * NMOD * NP, P.ws};
        if (l == 0 || !defer) {
            pg8::StaticOrder S; S.init(ROWS, NP, nvb, vb);
            pg8::gemm_phase(lds + LDS_RING, g, S, E);
        } else {
            unsigned* cnt = (unsigned*)(P.ws + WS_CTL + CTL_CTXCNT);
            const int nct = PMC * (D / 256), nhb = nct < nvb ? nct : nvb;
            { pg8::Gemm g2{(const bf16_t*)(P.ws + T_HID), (const bf16_t*)(P.ws + WS_WFF2), ROWS, D, FF};
              pg8::SegOrder S; S.init(PML, PMC, D, vb, nvb, 1 << 20);
              pg8::EpiRes E2{P.out, xc, P.out, xc, MOD + 5 * D, GS + (size_t)(2) * NMOD * D, (bf16_t*)(P.ws + T_A), ss + (size_t)2 * ROWS};
              pg8::gemm_phase(lds + LDS_RING, g2, S, E2);
              if (vb < nhb) handoff_publish(cnt); }
            { const int ntot = PML * (NP / 256), nlight = nvb - nhb;
              const int per_light = nlight > 0 ? (ntot + 4 * nhb + nvb - 1) / nvb : 0, per_heavy = per_light > 4 ? per_light - 4 : 0;
              pg8::SegOrder S;
              if (vb >= nhb) S.init(0, PML, NP, vb - nhb, nlight, per_light); else S.init(0, PML, NP, nlight * per_light + vb, nhb, nlight > 0 ? per_heavy : 1 << 20);
              pg8::gemm_phase(lds + LDS_RING, g, S, E); }
            { pg8::SegOrder S; S.init(PML, PMC, NP, nvb - 1 - vb, nvb, 1 << 20);
              pg8::Unit u0; if (S.next(0, u0)) handoff_wait(cnt, (unsigned)nhb);
              pg8::gemm_phase(lds + LDS_RING, g, S, E); }
        }
    } else if (sub == 1) { phase_prep_a(P, lds, l, vb, nvb);
    } else if (sub == 2) { phase_prep_b(P, lds, l, vb, nvb);
    } else if (sub == 3) { phase_scan(P, lds, l, vb, nvb);
    } else if (sub == 4) { phase_merge(P, l, vb, nvb);
    } else if (sub == 5) {
        pg8::Gemm g{(const bf16_t*)(P.ws + T_Y), (const bf16_t*)(P.ws + WS_WOUT), Mx, D, D};
        pg8::EpiRes E{l == 0 ? P.x : P.out, l == 0 ? P.ctx : xc, P.out, xc, MOD + (size_t)l * NMOD * 6 * D + 2 * D, GS + (size_t)(l * 2 + 1) * NMOD * D,
                      (bf16_t*)(P.ws + T_A), ss + (size_t)(2 * l + 1) * ROWS};
        if (l == 0 && defer) { pg8::SegOrder S; S.init(0, PML, D, vb, nvb, 1 << 20); pg8::gemm_phase(lds + LDS_RING, g, S, E); }
        else { pg8::StaticOrder S; S.init(Mx, D, nvb, vb); pg8::gemm_phase(lds + LDS_RING, g, S, E); }
    } else if (sub == 6) {
        pg8::Gemm g{(const bf16_t*)(P.ws + T_A), (const bf16_t*)(P.ws + WS_WFF1), Mx, FF, D};
        pg8::EpiFF1 E{ss + (size_t)(2 * l + 1) * ROWS, (const float*)(P.ws + WS_SHW2) + (size_t)l * NMOD * FF, (bf16_t*)(P.ws + T_HID)};
        if (l == 0 && defer) {
            { pg8::Gemm g2{(const bf16_t*)(P.ws + WS_YC) - (size_t)RL * D, (const bf16_t*)(P.ws + WS_WOUT), ROWS, D, D};
              pg8::EpiRes E2{P.x, P.ctx, P.out, xc, MOD + 2 * D, GS + (size_t)(1) * NMOD * D, (bf16_t*)(P.ws + T_A), ss + (size_t)1 * ROWS};
              pg8::SegOrder S; S.init(PML, PMC, D, nvb - 1 - vb, nvb, 1 << 20); pg8::gemm_phase(lds + LDS_RING, g2, S, E2); }
            { pg8::SegOrder S; S.init(0, PML, FF, vb, nvb, 1 << 20); pg8::gemm_phase(lds + LDS_RING, g, S, E); }
        } else { pg8::StaticOrder S; S.init(Mx, FF, nvb, vb); pg8::gemm_phase(lds + LDS_RING, g, S, E); }
    } else {
        pg8::Gemm g{(const bf16_t*)(P.ws + T_HID), (const bf16_t*)(P.ws + WS_WFF2), Mx, D, FF};
        pg8::EpiRes E{P.out, xc, P.out, xc, MOD + (size_t)l * NMOD * 6 * D + 5 * D, l == 0 ? GS + (size_t)(2) * NMOD * D : nullptr,
                      (bf16_t*)(P.ws + T_A), ss + (size_t)(l == 0 ? 2 : 4) * ROWS};
        if (l == 0 && defer) {
            { pg8::Gemm g2{(const bf16_t*)(P.ws + T_A), (const bf16_t*)(P.ws + WS_WFF1), ROWS, FF, D};
              pg8::EpiFF1 E2{ss + (size_t)1 * ROWS, (const float*)(P.ws + WS_SHW2), (bf16_t*)(P.ws + T_HID)};
              pg8::SegOrder S; S.init(PML, PMC, FF, nvb - 1 - vb, nvb, 1 << 20); pg8::gemm_phase(lds + LDS_RING, g2, S, E2); }
            { pg8::SegOrder S; S.init(0, PML, D, vb, nvb, 1 << 20); pg8::gemm_phase(lds + LDS_RING, g, S, E); }
        } else { pg8::StaticOrder S; S.init(Mx, D, nvb, vb); pg8::gemm_phase(lds + LDS_RING, g, S, E); }
    }
}

#ifndef EMU
#define XB_TMO      128
#define XB_XCNT(j)  (256  + 64 * (j))
#define XB_XSUB(j)  (1280 + 64 * (j))
#define XB_XGEN(j)  (2304 + 64 * (j))
#define XB_TOP      3328
#define XB_TOPGEN   3392
#define XCD_BAR_WORDS 3456
#define XB_SPIN_CAP (1u << 22)
__device__ __forceinline__ unsigned xb_ld(unsigned* p)              { return __hip_atomic_load(p, __ATOMIC_RELAXED, __HIP_MEMORY_SCOPE_AGENT); }
__device__ __forceinline__ unsigned xb_add(unsigned* p, unsigned v) { return __hip_atomic_fetch_add(p, v, __ATOMIC_RELAXED, __HIP_MEMORY_SCOPE_AGENT); }
__device__ __forceinline__ unsigned xb_xcc_id() { return (unsigned)__builtin_amdgcn_s_getreg((3 << 11) | 20) & 0xFu; }
#define XB_SPIN(cond, bar) do { unsigned _sp = 0; while (cond) { __builtin_amdgcn_s_sleep(1); \
    if ((++_sp & 255u) == 0u) { if (xb_ld(&(bar)[XB_TMO])) break; if (_sp > XB_SPIN_CAP) { atomicAdd(&(bar)[XB_TMO], 1u); break; } } } } while (0)
struct XcdBarrier { unsigned* bar; unsigned x; volatile LAS unsigned* st; };
__device__ __forceinline__ XcdBarrier xcd_barrier_post(unsigned* bar, volatile LAS unsigned* st) {
    XcdBarrier b; b.bar = bar; b.x = xb_xcc_id(); b.st = st;
    if (threadIdx.x == 0) (void)xb_add(&bar[XB_XCNT(b.x)], 1u);
    return b;
}
__device__ __forceinline__ void xcd_barrier_complete(unsigned* bar, unsigned x, unsigned& nloc, unsigned& nx) {
    const unsigned G = gridDim.x * gridDim.y * gridDim.z;
    unsigned sum, cnt, mine, sp = 0u;
    for (;;) {
        sum = 0u; cnt = 0u; mine = 0u;
#pragma unroll
        for (unsigned j = 0; j < 16; ++j) { const unsigned c = xb_ld(&bar[XB_XCNT(j)]); sum += c; cnt += (c > 0u) ? 1u : 0u; mine = (j == x) ? c : mine; }
        if (sum == G) break;
        __builtin_amdgcn_s_sleep(1);
        if ((++sp & 255u) == 0u) { if (xb_ld(&bar[XB_TMO])) break; if (sp > XB_SPIN_CAP) { atomicAdd(&bar[XB_TMO], 1u); break; } }
    }
    nloc = mine > 0u ? mine : 1u; nx = cnt > 0u ? cnt : 1u;
}
__device__ __forceinline__ void xcd_barrier(const XcdBarrier& b) {
    asm volatile("s_waitcnt vmcnt(0)" ::: "memory");
    __syncthreads();
    if (threadIdx.x == 0) {
        unsigned* bar = b.bar;
        __builtin_amdgcn_s_waitcnt(0);
        unsigned nloc = b.st[0], nx = b.st[1];
        if (nloc == 0u) { xcd_barrier_complete(bar, b.x, nloc, nx); b.st[0] = nloc; b.st[1] = nx; }
        const unsigned old = xb_add(&bar[XB_XSUB(b.x)], 1u);
        const unsigned gen = old / nloc;
        if (old + 1u == (gen + 1u) * nloc) {
            __builtin_amdgcn_fence(__ATOMIC_RELEASE, "agent");
            asm volatile("s_waitcnt vmcnt(0)" ::: "memory");
            const unsigned og = xb_add(&bar[XB_TOP], 1u);
            const unsigned tg = og / nx;
            if (og + 1u == (tg + 1u) * nx) xb_add(&bar[XB_TOPGEN], 1u);
            else XB_SPIN(xb_ld(&bar[XB_TOPGEN]) == tg, bar);
            __builtin_amdgcn_fence(__ATOMIC_ACQUIRE, "agent");
            xb_add(&bar[XB_XGEN(b.x)], 1u);
            asm volatile("s_waitcnt vmcnt(0)" ::: "memory");
        } else {
            XB_SPIN(xb_ld(&bar[XB_XGEN(b.x)]) == gen, bar);
            __builtin_amdgcn_fence(__ATOMIC_ACQUIRE, "agent");
            asm volatile("s_waitcnt vmcnt(0)" ::: "memory");
        }
    }
    __syncthreads();
}
constexpr int LDS_MISC = 163840 - 256;

__global__ void __launch_bounds__(NT, 2) k_mega(Params P) {
    extern __shared__ __attribute__((aligned(16))) unsigned char lds_raw[];
    LAS unsigned char* lds = (LAS unsigned char*)lds_raw;
    cg::grid_group grid = cg::this_grid();
    if (threadIdx.x < 64) ((LAS unsigned*)(lds + LDS_MISC))[threadIdx.x] = 0u;
    __syncthreads();
    XcdBarrier bar = xcd_barrier_post((unsigned*)(P.ws + WS_CTL), (volatile LAS unsigned*)(lds + LDS_MISC));
    for (int ph = 0; ph < N_PHASES; ++ph) {
        run_phase(P, lds, ph, (int)blockIdx.x, (int)gridDim.x);
        if (ph == 0) grid.sync();
        else if (ph + 1 < N_PHASES) xcd_barrier(bar);
    }
}

extern "C" void kernel_launch(void* const* d_in, const int* in_sizes, int n_in, void* d_out, int out_size, void* d_ws, size_t ws_size, hipStream_t stream) {
    static int grid = 0;
    if (grid == 0) {
        int dev = 0, cus = 0, per_cu = 0;
        (void)hipGetDevice(&dev); (void)hipDeviceGetAttribute(&cus, hipDeviceAttributeMultiprocessorCount, dev);
        (void)hipFuncSetAttribute((const void*)k_mega, hipFuncAttributeMaxDynamicSharedMemorySize, LDS_BYTES);
        (void)hipOccupancyMaxActiveBlocksPerMultiprocessor(&per_cu, (const void*)k_mega, NT, LDS_BYTES);
        if (per_cu < 1) { fprintf(stderr, "kernel_launch: occupancy query says %d blocks per CU\n", per_cu); per_cu = 1; }
        if (per_cu > 1) per_cu = 1;
        grid = (cus > 0 ? cus : 256) * per_cu;
        if (ws_size < WS_END) { fprintf(stderr, "kernel_launch: workspace too small: %zu < %zu\n", ws_size, (size_t)WS_END); grid = -1; }
    }
    if (grid < 0) return;
    Params P{};
    const float** pp = (const float**)&P;
    for (int i = 0; i < 20; ++i) pp[i] = (const float*)d_in[i];
    P.out = (float*)d_out; P.ws = (unsigned char*)d_ws;
    (void)hipMemsetAsync((char*)d_ws + WS_CTL, 0, CTL_BYTES, stream);
    void* args[] = {&P};
    hipError_t e = hipLaunchCooperativeKernel((const void*)k_mega, dim3(grid), dim3(NT), args, LDS_BYTES, stream);
    if (e != hipSuccess) fprintf(stderr, "cooperative launch failed: %s (grid %d)\n", hipGetErrorString(e), grid);
}
#endif
```

```cpp
#ifndef EMU
#include <hip/hip_runtime.h>
#include <hip/hip_cooperative_groups.h>
#include <cstdio>
#include <cstdint>
namespace cg = cooperative_groups;
typedef short bf16x8 __attribute__((ext_vector_type(8)));
typedef short s16x4 __attribute__((ext_vector_type(4)));
typedef float f32x4 __attribute__((ext_vector_type(4)));
typedef float f32x2 __attribute__((ext_vector_type(2)));
typedef unsigned u32x4 __attribute__((ext_vector_type(4)));
typedef unsigned u32x2 __attribute__((ext_vector_type(2)));
#define LAS __attribute__((address_space(3)))
#define DEV __device__ __forceinline__
#define MDEV __device__ __forceinline__
#else
#define LAS
#define DEV static inline __attribute__((always_inline))
#define MDEV inline __attribute__((always_inline))
#endif
typedef unsigned short bf16_t;

#ifndef CFG_BATCH
#define CFG_BATCH 8
#define CFG_SEQ 4096
#define CFG_CTX 256
#endif
constexpr int D = 1024, NB = CFG_BATCH, SEQ = CFG_SEQ, CTX = CFG_CTX, FF = 4096, NP = 3840, NPROJ = 3616;
constexpr int RL = NB * SEQ, RC = NB * CTX, ROWS = RL + RC;
constexpr int NCL = SEQ / 64, NCC = CTX / 64, NCH = ROWS / 64;
constexpr int NMOD = NB + 1;
constexpr bool SKIP_CTX_LAST = (RL % 256 == 0);
constexpr int M_LAST = SKIP_CTX_LAST ? RL : ROWS;
constexpr float EPSN = 1e-6f;
static_assert(ROWS % 256 == 0 && SEQ % 64 == 0 && CTX % 64 == 0, "shape");
constexpr int NT = 512, NWAVE = 8;

constexpr size_t al256(size_t x) { return (x + 255) & ~(size_t)255; }
constexpr size_t WS_CTL = 0;                                   constexpr size_t CTL_BYTES = 65536;
constexpr size_t WS_MOD = WS_CTL + CTL_BYTES;                  constexpr size_t MOD_BYTES = al256((size_t)2 * NMOD * 6 * D * 4);
constexpr size_t WS_GS = WS_MOD + MOD_BYTES;                   constexpr size_t GS_BYTES = al256((size_t)2 * 2 * NMOD * D * 4);
constexpr size_t WS_SHW1 = WS_GS + GS_BYTES;                   constexpr size_t SHW1_BYTES = al256((size_t)2 * NMOD * NP * 4);
constexpr size_t WS_SHW2 = WS_SHW1 + SHW1_BYTES;               constexpr size_t SHW2_BYTES = al256((size_t)2 * NMOD * FF * 4);
constexpr size_t WS_SUMSQ = WS_SHW2 + SHW2_BYTES;              constexpr size_t SUMSQ_BYTES = al256((size_t)5 * ROWS * 4);
constexpr size_t WS_GATE = WS_SUMSQ + SUMSQ_BYTES;             constexpr size_t GATE_BYTES = al256((size_t)ROWS * 32 * 4);
constexpr size_t WS_XC = WS_GATE + GATE_BYTES;                 constexpr size_t XC_BYTES = al256((size_t)RC * D * 4);
constexpr size_t WS_WIN = WS_XC + XC_BYTES;                    constexpr size_t WIN_BYTES = al256((size_t)NP * D * 2);
constexpr size_t WS_WOUT = WS_WIN + 2 * WIN_BYTES;             constexpr size_t WOUT_BYTES = al256((size_t)D * D * 2);
constexpr size_t WS_WFF1 = WS_WOUT + WOUT_BYTES;               constexpr size_t WFF1_BYTES = al256((size_t)FF * D * 2);
constexpr size_t WS_WFF2 = WS_WFF1 + WFF1_BYTES;               constexpr size_t WFF2_BYTES = al256((size_t)D * FF * 2);
constexpr size_t WS_QKVNC = WS_WFF2 + WFF2_BYTES;              constexpr size_t QKVNC_BYTES = al256((size_t)RC * 1536 * 2);
constexpr size_t WS_YC = WS_QKVNC + QKVNC_BYTES;               constexpr size_t YC_BYTES = al256((size_t)RC * D * 2);
constexpr size_t WS_TEMP = WS_YC + YC_BYTES;
constexpr size_t SZA = (size_t)ROWS * D * 2;
constexpr size_t TAQK_ITEM = 8192 + 8192 + 1024;
constexpr size_t T_A = WS_TEMP;
constexpr size_t T_PG = WS_TEMP + SZA;
constexpr size_t T_PGLAQK = WS_TEMP + 2 * SZA;
constexpr size_t T_PGLAV = T_PGLAQK + SZA / 2;
constexpr size_t T_PGDN = WS_TEMP + 3 * SZA;
constexpr size_t T_TAQK = T_PGDN + SZA + SZA / 2;
constexpr size_t TAQK_BYTES = al256((size_t)NCH * 8 * TAQK_ITEM);
constexpr size_t T_OGDN = T_TAQK + TAQK_BYTES;
constexpr size_t T_OGLA = T_A;
constexpr size_t T_Y = T_PGLAQK;
constexpr size_t T_HID = T_PG;
constexpr size_t WS_END = T_OGDN + SZA;
static_assert(T_HID + (size_t)ROWS * FF * 2 <= WS_END, "hid fits");
static_assert(WS_END <= (size_t)512 * 1024 * 1024, "workspace budget (512 MiB)");

constexpr int LDS_BYTES = 163840;
constexpr int LDS_RING = 0;

#ifndef EMU
DEV f32x4 mfma16(bf16x8 a, bf16x8 b, f32x4 c) { return __builtin_amdgcn_mfma_f32_16x16x32_bf16(a, b, c, 0, 0, 0); }
DEV f32x4 mfma4f32(float a, float b, f32x4 c) { return __builtin_amdgcn_mfma_f32_16x16x4f32(a, b, c, 0, 0, 0); }
DEV void block_sync() { __syncthreads(); }
DEV float wshfl_xor(float v, int m) { return __shfl_xor(v, m); }
DEV float wshfl_up(float v, int d) { return __shfl_up(v, d); }
DEV float wshfl(float v, int l) { return __shfl(v, l); }
DEV s16x4 lds_tr16(const LAS unsigned char* p) { return __builtin_amdgcn_ds_read_tr16_b64_v4i16((LAS s16x4*)p); }
DEV void atomic_addf(float* p, float v) { atomicAdd(p, v); }
DEV float fexp(float x) { return __builtin_amdgcn_exp2f(x * 1.4426950408889634f); }
DEV float flog(float x) { return __builtin_amdgcn_logf(x) * 0.6931471805599453f; }
DEV float frcp(float x) { return __builtin_amdgcn_rcpf(x); }
DEV float frsq(float x) { return __builtin_amdgcn_rsqf(x); }
DEV float fexp_raw(float x) { return __builtin_amdgcn_exp2f(x * 1.4426950408889634f); }
DEV float flog_raw(float x) { return __builtin_amdgcn_logf(x) * 0.6931471805599453f; }
DEV int uniform_i(int x) { return __builtin_amdgcn_readfirstlane(x); }
DEV int opaque_i(int x) { asm volatile("" : "+v"(x)); return x; }
DEV void wave_sync() { asm volatile("s_waitcnt lgkmcnt(0)" ::: "memory"); __builtin_amdgcn_wave_barrier(); }
DEV int tidx() { return opaque_i((int)threadIdx.x); }
#else
DEV f32x4 mfma16(bf16x8 a, bf16x8 b, f32x4 c) { return emu_mfma16(a, b, c); }
DEV f32x4 mfma4f32(float a, float b, f32x4 c) { return emu_mfma4f32(a, b, c); }
DEV void block_sync() { emu_syncthreads(); }
DEV float wshfl_xor(float v, int m) { return emu_shfl_xor(v, m); }
DEV float wshfl_up(float v, int d) { return emu_shfl_up(v, d); }
DEV float wshfl(float v, int l) { return emu_shfl(v, l); }
DEV s16x4 lds_tr16(const unsigned char* p) { return emu_ds_read_tr16(p); }
DEV void atomic_addf(float* p, float v) { emu_atomic_add(p, v); }
DEV float fexp(float x) { return expf(x); }
DEV float flog(float x) { return logf(x); }
DEV float frcp(float x) { return 1.0f / x; }
DEV float frsq(float x) { return 1.0f / sqrtf(x); }
DEV float fexp_raw(float x) { return expf(x); }
DEV float flog_raw(float x) { return logf(x); }
DEV int uniform_i(int x) { return x; }
DEV int opaque_i(int x) { return x; }
DEV void wave_sync() { int z = 0; (void)emu_wave_exchange(&z, 4); }
DEV int tidx() { return (int)threadIdx.x; }
#endif
#ifndef EMU
#define VM_DRAIN() asm volatile("s_waitcnt vmcnt(0)" ::: "memory")
#define LGKM_DRAIN() asm volatile("s_waitcnt lgkmcnt(0)" ::: "memory")
#define RAW_BAR() __builtin_amdgcn_s_barrier()
#define SCHED_FENCE() __builtin_amdgcn_sched_barrier(0)
#else
#define VM_DRAIN()
#define LGKM_DRAIN()
#define RAW_BAR() emu_syncthreads()
#define SCHED_FENCE()
#endif
DEV unsigned f2bf(float f) { unsigned u = __builtin_bit_cast(unsigned, f); return (u + 0x7fffu + ((u >> 16) & 1u)) >> 16; }
#ifndef EMU
typedef __bf16 hwbf16x2 __attribute__((ext_vector_type(2)));
DEV unsigned pk2(float lo, float hi) { const f32x2 f = {lo, hi}; return __builtin_bit_cast(unsigned, __builtin_convertvector(f, hwbf16x2)); }
#else
DEV unsigned pk2(float lo, float hi) { return f2bf(lo) | (f2bf(hi) << 16); }
#endif
DEV float bf2f(unsigned short s) { return __builtin_bit_cast(float, (unsigned)s << 16); }
DEV float bflo(unsigned u) { return __builtin_bit_cast(float, u << 16); }
DEV float bfhi(unsigned u) { return __builtin_bit_cast(float, u & 0xffff0000u); }
DEV float silu_f(float x) { return x * frcp(1.f + fexp(-x)); }
DEV float sigmoid_f(float x) { return frcp(1.f + fexp(-x)); }
DEV float logsigmoid_f(float x) { return fminf(x, 0.f) - flog(1.f + fexp(-fabsf(x))); }
DEV float softplus_f(float x) { return fmaxf(x, 0.f) + log1pf(fexp(-fabsf(x))); }
DEV float wave_sum(float v) {
#pragma unroll
    for (int o = 1; o < 64; o <<= 1) v += wshfl_xor(v, o);
    return v;
}
DEV int mod_of_row(int row) { return row < RL ? row / SEQ : NB; }
DEV int win_src_col(int n) {
    if (n < 1536) return n;
    if (n < 3584) return n + 16;
    if (n < 3600) return n - 3584 + 1536;
    if (n < 3616) return n;
    return -1;
}

#define PROF_B(t)
#define PROF_E(t)
struct Params {
    const float *x, *c, *ctx, *c_ctx, *w_ada, *b_ada, *norm1_g, *norm2_g, *w_in, *gla_w_lr, *gla_b_lr, *gdn_conv_w, *gdn_a_log, *gdn_dt_bias,
        *gla_norm_g, *gdn_norm_g, *w_out, *w_ff1, *w_ff2, *final_norm_g;
    float* out; unsigned char* ws;
};

template <class VecFn, class ColFn>
DEV void gemv_item(LAS unsigned char* lds, VecFn vecfn, const float* W, int ldw, ColFn colfn, int n0, const float* bias, float* out, int ldo) {
    LAS float* vec = (LAS float*)lds;
    LAS float* red = (LAS float*)(lds + NMOD * D * 4);
    const int tid = tidx(), wave = tid >> 6, lane = tid & 63;
    static_assert((NMOD * D) % NT == 0, "vec staging");
    { float tmp[NMOD * D / NT];
#pragma unroll
      for (int u = 0; u < NMOD * D / NT; ++u) { const int i = tid + u * NT; tmp[u] = vecfn(i / D, i % D); }
#pragma unroll
      for (int u = 0; u < NMOD * D / NT; ++u) vec[tid + u * NT] = tmp[u]; }
    block_sync();
    const int sc = colfn(n0 + lane);
    float acc[NMOD];
#pragma unroll
    for (int b = 0; b < NMOD; ++b) acc[b] = 0.f;
    const int k0 = wave * (D / 8);
    const float* wp = W + (sc >= 0 ? sc : 0);
    const float wm = sc >= 0 ? 1.f : 0.f;
#pragma unroll 1
    for (int k = k0; k < k0 + D / 8; k += 64) {
        float w[64];
#pragma unroll
        for (int u = 0; u < 64; ++u) w[u] = wp[(size_t)(k + u) * ldw];
#pragma unroll
        for (int u = 0; u < 64; ++u) { const float wv = w[u] * wm;
#pragma unroll
            for (int b = 0; b < NMOD; ++b) acc[b] += vec[b * D + k + u] * wv; }
    }
#pragma unroll
    for (int b = 0; b < NMOD; ++b) red[(wave * NMOD + b) * 64 + lane] = acc[b];
    block_sync();
    for (int i = tid; i < NMOD * 64; i += NT) {
        const int b = i >> 6, ln = i & 63; float s = 0.f;
#pragma unroll
        for (int w = 0; w < 8; ++w) s += red[(w * NMOD + b) * 64 + ln];
        const int sc2 = colfn(n0 + ln);
        if (bias && sc2 >= 0) s += bias[sc2];
        out[(size_t)b * ldo + n0 + ln] = s;
    }
    block_sync();
}
struct CvItem { const float* W; bf16_t* WT; int K, ldw, nblk, r; bool win; };
DEV int cv_src_col(const CvItem& c, int n) { return c.win ? win_src_col(n) : n; }
DEV void cv_load(const CvItem& c, f32x4 (&tv)[16], int lane) {
    const int kb = c.r / c.nblk, nb = c.r % c.nblk, k0 = 64 * kb, n0 = 64 * nb;
    const int c4 = lane & 15, kr = lane >> 4;
    const int sc = cv_src_col(c, n0 + 4 * c4);
    const float* wp = c.W + (sc >= 0 ? sc : 0);
#pragma unroll
    for (int i = 0; i < 16; ++i) tv[i] = *(const f32x4*)(wp + (size_t)(k0 + kr + 4 * i) * c.ldw);
}
DEV void cv_finish(const CvItem& c, const f32x4 (&tv)[16], LAS float* scr, int lane) {
    const int kb = c.r / c.nblk, nb = c.r % c.nblk, k0 = 64 * kb, n0 = 64 * nb;
    const int c4 = lane & 15, kr = lane >> 4;
    const float wm = cv_src_col(c, n0 + 4 * c4) >= 0 ? 1.f : 0.f;
#pragma unroll
    for (int i = 0; i < 16; ++i) { LAS float* d = scr + (kr + 4 * i) * 65 + 4 * c4; const f32x4 v = tv[i] * wm; d[0] = v[0]; d[1] = v[1]; d[2] = v[2]; d[3] = v[3]; }
    wave_sync();
    const int cc = lane & 7;
#pragma unroll
    for (int j = 0; j < 8; ++j) { const int n = (lane >> 3) + 8 * j; const LAS float* sp = scr + (8 * cc) * 65 + n;
        u32x4 o; o.x = pk2(sp[0 * 65], sp[1 * 65]); o.y = pk2(sp[2 * 65], sp[3 * 65]); o.z = pk2(sp[4 * 65], sp[5 * 65]); o.w = pk2(sp[6 * 65], sp[7 * 65]);
        *(u32x4*)(c.WT + (size_t)(n0 + n) * c.K + k0 + 8 * cc) = o; }
    wave_sync();
}
struct ColId { MDEV int operator()(int n) const { return n; } };
struct ColWin { MDEV int operator()(int n) const { return win_src_col(n); } };

DEV CvItem cv_decode(const Params& P, int l, int it) {
    constexpr int I_IN = (D / 64) * (NP / 64), I_OUT = (D / 64) * (D / 64), I_F1 = (D / 64) * (FF / 64);
    int r = it; CvItem c;
    if (l == 0) {
        if (r < I_IN) { c.W = P.w_in; c.WT = (bf16_t*)(P.ws + WS_WIN); c.K = D; c.ldw = NPROJ; c.nblk = NP / 64; c.r = r; c.win = true; return c; } r -= I_IN;
        if (r < I_IN) { c.W = P.w_in + (size_t)D * NPROJ; c.WT = (bf16_t*)(P.ws + WS_WIN + WIN_BYTES); c.K = D; c.ldw = NPROJ; c.nblk = NP / 64; c.r = r; c.win = true; return c; } r -= I_IN;
    }
    c.win = false;
    if (r < I_OUT) { c.W = P.w_out + (size_t)l * D * D; c.WT = (bf16_t*)(P.ws + WS_WOUT); c.K = D; c.ldw = D; c.nblk = D / 64; c.r = r; return c; } r -= I_OUT;
    if (r < I_F1) { c.W = P.w_ff1 + (size_t)l * D * FF; c.WT = (bf16_t*)(P.ws + WS_WFF1); c.K = D; c.ldw = FF; c.nblk = FF / 64; c.r = r; return c; } r -= I_F1;
    c.W = P.w_ff2 + (size_t)l * FF * D; c.WT = (bf16_t*)(P.ws + WS_WFF2); c.K = FF; c.ldw = D; c.nblk = D / 64; c.r = r; return c;
}
DEV void convert_weights(const Params& P, LAS unsigned char* lds, int vb, int nvb, int layer_set) {
    const int tid = tidx(), wave = tid >> 6, lane = tid & 63;
    LAS float* scr = (LAS float*)(lds + wave * 16896);
    const int gw = vb * NWAVE + wave, NGW = nvb * NWAVE;
    constexpr int I_IN = (D / 64) * (NP / 64), I_OUT = (D / 64) * (D / 64), I_F1 = (D / 64) * (FF / 64), I_F2 = (FF / 64) * (D / 64);
    const int l = layer_set;
    const int nitems = (l == 0 ? 2 * I_IN : 0) + I_OUT + I_F1 + I_F2;
    int it = gw;
    if (it >= nitems) return;
    f32x4 ta[16], tb[16];
    CvItem ca = cv_decode(P, l, it), cb = ca;
    cv_load(ca, ta, lane);
#pragma unroll 1
    for (;;) {
        int itn = it + NGW; bool hn = itn < nitems;
        if (hn) { cb = cv_decode(P, l, itn); cv_load(cb, tb, lane); }
        cv_finish(ca, ta, scr, lane);
        if (!hn) break;
        it = itn; itn = it + NGW; hn = itn < nitems;
        if (hn) { ca = cv_decode(P, l, itn); cv_load(ca, ta, lane); }
        cv_finish(cb, tb, scr, lane);
        if (!hn) break;
        it = itn;
    }
}

DEV void phase0a(const Params& P, LAS unsigned char* lds, int vb, int nvb) {
    const int tid = tidx();
    { float* ss = (float*)(P.ws + WS_SUMSQ); for (size_t i = (size_t)vb * NT + tid; i < (size_t)5 * ROWS; i += (size_t)nvb * NT) ss[i] = 0.f; }
    float* MOD = (float*)(P.ws + WS_MOD);
    constexpr int NBLK = 6 * D / 64;
    for (int it = vb; it < 2 * NBLK; it += nvb) {
        const int l = it / NBLK, nb = it % NBLK;
        auto vf = [&](int b, int k) { const float v = b < NB ? P.c[(size_t)b * D + k] : P.c_ctx[k]; return silu_f(v); };
        gemv_item(lds, vf, P.w_ada + (size_t)l * D * 6 * D, 6 * D, ColId(), nb * 64, P.b_ada + (size_t)l * 6 * D, MOD + (size_t)l * NMOD * 6 * D, 6 * D);
    }
    block_sync();
    convert_weights(P, lds, vb, nvb, 0);
}

DEV void phase0b(const Params& P, LAS unsigned char* lds, int vb, int nvb) {
    const int tid = tidx(), wave = tid >> 6, lane = tid & 63;
    const float* MOD = (const float*)(P.ws + WS_MOD);
    { float* GS = (float*)(P.ws + WS_GS);
      for (int i = vb * NT + tid; i < 2 * 2 * NMOD * D; i += nvb * NT) {
          const int k = i % D, b = (i / D) % NMOD, wh = (i / (D * NMOD)) & 1, l = i / (D * NMOD * 2);
          const float g = (wh ? P.norm2_g : P.norm1_g)[l * D + k];
          GS[i] = g * (1.f + MOD[((size_t)l * NMOD + b) * 6 * D + (wh ? 4 : 1) * D + k]);
      } }
    constexpr int NB1 = NP / 64, NB2 = FF / 64;
    for (int it = vb; it < 2 * (NB1 + NB2); it += nvb) {
        const int l = it / (NB1 + NB2), r = it % (NB1 + NB2);
        if (r < NB1) {
            auto vf = [&](int b, int k) { return MOD[((size_t)l * NMOD + b) * 6 * D + 0 * D + k]; };
            gemv_item(lds, vf, P.w_in + (size_t)l * D * NPROJ, NPROJ, ColWin(), r * 64, nullptr, (float*)(P.ws + WS_SHW1) + (size_t)l * NMOD * NP, NP);
        } else {
            auto vf = [&](int b, int k) { return MOD[((size_t)l * NMOD + b) * 6 * D + 3 * D + k]; };
            gemv_item(lds, vf, P.w_ff1 + (size_t)l * D * FF, FF, ColId(), (r - NB1) * 64, nullptr, (float*)(P.ws + WS_SHW2) + (size_t)l * NMOD * FF, FF);
        }
    }
    bf16_t* A = (bf16_t*)(P.ws + T_A); float* ss = (float*)(P.ws + WS_SUMSQ);
    constexpr int NQ = ROWS / 4;
    const int gw = vb * NWAVE + wave, NGW = nvb * NWAVE;
    const int q_b = (int)(((long)gw * NQ) / NGW), q_e = (int)(((long)(gw + 1) * NQ) / NGW);
    f32x4 gsr[4]; int gs_b9 = -1;
#pragma unroll
    for (int j = 0; j < 4; ++j) gsr[j] = (f32x4){0.f, 0.f, 0.f, 0.f};
    auto loadq = [&](f32x4 (&v)[4][4], int q) {
#pragma unroll
        for (int u = 0; u < 4; ++u) { const int row = 4 * q + u;
            const float* xr = row < RL ? P.x + (size_t)row * D : P.ctx + (size_t)(row - RL) * D;
#pragma unroll
            for (int j = 0; j < 4; ++j) v[u][j] = *(const f32x4*)(xr + 4 * (64 * j + lane)); }
    };
    auto procq = [&](const f32x4 (&v)[4][4], int q) {
        const int b9 = mod_of_row(4 * q);
        if (b9 != gs_b9) { gs_b9 = b9;
#pragma unroll
            for (int j = 0; j < 4; ++j) { const int col = 4 * (64 * j + lane);
                const f32x4 g = *(const f32x4*)(P.norm1_g + col); const f32x4 c = *(const f32x4*)(MOD + (size_t)b9 * 6 * D + 1 * D + col);
                gsr[j] = g * (1.f + c); } }
#pragma unroll
        for (int u = 0; u < 4; ++u) { const int row = 4 * q + u; float s = 0.f;
#pragma unroll
            for (int j = 0; j < 4; ++j) {
                const int col = 4 * (64 * j + lane);
                const f32x4 x = v[u][j]; const f32x4 y = x * gsr[j];
                s += (x[0] * x[0] + x[1] * x[1]) + (x[2] * x[2] + x[3] * x[3]);
                u32x2 o; o.x = pk2(y[0], y[1]); o.y = pk2(y[2], y[3]);
                *(u32x2*)(A + (size_t)row * D + col) = o;
            }
            s = wave_sum(s);
            if (lane == 0) ss[row] = s; }
    };
    f32x4 va[4][4], vb2[4][4];
    if (q_b < q_e) loadq(va, q_b);
#pragma unroll 1
    for (int q = q_b; q < q_e; q += 2) {
        const bool h1 = q + 1 < q_e;
        if (h1) loadq(vb2, q + 1);
        procq(va, q);
        if (!h1) break;
        if (q + 2 < q_e) loadq(va, q + 2);
        procq(vb2, q + 1);
    }
}

namespace pg8 {
constexpr int BM = 256, BK = 64, HALF = 128, HTB = HALF * BK * 2, STAGE_BYTES = 8 * HTB, NXCD = 8, WGM = 8;
DEV int lds_byte(int r, int c) { const int st = (r >> 4) * 2 + (c >> 5), rr = r & 15, cc = c & 31, ob = rr * 64 + cc * 2; return st * 1024 + (ob ^ (((ob >> 9) & 1) << 5)); }
DEV void stage_rc(int b, int& R, int& C) { const int st = b / 1024, sb = b % 1024, swz = sb ^ (((sb >> 9) & 1) << 5); R = (st >> 1) * 16 + swz / 64; C = (st & 1) * 32 + (swz % 64) / 2; }
DEV int perm32(int rho) { const int n = rho >> 4, i = rho & 15; return 8 * (i >> 2) + 4 * n + (i & 3); }
struct Unit { int pm, pn; };
struct Gemm { const bf16_t* A; const bf16_t* Bt; int M, N, K; };
struct StaticOrder {
    int nM, nN, nwg, G, c;
    MDEV void init(int M, int N, int G_, int c_) { nM = M / BM; nN = N / BM; nwg = nM * nN; G = G_; c = c_; }
    MDEV void tile_of(long L, Unit& u) const {
        int wgid = (int)L; { const int q = nwg / NXCD, r = nwg % NXCD, xcd = wgid % NXCD, off = wgid / NXCD; wgid = (xcd < r ? xcd * (q + 1) : r * (q + 1) + (xcd - r) * q) + off; }
        const int nig = WGM * nN, gid = wgid / nig, fm = gid * WGM, gsz = (nM - fm) < WGM ? (nM - fm) : WGM;
        u.pm = fm + ((wgid % nig) % gsz); u.pn = (wgid % nig) / gsz;
    }
    MDEV bool next(int i, Unit& u) const { const long L = (long)i * G + c; if (L >= nwg) return false; tile_of(L, u); return true; }
};
struct SegOrder {
    StaticOrder so; int pm0, l0, lstride, lcount;
    MDEV void init(int pm0_, int npm, int N, int l0_, int lstride_, int lcount_) { so.init(npm * BM, N, 1, 0); pm0 = pm0_; l0 = l0_; lstride = lstride_; lcount = lcount_; }
    MDEV bool next(int i, Unit& u) const { if (i >= lcount) return false; const long L = (long)l0 + (long)i * lstride; if (L >= so.nwg) return false; so.tile_of(L, u); u.pm += pm0; return true; }
};
#ifndef EMU
DEV unsigned cvt_pk_bf16(float lo, float hi) { return pk2(lo, hi); }
DEV void glds16(const void* g, LAS unsigned char* l) { __builtin_amdgcn_global_load_lds((const unsigned*)g, (LAS unsigned*)l, 16, 0, 0); }
#define PG8_WAIT_V(n) asm volatile("s_waitcnt vmcnt(" #n ")" ::: "memory")
#define PG8_WAIT_L(n) asm volatile("s_waitcnt lgkmcnt(" #n ")" ::: "memory")
#define PG8_BAR __builtin_amdgcn_s_barrier()
#define PG8_SCHED __builtin_amdgcn_sched_barrier(0)
#define PG8_PRIO(x) __builtin_amdgcn_s_setprio(x)
#else
DEV unsigned cvt_pk_bf16(float lo, float hi) { return pk2(lo, hi); }
DEV void glds16(const void* g, unsigned char* l) { memcpy(l + (threadIdx.x & 63) * 16, g, 16); }
#define PG8_WAIT_V(n)
#define PG8_WAIT_L(n)
#define PG8_BAR emu_syncthreads()
#define PG8_SCHED
#define PG8_PRIO(x)
#endif

template <class Epi, class Sched>
DEV void gemm_phase(LAS unsigned char* lds, const Gemm g, const Sched& S, const Epi& E) {
    const int tid = tidx(), wid = uniform_i(tid >> 6), lane = tid & 63, wr = wid >> 2, wc = wid & 3, fr = lane & 15, fq = lane >> 4;
    const int K = g.K, nt = K / BK;
    unsigned voffA[2], voffB[2];
#pragma unroll
    for (int i = 0; i < 2; ++i) { int R, C; stage_rc(tid * 16 + i * 8192, R, C); const int Rb = Epi::PERM ? ((R & ~31) + perm32(R & 31)) : R;
        voffA[i] = (unsigned)(R * K + C) * 2u; voffB[i] = (unsigned)(Rb * K + C) * 2u; }
    const size_t kstep = (size_t)(BK * 2);
    const size_t hstep = (size_t)HALF * K * 2;
    const size_t tstep = 2 * hstep;
    const unsigned ldsw = (unsigned)wid * 1024u;
    const int aoff = lds_byte(wr * 64 + fr, fq * 8), boff = lds_byte(wc * 32 + fr, fq * 8);
#define PG8_SA(b, h) (((b) * 2 + (h)) * HTB)
#define PG8_SB(b, h) ((4 + (b) * 2 + (h)) * HTB)
#define PG8_STAGE(bufoff, gbase, voff) do { _Pragma("unroll") for (int _i = 0; _i < 2; ++_i) \
        glds16((const char*)(gbase) + (voff)[_i], lds + (bufoff) + ldsw + _i * 8192); } while (0)
#define PG8_LDA(dst, b, h) do { _Pragma("unroll") for (int m = 0; m < 4; ++m) _Pragma("unroll") for (int k = 0; k < 2; ++k) dst[m][k] = *(const LAS bf16x8*)(lds + PG8_SA(b, h) + aoff + m * 2048 + k * 1024); } while (0)
#define PG8_LDB(dst, b, h) do { _Pragma("unroll") for (int n = 0; n < 2; ++n) _Pragma("unroll") for (int k = 0; k < 2; ++k) dst[n][k] = *(const LAS bf16x8*)(lds + PG8_SB(b, h) + boff + n * 2048 + k * 1024); } while (0)
#define PG8_MMA(ai, bj, At, Bt) do { PG8_PRIO(1); _Pragma("unroll") for (int m = 0; m < 4; ++m) _Pragma("unroll") for (int n = 0; n < 2; ++n) _Pragma("unroll") for (int k = 0; k < 2; ++k) \
        acc[ai][bj][m][n] = mfma16(Bt[n][k], At[m][k], acc[ai][bj][m][n]); PG8_PRIO(0); } while (0)
    Unit cur, nxt; int ui = 0;
    if (!S.next(0, cur)) return;
    f32x4 acc[2][2][4][2];
#pragma unroll
    for (int a = 0; a < 2; ++a)
#pragma unroll
        for (int b = 0; b < 2; ++b)
#pragma unroll
            for (int m = 0; m < 4; ++m)
#pragma unroll
                for (int n = 0; n < 2; ++n) acc[a][b][m][n] = (f32x4){0.f, 0.f, 0.f, 0.f};
    bf16x8 At[4][2], B0[2][2], B1[2][2];
    const char* cA = (const char*)g.A + (size_t)cur.pm * tstep; const char* cB = (const char*)g.Bt + (size_t)cur.pn * tstep;
    PG8_STAGE(PG8_SB(0, 0), cB, voffB); PG8_STAGE(PG8_SB(0, 1), cB + hstep, voffB); PG8_STAGE(PG8_SA(0, 0), cA, voffA); PG8_STAGE(PG8_SA(0, 1), cA + hstep, voffA);
    if (wr == 1) PG8_BAR;
    PG8_WAIT_V(2); PG8_BAR;
    PG8_STAGE(PG8_SB(1, 0), cB + kstep, voffB); PG8_STAGE(PG8_SA(1, 0), cA + kstep, voffA); PG8_STAGE(PG8_SB(1, 1), cB + hstep + kstep, voffB);
    PG8_WAIT_V(6); PG8_BAR;
    for (;;) {
        const bool has_next = S.next(ui + 1, nxt);
        const char* nA = has_next ? (const char*)g.A + (size_t)nxt.pm * tstep : cA; const char* nB = has_next ? (const char*)g.Bt + (size_t)nxt.pn * tstep : cB;
        for (int t = 0; t < nt; t += 2) {
            const bool last = (t == nt - 2);
            const char* a1 = cA + (size_t)(t + 1) * kstep;
            const char* a2 = last ? nA : cA + (size_t)(t + 2) * kstep; const char* b2 = last ? nB : cB + (size_t)(t + 2) * kstep;
            const char* a3 = a2 + kstep; const char* b3 = b2 + kstep;
            PG8_LDB(B0, 0, 0); PG8_LDB(B1, 0, 1); PG8_SCHED; PG8_LDA(At, 0, 0); PG8_STAGE(PG8_SA(1, 1), a1 + hstep, voffA);
            PG8_WAIT_V(8); PG8_WAIT_L(0); PG8_BAR; PG8_MMA(0, 0, At, B0); PG8_MMA(0, 1, At, B1); PG8_BAR; PG8_SCHED;
            PG8_LDA(At, 0, 1); PG8_STAGE(PG8_SB(0, 0), b2, voffB); PG8_STAGE(PG8_SB(0, 1), b2 + hstep, voffB); PG8_STAGE(PG8_SA(0, 0), a2, voffA);
            PG8_WAIT_V(8); PG8_WAIT_L(0); PG8_BAR; PG8_MMA(1, 0, At, B0); PG8_MMA(1, 1, At, B1); PG8_BAR; PG8_SCHED;
            PG8_LDB(B0, 1, 0); PG8_LDB(B1, 1, 1); PG8_SCHED; PG8_LDA(At, 1, 0); PG8_STAGE(PG8_SA(0, 1), a2 + hstep, voffA);
            PG8_WAIT_V(8); PG8_WAIT_L(0); PG8_BAR; PG8_MMA(0, 0, At, B0); PG8_MMA(0, 1, At, B1); PG8_BAR; PG8_SCHED;
            PG8_LDA(At, 1, 1); PG8_STAGE(PG8_SB(1, 0), b3, voffB); PG8_STAGE(PG8_SB(1, 1), b3 + hstep, voffB); PG8_STAGE(PG8_SA(1, 0), a3, voffA);
            PG8_WAIT_V(8); PG8_WAIT_L(0); PG8_BAR; PG8_MMA(1, 0, At, B0); PG8_MMA(1, 1, At, B1); PG8_BAR; PG8_SCHED;
        }
        if (wr == 0) PG8_BAR;
        E(acc, cur, wr, wc, fr, fq);
        if (!has_next) break;
#pragma unroll
        for (int a = 0; a < 2; ++a)
#pragma unroll
            for (int b = 0; b < 2; ++b)
#pragma unroll
                for (int m = 0; m < 4; ++m)
#pragma unroll
                    for (int n = 0; n < 2; ++n) acc[a][b][m][n] = (f32x4){0.f, 0.f, 0.f, 0.f};
        cur = nxt; cA = nA; cB = nB; ++ui;
        if (wr == 1) PG8_BAR;
    }
    PG8_WAIT_V(0);
    PG8_BAR;
#undef PG8_SA
#undef PG8_SB
#undef PG8_STAGE
#undef PG8_LDA
#undef PG8_LDB
#undef PG8_MMA
}

struct EpiIn {
    static constexpr bool PERM = true;
    const float* sumsq; const float* shw; unsigned char* ws;
    MDEV void operator()(const f32x4 (&acc)[2][2][4][2], const Unit& u, int wr, int wc, int fr, int fq) const {
        const int pn = u.pn;
        bf16_t* base; int ld, cofs;
        if (pn < 2) { base = (bf16_t*)(ws + T_PGLAQK); ld = 512; cofs = pn * 256; }
        else if (pn < 4) { base = (bf16_t*)(ws + T_PGLAV); ld = 512; cofs = (pn - 2) * 256; }
        else if (pn < 6) { base = (bf16_t*)(ws + T_PG); ld = 1024; cofs = (pn - 4) * 256; }
        else if (pn < 12) { base = (bf16_t*)(ws + T_PGDN); ld = 1536; cofs = (pn - 6) * 256; }
        else if (pn < 14) { base = (bf16_t*)(ws + T_PG); ld = 1024; cofs = 512 + (pn - 12) * 256; }
        else { base = nullptr; ld = 0; cofs = 0; }
        const int lc = wc * 32 + 8 * fq;
        const int r0 = u.pm * BM + wr * 64 + fr;
        const int b9t = mod_of_row(u.pm * BM); const bool uni = b9t == mod_of_row(u.pm * BM + BM - 1);
        float ssv[2][4];
#pragma unroll
        for (int ai = 0; ai < 2; ++ai)
#pragma unroll
            for (int m = 0; m < 4; ++m) ssv[ai][m] = sumsq[r0 + ai * HALF + m * 16];
        f32x4 bv[2][2];
        { const float* sh = shw + (size_t)b9t * NP + pn * BM + lc;
#pragma unroll
          for (int bj = 0; bj < 2; ++bj) { bv[bj][0] = *(const f32x4*)(sh + bj * HALF); bv[bj][1] = *(const f32x4*)(sh + bj * HALF + 4); } }
#pragma unroll
        for (int ai = 0; ai < 2; ++ai)
#pragma unroll
            for (int m = 0; m < 4; ++m) {
                const int row = r0 + ai * HALF + m * 16;
                const float rstd = frsq(ssv[ai][m] * (1.0f / D) + EPSN);
                if (!uni) { const float* sh = shw + (size_t)mod_of_row(row) * NP + pn * BM + lc;
#pragma unroll
                    for (int bj = 0; bj < 2; ++bj) { bv[bj][0] = *(const f32x4*)(sh + bj * HALF); bv[bj][1] = *(const f32x4*)(sh + bj * HALF + 4); } }
                if (base) {
#pragma unroll
                    for (int bj = 0; bj < 2; ++bj) {
                        const f32x4 v0 = acc[ai][bj][m][0] * rstd + bv[bj][0], v1 = acc[ai][bj][m][1] * rstd + bv[bj][1];
                        u32x4 w; w.x = cvt_pk_bf16(v0[0], v0[1]); w.y = cvt_pk_bf16(v0[2], v0[3]); w.z = cvt_pk_bf16(v1[0], v1[1]); w.w = cvt_pk_bf16(v1[2], v1[3]);
                        *(u32x4*)(base + (size_t)row * ld + cofs + lc + bj * HALF) = w;
                    }
                } else if (wc == 0) {
                    float* gp = (float*)(ws + WS_GATE) + (size_t)row * 32 + lc;
                    *(f32x4*)gp = acc[ai][0][m][0] * rstd + bv[0][0]; *(f32x4*)(gp + 4) = acc[ai][0][m][1] * rstd + bv[0][1];
                }
            }
    }
};
struct EpiFF1 {
    static constexpr bool PERM = true;
    const float* sumsq; const float* shw; bf16_t* hid;
    MDEV void operator()(const f32x4 (&acc)[2][2][4][2], const Unit& u, int wr, int wc, int fr, int fq) const {
        const int c0 = u.pn * BM + wc * 32 + 8 * fq;
        const int r0 = u.pm * BM + wr * 64 + fr;
        const int b9t = mod_of_row(u.pm * BM); const bool uni = b9t == mod_of_row(u.pm * BM + BM - 1);
        float ssv[2][4];
#pragma unroll
        for (int ai = 0; ai < 2; ++ai)
#pragma unroll
            for (int m = 0; m < 4; ++m) ssv[ai][m] = sumsq[r0 + ai * HALF + m * 16];
        f32x4 bv[2][2];
        { const float* sh = shw + (size_t)b9t * FF + c0;
#pragma unroll
          for (int bj = 0; bj < 2; ++bj) { bv[bj][0] = *(const f32x4*)(sh + bj * HALF); bv[bj][1] = *(const f32x4*)(sh + bj * HALF + 4); } }
#pragma unroll
        for (int ai = 0; ai < 2; ++ai)
#pragma unroll
            for (int m = 0; m < 4; ++m) {
                const int row = r0 + ai * HALF + m * 16;
                const float rstd = frsq(ssv[ai][m] * (1.0f / D) + EPSN);
                if (!uni) { const float* sh = shw + (size_t)mod_of_row(row) * FF + c0;
#pragma unroll
                    for (int bj = 0; bj < 2; ++bj) { bv[bj][0] = *(const f32x4*)(sh + bj * HALF); bv[bj][1] = *(const f32x4*)(sh + bj * HALF + 4); } }
#pragma unroll
                for (int bj = 0; bj < 2; ++bj) {
                    f32x4 v0 = acc[ai][bj][m][0] * rstd + bv[bj][0], v1 = acc[ai][bj][m][1] * rstd + bv[bj][1];
#pragma unroll
                    for (int e = 0; e < 4; ++e) { const float a = fmaxf(v0[e], 0.f), b = fmaxf(v1[e], 0.f); v0[e] = a * a; v1[e] = b * b; }
                    u32x4 w; w.x = cvt_pk_bf16(v0[0], v0[1]); w.y = cvt_pk_bf16(v0[2], v0[3]); w.z = cvt_pk_bf16(v1[0], v1[1]); w.w = cvt_pk_bf16(v1[2], v1[3]);
                    *(u32x4*)(hid + (size_t)row * FF + c0 + bj * HALF) = w;
                }
            }
    }
};
struct EpiRes {
    static constexpr bool PERM = false;
    const float* res_lat; const float* res_ctx;
    float* out_lat; float* out_ctx;
    const float* gt;
    const float* gsn;
    bf16_t* anext; float* ssn;
    MDEV void operator()(const f32x4 (&acc)[2][2][4][2], const Unit& u, int wr, int wc, int fr, int fq) const {
        const int c0 = u.pn * BM + wc * 32 + 4 * fq;
        float part[2][4];
        const int b9t = mod_of_row(u.pm * BM); const bool uni = b9t == mod_of_row(u.pm * BM + BM - 1);
        f32x4 gtv[2][2], gsv[2][2];
#pragma unroll
        for (int bj = 0; bj < 2; ++bj)
#pragma unroll
            for (int n = 0; n < 2; ++n) { const int col = c0 + bj * HALF + n * 16;
                gtv[bj][n] = *(const f32x4*)(gt + (size_t)b9t * 6 * D + col); gsv[bj][n] = gsn ? *(const f32x4*)(gsn + (size_t)b9t * D + col) : (f32x4){0.f, 0.f, 0.f, 0.f}; }
#pragma unroll
        for (int aim = 0; aim < 4; ++aim) {
            const int ai = aim >> 1;
            f32x4 rv[2][2][2];
#pragma unroll
            for (int m2 = 0; m2 < 2; ++m2) { const int m = 2 * (aim & 1) + m2; const int row = u.pm * BM + ai * HALF + wr * 64 + m * 16 + fr;
                const float* rp = row < RL ? res_lat + (size_t)row * D : res_ctx + (size_t)(row - RL) * D;
#pragma unroll
                for (int bj = 0; bj < 2; ++bj)
#pragma unroll
                    for (int n = 0; n < 2; ++n) rv[m2][bj][n] = *(const f32x4*)(rp + c0 + bj * HALF + n * 16); }
#pragma unroll
            for (int m2 = 0; m2 < 2; ++m2) {
                const int m = 2 * (aim & 1) + m2;
                const int row = u.pm * BM + ai * HALF + wr * 64 + m * 16 + fr;
                float* op = row < RL ? out_lat + (size_t)row * D : out_ctx + (size_t)(row - RL) * D;
                if (!uni) { const int b9 = mod_of_row(row);
#pragma unroll
                    for (int bj = 0; bj < 2; ++bj)
#pragma unroll
                        for (int n = 0; n < 2; ++n) { const int col = c0 + bj * HALF + n * 16;
                            gtv[bj][n] = *(const f32x4*)(gt + (size_t)b9 * 6 * D + col); if (gsn) gsv[bj][n] = *(const f32x4*)(gsn + (size_t)b9 * D + col); } }
                float s = 0.f;
#pragma unroll
                for (int bj = 0; bj < 2; ++bj)
#pragma unroll
                    for (int n = 0; n < 2; ++n) {
                        const int col = c0 + bj * HALF + n * 16;
                        const f32x4 xn = rv[m2][bj][n] + gtv[bj][n] * acc[ai][bj][m][n];
                        *(f32x4*)(op + col) = xn;
                        s += (xn[0] * xn[0] + xn[1] * xn[1]) + (xn[2] * xn[2] + xn[3] * xn[3]);
                        if (gsn) { const f32x4 gs = gsv[bj][n]; u32x2 w; w.x = cvt_pk_bf16(xn[0] * gs[0], xn[1] * gs[1]); w.y = cvt_pk_bf16(xn[2] * gs[2], xn[3] * gs[3]);
                            *(u32x2*)(anext + (size_t)row * D + col) = w; }
                    }
                part[ai][m] = s;
            }
        }
        if (ssn) {
#pragma unroll
            for (int ai = 0; ai < 2; ++ai) {
                float v[4];
#pragma unroll
                for (int m = 0; m < 4; ++m) { float s = part[ai][m]; s += wshfl_xor(s, 16); s += wshfl_xor(s, 32); v[m] = s; }
                const float mine = fq == 0 ? v[0] : fq == 1 ? v[1] : fq == 2 ? v[2] : v[3];
                atomic_addf(ssn + u.pm * BM + ai * HALF + wr * 64 + fq * 16 + fr, mine);
            }
        }
    }
};
}

DEV int swz256(int row, int chunk16) { return row * 256 + (((chunk16) ^ (row & 15)) << 4); }
DEV bf16_t* gdn_qkvn_row(unsigned char* ws, int row) {
    return row < RL ? (bf16_t*)(ws + T_PGDN) + (size_t)row * 1536 : (bf16_t*)(ws + WS_QKVNC) + (size_t)(row - RL) * 1536;
}
#ifndef EMU
DEV unsigned row_ror1(unsigned v) { return (unsigned)__builtin_amdgcn_update_dpp(0, (int)v, 0x121, 0xf, 0xf, false); }
DEV unsigned row_ror15(unsigned v) { return (unsigned)__builtin_amdgcn_update_dpp(0, (int)v, 0x12f, 0xf, 0xf, false); }
#else
DEV unsigned row_ror1(unsigned v) { const int l = threadIdx.x & 63; return __builtin_bit_cast(unsigned, emu_shfl(__builtin_bit_cast(float, v), (l & ~15) | ((l - 1) & 15))); }
DEV unsigned row_ror15(unsigned v) { const int l = threadIdx.x & 63; return __builtin_bit_cast(unsigned, emu_shfl(__builtin_bit_cast(float, v), (l & ~15) | ((l + 1) & 15))); }
#endif
DEV u32x4 ror1x4(const u32x4 v) { const unsigned a = v.x, b = v.y, c = v.z, d = v.w; u32x4 r; r.x = row_ror1(a); r.y = row_ror1(b); r.z = row_ror1(c); r.w = row_ror1(d); return r; }
DEV u32x4 ror15x4(const u32x4 v) { const unsigned a = v.x, b = v.y, c = v.z, d = v.w; u32x4 r; r.x = row_ror15(a); r.y = row_ror15(b); r.z = row_ror15(c); r.w = row_ror15(d); return r; }
DEV u32x4 shfl4(const u32x4 v, int src) {
    const unsigned a = v.x, b = v.y, c = v.z, d = v.w;
    u32x4 r;
    r.x = __builtin_bit_cast(unsigned, wshfl(__builtin_bit_cast(float, a), src));
    r.y = __builtin_bit_cast(unsigned, wshfl(__builtin_bit_cast(float, b), src));
    r.z = __builtin_bit_cast(unsigned, wshfl(__builtin_bit_cast(float, c), src));
    r.w = __builtin_bit_cast(unsigned, wshfl(__builtin_bit_cast(float, d), src));
    return r;
}
DEV void gdn_conv_unit(const Params& P, const LAS float* cwl, int l, int gc, int h, int part, int lane) {
    const int fr = lane & 15, fq = lane >> 4;
    const int row0 = gc * 64; const bool is_ctx = row0 >= RL;
    const bf16_t* raw = (const bf16_t*)(P.ws + T_PGDN) + part * 512 + h * 128 + 8 * fq;
    u32x4 c0[4][4], hp[4], hn[4];
#pragma unroll
    for (int it = 0; it < 4; ++it)
#pragma unroll
        for (int s4 = 0; s4 < 4; ++s4) c0[it][s4] = *(const u32x4*)(raw + (size_t)(row0 + 16 * it + fr) * 1536 + 32 * s4);
    { bool hasp = false, hasn = false;
      if (is_ctx) { const int pos0 = (row0 - RL) % CTX; hasp = pos0 > 0; hasn = pos0 + 64 < CTX; }
      const unsigned mp = hasp ? 0xffffffffu : 0u, mn = hasn ? 0xffffffffu : 0u;
      const bf16_t* rp = raw + (size_t)(hasp ? row0 - 1 : row0) * 1536; const bf16_t* rn = raw + (size_t)(hasn ? row0 + 64 : row0) * 1536;
#pragma unroll
      for (int s4 = 0; s4 < 4; ++s4) { hp[s4] = *(const u32x4*)(rp + 32 * s4) & mp; hn[s4] = *(const u32x4*)(rn + 32 * s4) & mn; } }
    const LAS float* cwp = cwl + part * 512 + h * 128 + 8 * fq;
#pragma unroll
    for (int it = 0; it < 4; ++it) {
        float y[4][8]; float ssq = 0.f;
#pragma unroll
        for (int s4 = 0; s4 < 4; ++s4) {
            const u32x4 up = ror1x4(c0[it][s4]), dn = ror15x4(c0[it][s4]);
            u32x4 upb, dnb;
            if (it > 0) upb = ror1x4(c0[it > 0 ? it - 1 : 0][s4]); else upb = hp[s4];
            if (it < 3) dnb = ror15x4(c0[it < 3 ? it + 1 : 3][s4]); else dnb = hn[s4];
            const u32x4 cm = fr > 0 ? up : upb, cp = fr < 15 ? dn : dnb, cc = c0[it][s4];
            const LAS float* cw = cwp + 32 * s4;
            f32x4 w0[2], w1[2], w2[2];
#pragma unroll
            for (int e = 0; e < 2; ++e) { w0[e] = *(const LAS f32x4*)(cw + 4 * e); w1[e] = *(const LAS f32x4*)(cw + 1536 + 4 * e); w2[e] = *(const LAS f32x4*)(cw + 3072 + 4 * e); }
#pragma unroll
            for (int j = 0; j < 4; ++j) {
                const int e = j >> 1, o = (j & 1) * 2;
                const float a = w0[e][o] * bflo(cm[j]) + w1[e][o] * bflo(cc[j]) + w2[e][o] * bflo(cp[j]);
                const float b = w0[e][o + 1] * bfhi(cm[j]) + w1[e][o + 1] * bfhi(cc[j]) + w2[e][o + 1] * bfhi(cp[j]);
                const float sa = silu_f(a), sb = silu_f(b);
                y[s4][2 * j] = sa; y[s4][2 * j + 1] = sb; ssq += sa * sa + sb * sb;
            }
        }
        float scale = 1.f;
        if (part < 2) { ssq += wshfl_xor(ssq, 16); ssq += wshfl_xor(ssq, 32); scale = 1.0f / sqrtf(ssq + EPSN); if (part == 0) scale *= 0.08838834764831845f; }
        bf16_t* orow = gdn_qkvn_row(P.ws, row0 + 16 * it + fr) + part * 512 + h * 128 + 8 * fq;
#pragma unroll
        for (int s4 = 0; s4 < 4; ++s4) { u32x4 w;
#pragma unroll
            for (int j = 0; j < 4; ++j) w[j] = pk2(y[s4][2 * j] * scale, y[s4][2 * j + 1] * scale);
            *(u32x4*)(orow + 32 * s4) = w; }
        SCHED_FENCE();
    }
}
DEV void gdn_mat_unit(const Params& P, LAS unsigned char* slot, LAS float* gb, int l, int gc, int h, int dir, int lane) {
    const int fr = lane & 15, fq = lane >> 4;
    const int row0 = gc * 64;
    unsigned char* item = P.ws + T_TAQK + (size_t)((gc * 4 + h) * 2 + dir) * TAQK_ITEM;
    bf16x8 Qf[4][4], Kf[4][4];
    { const bf16_t* qn0 = gdn_qkvn_row(P.ws, row0 + fr) + h * 128 + 8 * fq;
#pragma unroll
      for (int it = 0; it < 4; ++it)
#pragma unroll
        for (int s4 = 0; s4 < 4; ++s4) { Qf[it][s4] = *(const bf16x8*)(qn0 + (size_t)it * 16 * 1536 + 32 * s4); Kf[it][s4] = *(const bf16x8*)(qn0 + 512 + (size_t)it * 16 * 1536 + 32 * s4); } }
    { const int tok = dir ? 63 - lane : lane;
      const float* gr = (const float*)(P.ws + WS_GATE) + (size_t)(row0 + tok) * 32;
      const float av = gr[16 + dir * 4 + h], bbv = gr[24 + dir * 4 + h];
      const float la = -fexp(P.gdn_a_log[(l * 2 + dir) * 4 + h]) * softplus_f(av + P.gdn_dt_bias[(l * 2 + dir) * 4 + h]);
      const float beta = sigmoid_f(bbv);
      float g = la;
#pragma unroll
      for (int o = 1; o < 64; o <<= 1) { const float t = wshfl_up(g, o); if (lane >= o) g += t; }
      const float gl = wshfl(g, 63);
      gb[tok] = g; gb[64 + tok] = beta;
      float* sc = (float*)(item + 16384);
      sc[tok] = fexp(g); sc[64 + tok] = fexp(gl - g); sc[128 + tok] = beta; sc[192 + tok] = fexp(gl); }
    wave_sync();
    float gi[4][4], bi[4][4], gjv[4];
#pragma unroll
    for (int it = 0; it < 4; ++it) { const f32x4 gv = *(const LAS f32x4*)(gb + 16 * it + 4 * fq), bv = *(const LAS f32x4*)(gb + 64 + 16 * it + 4 * fq);
#pragma unroll
        for (int r = 0; r < 4; ++r) { gi[it][r] = gv[r]; bi[it][r] = bv[r]; } }
#pragma unroll
    for (int jt = 0; jt < 4; ++jt) gjv[jt] = gb[16 * jt + fr];
#pragma unroll
    for (int it = 0; it < 4; ++it)
#pragma unroll
        for (int jt = 0; jt < 4; ++jt) {
            f32x4 c = {0.f, 0.f, 0.f, 0.f};
            if (dir ? jt >= it : jt <= it) {
#pragma unroll
            for (int s4 = 0; s4 < 4; ++s4) c = mfma16(Qf[it][s4], Kf[jt][s4], c);
            }
            const int j = 16 * jt + fr; const float gj = gjv[jt];
#pragma unroll
            for (int r = 0; r < 4; ++r) { const int i = 16 * it + 4 * fq + r; const bool keep = dir ? j >= i : j <= i;
                const float v = c[r] * fexp(fminf(gi[it][r] - gj, 0.f)) * (keep ? 1.f : 0.f);
                *(LAS bf16_t*)(slot + (i * 64 + j) * 2) = (bf16_t)f2bf(v); }
        }
    wave_sync();
#pragma unroll 1
    for (int q = 0; q < 8; ++q) { const int off = (lane + 64 * q) * 16; *(u32x4*)(item + 8192 + off) = *(const LAS u32x4*)(slot + off); }
    wave_sync();
    LAS float* W = (LAS float*)slot;
#pragma unroll
    for (int it = 0; it < 4; ++it)
#pragma unroll
        for (int jt = 0; jt < 4; ++jt) {
            f32x4 c = {0.f, 0.f, 0.f, 0.f};
            if (dir ? jt >= it : jt <= it) {
#pragma unroll
            for (int s4 = 0; s4 < 4; ++s4) c = mfma16(Kf[it][s4], Kf[jt][s4], c);
            }
            const int j = 16 * jt + fr, jp = dir ? 63 - j : j; const float gj = gjv[jt];
#pragma unroll
            for (int r = 0; r < 4; ++r) { const int i = 16 * it + 4 * fq + r, ip = dir ? 63 - i : i;
                W[jp * 64 + ip] = bi[it][r] * c[r] * fexp(fminf(gi[it][r] - gj, 0.f)) * (jp < ip ? 1.f : 0.f); }
        }
    wave_sync();
    const int nj = dir ? 63 - lane : lane;
#pragma unroll
    for (int bk = 0; bk < 4; ++bk) {
        if (bk > 0) {
#pragma unroll
            for (int nt = 0; nt < bk; ++nt) {
                f32x4 acc = {0.f, 0.f, 0.f, 0.f};
#pragma unroll
                for (int m0 = 16 * nt; m0 < 16 * bk; m0 += 4) {
                    const int m = m0 + fq;
                    const float av = W[m * 64 + 16 * bk + fr];
                    const float xv = W[m * 64 + 16 * nt + fr];
                    const float bvv = (16 * nt + fr <= m) ? xv : 0.f;
                    acc = mfma4f32(av, bvv, acc);
                }
                wave_sync();
#pragma unroll
                for (int r = 0; r < 4; ++r) W[(16 * bk + 4 * fq + r) * 64 + 16 * nt + fr] = acc[r];
            }
            wave_sync();
        }
        float v[16];
#pragma unroll
        for (int r = 0; r < 16; ++r) { const float a = (bk > 0 && lane < 16 * bk) ? W[(16 * bk + r) * 64 + lane] : 0.f; v[r] = ((16 * bk + r == lane) ? 1.f : 0.f) - a; }
#pragma unroll
        for (int rp = 0; rp < 15; ++rp) {
            const float xp = v[rp];
            const LAS float* lrow = W + (16 * bk + rp) * 64 + 16 * bk;
#pragma unroll
            for (int q4 = (rp + 1) / 4; q4 < 4; ++q4) { const f32x4 lv = *(const LAS f32x4*)(lrow + 4 * q4);
#pragma unroll
                for (int e = 0; e < 4; ++e) if (4 * q4 + e > rp) v[4 * q4 + e] -= lv[e] * xp; }
        }
        wave_sync();
#pragma unroll
        for (int r = 0; r < 16; ++r) if (lane <= 16 * bk + r) W[(16 * bk + r) * 64 + lane] = v[r];
        wave_sync();
    }
    float x[64];
#pragma unroll
    for (int i = 0; i < 64; ++i) x[i] = lane <= i ? W[i * 64 + lane] : 0.f;
    wave_sync();
#pragma unroll
    for (int i = 0; i < 64; ++i) { const int ni = dir ? 63 - i : i; *(LAS bf16_t*)(slot + (ni * 64 + nj) * 2) = (bf16_t)f2bf(x[i]); }
    wave_sync();
#pragma unroll 1
    for (int q = 0; q < 8; ++q) { const int off = (lane + 64 * q) * 16; *(u32x4*)(item + off) = *(const LAS u32x4*)(slot + off); }
    wave_sync();
}
constexpr int PREP_CW = 0, PREP_SLOT0 = 18432, PREP_SLOT_STRIDE = 17408;
constexpr size_t CTL_QUEUE_OFS = 20480;
DEV int queue_pull(const Params& P, int inst, int vb, int first, int total, int lane) {
    unsigned* head = (unsigned*)(P.ws + WS_CTL + CTL_QUEUE_OFS + (size_t)(inst * 8 + (vb & 7)) * 256);
    unsigned k = 0;
#ifndef EMU
    if (lane == 0) k = __hip_atomic_fetch_add(head, 1u, __ATOMIC_RELAXED, __HIP_MEMORY_SCOPE_AGENT);
    k = (unsigned)__builtin_amdgcn_readfirstlane((int)k);
#else
    if (lane == 0) k = __atomic_fetch_add(head, 1u, __ATOMIC_SEQ_CST);
    k = __builtin_bit_cast(unsigned, wshfl(__builtin_bit_cast(float, k), 0));
#endif
    const long u = (long)first + (vb & 7) + 8l * k;
    return u < total ? (int)u : -1;
}
constexpr int GDN_ITEMS = NB * 16, GLA_ITEMS = NB * 8;
DEV void phase_prep_a(const Params& P, LAS unsigned char* lds, int l, int vb, int nvb) {
    const int tid = tidx(), wave = uniform_i(tid >> 6), lane = tid & 63;
    LAS float* cwl = (LAS float*)(lds + PREP_CW);
    { float tmp[9];
#pragma unroll
      for (int u = 0; u < 9; ++u) tmp[u] = P.gdn_conv_w[(size_t)l * 3 * 1536 + tid + u * NT];
#pragma unroll
      for (int u = 0; u < 9; ++u) cwl[tid + u * NT] = tmp[u]; }
    block_sync();
#pragma unroll 1
    for (int it = vb * NWAVE + wave; it >= 0 && it < NCH * 12; it = queue_pull(P, 2 * l, vb, nvb * NWAVE, NCH * 12, lane)) { const int part = it % 3, gh = it / 3; gdn_conv_unit(P, cwl, l, gh >> 2, gh & 3, part, opaque_i(lane)); }
    block_sync();
    if (l == 1 && nvb <= GDN_ITEMS + GLA_ITEMS) convert_weights(P, lds, vb, nvb, 1);
}
DEV void phase_prep_b(const Params& P, LAS unsigned char* lds, int l, int vb, int nvb) {
    const int tid = tidx(), wave = uniform_i(tid >> 6), lane = tid & 63;
    LAS unsigned char* slot = lds + wave * PREP_SLOT_STRIDE;
#pragma unroll 1
    for (int it = vb * NWAVE + wave; it >= 0 && it < NCH * 8; it = queue_pull(P, 2 * l + 1, vb, nvb * NWAVE, NCH * 8, lane)) gdn_mat_unit(P, slot, (LAS float*)(slot + 16384), l, it >> 3, (it >> 1) & 3, it & 1, opaque_i(lane));
    block_sync();
}

DEV int swz128(int row, int chunk16) { return row * 128 + (((chunk16) ^ ((row >> 1) & 7)) << 4); }
DEV bf16x8 pack_bf8(const f32x4& a, const f32x4& b) {
    u32x4 w; w.x = pk2(a[0], a[1]); w.y = pk2(a[2], a[3]); w.z = pk2(b[0], b[1]); w.w = pk2(b[2], b[3]); return __builtin_bit_cast(bf16x8, w);
}
DEV bf16x8 join_s4(const s16x4& a, const s16x4& b) { return (bf16x8){a[0], a[1], a[2], a[3], b[0], b[1], b[2], b[3]}; }
DEV bf16x8 afrag_pi256(const LAS unsigned char* tile, int row, int s, int fq) {
    const u32x2 lo = *(const LAS u32x2*)(tile + swz256(row, 4 * s + (fq >> 1)) + (fq & 1) * 8);
    const u32x2 hi = *(const LAS u32x2*)(tile + swz256(row, 4 * s + 2 + (fq >> 1)) + (fq & 1) * 8);
    return __builtin_bit_cast(bf16x8, (u32x4){lo.x, lo.y, hi.x, hi.y});
}
DEV bf16x8 afrag_pi128(const LAS unsigned char* tile, int row, int s, int fq) {
    const u32x2 lo = *(const LAS u32x2*)(tile + swz128(row, 4 * s + (fq >> 1)) + (fq & 1) * 8);
    const u32x2 hi = *(const LAS u32x2*)(tile + swz128(row, 4 * s + 2 + (fq >> 1)) + (fq & 1) * 8);
    return __builtin_bit_cast(bf16x8, (u32x4){lo.x, lo.y, hi.x, hi.y});
}
constexpr int GB_K = 0, GB_Q = 16384, GB_T = 32768, GB_AQ = 40960, GB_V = 49152, GB_SC = 57344, GB_SIZE = 58368;

DEV void gdn_chunk_of_step(int b, int dir, int s, int& gc) {
    if (s < NCC) { const int c = dir ? NCC - 1 - s : s; gc = RL / 64 + b * NCC + c; }
    else { const int c2 = s - NCC; const int c = dir ? NCL - 1 - c2 : c2; gc = b * NCL + c; }
}
DEV void gdn_issue_loads(const Params& P, LAS unsigned char* buf, int lw, int lane, int gc, int h, int dir, int dvh);
DEV void gdn_issue_loads(const Params& P, LAS unsigned char* buf, int lw, int lane, int gc, int h, int dir, int dvh) {
    const int row0 = gc * 64;
    const unsigned char* item = P.ws + T_TAQK + (size_t)((gc * 4 + h) * 2 + dir) * TAQK_ITEM;
#pragma unroll
    for (int jj = 0; jj < 4; ++jj) { const int j = 4 * jj + lw, r = 4 * j + (lane >> 4), ch = (lane & 15) ^ (r & 15);
        const bf16_t* rp = gdn_qkvn_row(P.ws, row0 + r) + h * 128 + ch * 8;
        pg8::glds16(rp, buf + GB_Q + 1024 * j); pg8::glds16(rp + 512, buf + GB_K + 1024 * j); }
#pragma unroll
    for (int jj = 0; jj < 2; ++jj) { const int j = 4 * jj + lw, r = 8 * j + (lane >> 3), pos = lane & 7, ch = pos ^ ((r >> 1) & 7);
        pg8::glds16(item + (r * 64 + ch * 8) * 2, buf + GB_T + 1024 * j); pg8::glds16(item + 8192 + (r * 64 + ch * 8) * 2, buf + GB_AQ + 1024 * j);
        pg8::glds16(gdn_qkvn_row(P.ws, row0 + r) + 1024 + h * 128 + dvh * 64 + pos * 8, buf + GB_V + 1024 * j); }
    if (lw == 0) pg8::glds16(item + 16384 + lane * 16, buf + GB_SC);
}
DEV void gdn_scan_item(const Params& P, LAS unsigned char* lds, int item, bool ctx_out) {
    const int tid = tidx(), wave = uniform_i(tid >> 6), lane0 = tid & 63;
    const int b = item % NB, rest = item / NB, h = rest >> 2, dir = (rest >> 1) & 1, dvh = rest & 1;
    constexpr int NS = NCC + NCL;
    const bool loader = wave >= 4; const int lw = wave - 4;
    int gc;
    if (loader) { gdn_chunk_of_step(b, dir, 0, gc); gdn_issue_loads(P, lds, lw, lane0, gc, h, dir, dvh); }
    f32x4 S[8];
#pragma unroll
    for (int i = 0; i < 8; ++i) S[i] = (f32x4){0.f, 0.f, 0.f, 0.f};
    if (loader) VM_DRAIN();
    RAW_BAR();
    for (int s = 0; s < NS; ++s) {
        LAS unsigned char* buf = lds + (s & 1) * GB_SIZE;
        if (loader) {
            if (s + 1 < NS) { gdn_chunk_of_step(b, dir, s + 1, gc); gdn_issue_loads(P, lds + ((s + 1) & 1) * GB_SIZE, lw, opaque_i(lane0), gc, h, dir, dvh); }
        } else {
            gdn_chunk_of_step(b, dir, s, gc);
            const int row0 = gc * 64, n0 = 16 * wave;
            const int lane = opaque_i(lane0), fr = lane & 15, fq = lane >> 4;
            const LAS float* SC = (const LAS float*)(buf + GB_SC);
            bf16x8 Sb[4];
#pragma unroll
            for (int k = 0; k < 4; ++k) Sb[k] = pack_bf8(S[2 * k], S[2 * k + 1]);
            f32x4 rr[4];
            { bf16x8 Af[4][4];
#pragma unroll
              for (int mt = 0; mt < 4; ++mt)
#pragma unroll
                for (int k = 0; k < 4; ++k) Af[mt][k] = afrag_pi256(buf + GB_K, 16 * mt + fr, k, fq);
              f32x4 acc[4];
#pragma unroll
              for (int mt = 0; mt < 4; ++mt) acc[mt] = (f32x4){0.f, 0.f, 0.f, 0.f};
#pragma unroll
              for (int k = 0; k < 4; ++k)
#pragma unroll
                for (int mt = 0; mt < 4; ++mt) acc[mt] = mfma16(Af[mt][k], Sb[k], acc[mt]);
#pragma unroll
              for (int mt = 0; mt < 4; ++mt) {
                const f32x4 eg = *(const LAS f32x4*)(SC + 16 * mt + 4 * fq), be = *(const LAS f32x4*)(SC + 128 + 16 * mt + 4 * fq);
#pragma unroll
                for (int j = 0; j < 4; ++j) { const float v = bf2f(*(const LAS bf16_t*)(buf + GB_V + (16 * mt + 4 * fq + j) * 128 + (n0 + fr) * 2)); rr[mt][j] = be[j] * (v - eg[j] * acc[mt][j]); }
              } }
            SCHED_FENCE();
            bf16x8 Rb[2] = {pack_bf8(rr[0], rr[1]), pack_bf8(rr[2], rr[3])};
            f32x4 dl[4];
            { bf16x8 Tf[4][2];
#pragma unroll
              for (int it = 0; it < 4; ++it)
#pragma unroll
                for (int k = 0; k < 2; ++k) Tf[it][k] = afrag_pi128(buf + GB_T, 16 * it + fr, k, fq);
#pragma unroll
              for (int it = 0; it < 4; ++it) dl[it] = (f32x4){0.f, 0.f, 0.f, 0.f};
#pragma unroll
              for (int k = 0; k < 2; ++k)
#pragma unroll
                for (int it = 0; it < 4; ++it) dl[it] = mfma16(Tf[it][k], Rb[k], dl[it]); }
            SCHED_FENCE();
            bf16x8 Db[2] = {pack_bf8(dl[0], dl[1]), pack_bf8(dl[2], dl[3])};
            { f32x4 ds[4];
#pragma unroll
              for (int mt = 0; mt < 4; ++mt) { const f32x4 el = *(const LAS f32x4*)(SC + 64 + 16 * mt + 4 * fq); ds[mt] = dl[mt] * el; }
              bf16x8 Dp[2] = {pack_bf8(ds[0], ds[1]), pack_bf8(ds[2], ds[3])};
              const float ach = SC[192];
#pragma unroll
              for (int dkt = 0; dkt < 8; ++dkt) S[dkt] = S[dkt] * ach;
#pragma unroll
              for (int hf = 0; hf < 2; ++hf) {
                  bf16x8 Kt[4][2];
#pragma unroll
                  for (int d4 = 0; d4 < 4; ++d4)
#pragma unroll
                    for (int k = 0; k < 2; ++k) {
                        const int dkt = 4 * hf + d4;
                        const int row = 32 * k + 4 * fq + ((lane >> 2) & 3), ch = 2 * dkt + ((lane & 3) >> 1), off = (lane & 1) * 8;
                        Kt[d4][k] = join_s4(lds_tr16(buf + GB_K + swz256(row, ch) + off), lds_tr16(buf + GB_K + swz256(row + 16, ch) + off));
                    }
#pragma unroll
                  for (int k = 0; k < 2; ++k)
#pragma unroll
                    for (int d4 = 0; d4 < 4; ++d4) S[4 * hf + d4] = mfma16(Kt[d4][k], Dp[k], S[4 * hf + d4]);
                  SCHED_FENCE();
              } }
            SCHED_FENCE();
            const bool want_o = ctx_out || row0 < RL;
            if (want_o) {
                LAS unsigned char* ost = lds + 2 * GB_SIZE + wave * 2048;
                f32x4 oa[4];
                { bf16x8 Qf[4][4];
#pragma unroll
                  for (int it = 0; it < 4; ++it)
#pragma unroll
                    for (int k = 0; k < 4; ++k) Qf[it][k] = afrag_pi256(buf + GB_Q, 16 * it + fr, k, fq);
#pragma unroll
                  for (int it = 0; it < 4; ++it) oa[it] = (f32x4){0.f, 0.f, 0.f, 0.f};
#pragma unroll
                  for (int k = 0; k < 4; ++k)
#pragma unroll
                    for (int it = 0; it < 4; ++it) oa[it] = mfma16(Qf[it][k], Sb[k], oa[it]); }
                SCHED_FENCE();
                { bf16x8 Gf[4][2];
#pragma unroll
                  for (int it = 0; it < 4; ++it)
#pragma unroll
                    for (int k = 0; k < 2; ++k) Gf[it][k] = afrag_pi128(buf + GB_AQ, 16 * it + fr, k, fq);
#pragma unroll
                  for (int it = 0; it < 4; ++it) oa[it] = oa[it] * *(const LAS f32x4*)(SC + 16 * it + 4 * fq);
#pragma unroll
                  for (int k = 0; k < 2; ++k)
#pragma unroll
                    for (int it = 0; it < 4; ++it) oa[it] = mfma16(Gf[it][k], Db[k], oa[it]); }
#pragma unroll
                for (int it = 0; it < 4; ++it)
#pragma unroll
                    for (int j = 0; j < 4; ++j) *(LAS bf16_t*)(ost + (16 * it + 4 * fq + j) * 32 + fr * 2) = (bf16_t)f2bf(oa[it][j]);
                wave_sync();
                bf16_t* og = (bf16_t*)(P.ws + T_OGDN) + ((size_t)dir * ROWS + row0) * 512 + h * 128 + dvh * 64 + n0;
#pragma unroll
                for (int i = 0; i < 2; ++i) { const int c = lane + 64 * i, row = c >> 1, half = c & 1;
                    *(u32x4*)(og + (size_t)row * 512 + half * 8) = *(const LAS u32x4*)(ost + row * 32 + half * 16); }
            }
        }
        if (loader) VM_DRAIN(); else LGKM_DRAIN();
        RAW_BAR();
    }
    VM_DRAIN(); block_sync();
}

constexpr int GL_RAW = 0, GL_RA = 32768, GL_V = 40960, GL_QK = 73728, GL_P = 106496, GL_VEC = 114688, GL_OST = 116736;
struct GlaDmaOff { unsigned qk[2], v[4], ra; };
DEV void gla_dma_offsets(GlaDmaOff& o, int pw, int lane) {
#pragma unroll
    for (int jj = 0; jj < 2; ++jj) { const int j = 4 * jj + pw, r = 8 * j + (lane >> 3), ch = (lane & 7) ^ ((r >> 1) & 7); o.qk[jj] = (unsigned)(r * 512 + ch * 8) * 2u; }
#pragma unroll
    for (int jj = 0; jj < 4; ++jj) { const int j = 4 * jj + pw, r = 4 * j + (lane >> 4), ch = (lane & 15) ^ (r & 15); o.v[jj] = (unsigned)(r * 512 + ch * 8) * 2u; }
    { const int idx = pw * 64 + lane, r = idx >> 2, c4 = idx & 3; o.ra = (unsigned)(r * 32 + c4 * 4) * 4u; }
}
DEV void gla_issue_raw(const Params& P, LAS unsigned char* lds, int slot, int pw, const GlaDmaOff& o, int gc, int h) {
    const size_t row0 = (size_t)gc * 64;
    const unsigned char* qk = P.ws + T_PGLAQK + (row0 * 512 + h * 64) * 2;
    LAS unsigned char* dst = lds + GL_RAW + slot * 16384;
#pragma unroll
    for (int jj = 0; jj < 2; ++jj) { const int j = 4 * jj + pw; pg8::glds16(qk + o.qk[jj], dst + 1024 * j); pg8::glds16(qk + 512 + o.qk[jj], dst + 8192 + 1024 * j); }
    pg8::glds16(P.ws + WS_GATE + row0 * 128 + o.ra, lds + GL_RA + slot * 4096 + 1024 * pw);
}
DEV void gla_issue_v(const Params& P, LAS unsigned char* lds, int slot, int pw, const GlaDmaOff& o, int gc, int h) {
    const unsigned char* vp = P.ws + T_PGLAV + ((size_t)gc * 64 * 512 + h * 128) * 2;
#pragma unroll
    for (int jj = 0; jj < 4; ++jj) { const int j = 4 * jj + pw; pg8::glds16(vp + o.v[jj], lds + GL_V + slot * 16384 + 1024 * j); }
}
template <bool BARB, int DIRC>
DEV void gla_alpha(LAS unsigned char* lds, int rslot, int oslot, int pw, int lane, const float (&wb)[4], float blr, const int (&offr)[4]) {
    constexpr int dir = DIRC, mtstep = DIRC ? -2048 : 2048;
    const int c = lane & 15, g = lane >> 4, dk = 16 * pw + c;
    const LAS float* RA = (const LAS float*)(lds + GL_RA + rslot * 4096);
    float bcs[4][4]; float toff = 0.f, bmid = 0.f;
    const int ra0 = (dir ? 63 - c : c) * 16 + g, rastep = dir ? -256 : 256;
#pragma unroll
    for (int mt = 0; mt < 4; ++mt) {
        f32x4 acc = {0.f, 0.f, 0.f, 0.f};
#pragma unroll
        for (int kk = 0; kk < 4; ++kk) acc = mfma4f32(RA[ra0 + mt * rastep + 4 * kk], wb[kk], acc);
        float run = 0.f;
#pragma unroll
        for (int r = 0; r < 4; ++r) { const float x = acc[r] + blr; run += (fminf(x, 0.f) - flog_raw(1.f + fexp_raw(-fabsf(x)))) * (1.0f / 16.0f); bcs[mt][r] = run; }
        const float t0 = wshfl(run, c), t1 = wshfl(run, c + 16), t2 = wshfl(run, c + 32), t3 = wshfl(run, c + 48);
        const float goff = (g > 0 ? t0 : 0.f) + (g > 1 ? t1 : 0.f) + (g > 2 ? t2 : 0.f);
#pragma unroll
        for (int r = 0; r < 4; ++r) bcs[mt][r] += toff + goff;
        toff += (t0 + t1) + (t2 + t3);
        if (mt == 1) bmid = toff;
    }
    const float blast = toff;
    if (BARB) { LGKM_DRAIN(); PROF_B(10); RAW_BAR(); PROF_E(10); }
    const LAS unsigned char* rq = lds + GL_RAW + rslot * 16384; LAS unsigned char* oq = lds + GL_QK + oslot * 16384;
    bf16_t qr[4][4], kr[4][4];
#pragma unroll
    for (int mt = 0; mt < 4; ++mt)
#pragma unroll
        for (int r = 0; r < 4; ++r) { const int off = offr[r] + mt * mtstep; qr[mt][r] = *(const LAS bf16_t*)(rq + off); kr[mt][r] = *(const LAS bf16_t*)(rq + 8192 + off); }
#pragma unroll
    for (int mt = 0; mt < 4; ++mt)
#pragma unroll
        for (int r = 0; r < 4; ++r) { const float bb = bcs[mt][r];
            const int off = offr[r] + mt * mtstep;
            const float ef = fexp_raw(bb - bmid), eb = frcp(ef);
            const float qv = bf2f(qr[mt][r]) * 0.125f * ef, kv = bf2f(kr[mt][r]) * eb;
            const unsigned pr = pk2(qv, kv);
            *(LAS bf16_t*)(oq + off) = (bf16_t)(pr & 0xffffu); *(LAS bf16_t*)(oq + 8192 + off) = (bf16_t)(pr >> 16); }
    if (g == 0) { LAS float* VEC = (LAS float*)(lds + GL_VEC + oslot * 1024); VEC[dk] = fexp_raw(bmid); VEC[64 + dk] = fexp_raw(blast - bmid); VEC[128 + dk] = fexp_raw(blast); }
}
DEV void gla_scan_item(const Params& P, LAS unsigned char* lds, int l, int item, bool ctx_out) {
    const int tid = tidx(), wave = uniform_i(tid >> 6), lane0 = tid & 63;
    const int b = item % NB, rest = item / NB, h = rest >> 1, dir = rest & 1;
    constexpr int NS = NCC + NCL;
    const bool producer = wave >= 4; const int pw = wave - 4, cw = wave;
    int gc;
    if (producer) {
        float wl[4];
        { const int dk = 16 * pw + (lane0 & 15);
#pragma unroll
          for (int kk = 0; kk < 4; ++kk) wl[kk] = P.gla_w_lr[(((size_t)l * 2 + dir) * 16 + 4 * kk + (lane0 >> 4)) * 256 + h * 64 + dk]; }
        const float blr = P.gla_b_lr[((size_t)l * 2 + dir) * 256 + h * 64 + 16 * pw + (lane0 & 15)];
        int offr[4];
        { const int dk = 16 * pw + (lane0 & 15), g = lane0 >> 4;
#pragma unroll
          for (int r = 0; r < 4; ++r) { const int ip = 4 * g + r, tok = dir ? 63 - ip : ip; offr[r] = swz128(tok, dk >> 3) + (dk & 7) * 2; } }
        GlaDmaOff dmo; gla_dma_offsets(dmo, pw, lane0);
        gdn_chunk_of_step(b, dir, 0, gc); gla_issue_raw(P, lds, 0, pw, dmo, gc, h); gla_issue_v(P, lds, 0, pw, dmo, gc, h);
        if (NS > 1) { gdn_chunk_of_step(b, dir, 1, gc); gla_issue_raw(P, lds, 1, pw, dmo, gc, h); }
        VM_DRAIN(); RAW_BAR();
        if (dir) gla_alpha<false, 1>(lds, 0, 0, pw, lane0, wl, blr, offr); else gla_alpha<false, 0>(lds, 0, 0, pw, lane0, wl, blr, offr);
        LGKM_DRAIN(); RAW_BAR();
#pragma unroll 1
        for (int s = 0; s < NS; ++s) {
            const int lane = opaque_i(lane0);
            if (s + 2 < NS) { gdn_chunk_of_step(b, dir, s + 2, gc); gla_issue_raw(P, lds, s & 1, pw, dmo, gc, h); }
            if (s + 1 < NS) { gdn_chunk_of_step(b, dir, s + 1, gc); gla_issue_v(P, lds, (s + 1) & 1, pw, dmo, gc, h);
                if (dir) gla_alpha<true, 1>(lds, (s + 1) & 1, (s + 1) & 1, pw, lane, wl, blr, offr); else gla_alpha<true, 0>(lds, (s + 1) & 1, (s + 1) & 1, pw, lane, wl, blr, offr); }
            else { RAW_BAR(); }
            PROF_B(12); VM_DRAIN(); PROF_E(12); LGKM_DRAIN(); PROF_B(11); RAW_BAR(); PROF_E(11);
        }
    } else {
        f32x4 S[4][2];
#pragma unroll
        for (int i = 0; i < 4; ++i) { S[i][0] = (f32x4){0.f, 0.f, 0.f, 0.f}; S[i][1] = (f32x4){0.f, 0.f, 0.f, 0.f}; }
        RAW_BAR(); RAW_BAR();
#pragma unroll 1
        for (int s = 0; s < NS; ++s) {
            const int lane = opaque_i(lane0), fr = lane & 15, fq = lane >> 4;
            gdn_chunk_of_step(b, dir, s, gc); const int row0 = gc * 64;
            const LAS unsigned char* QT = lds + GL_QK + (s & 1) * 16384; const LAS unsigned char* KT = QT + 8192;
            const LAS unsigned char* VT = lds + GL_V + (s & 1) * 16384; const LAS float* VEC = (const LAS float*)(lds + GL_VEC + (s & 1) * 1024);
            { const int it = cw;
              bf16x8 qa[2] = {*(const LAS bf16x8*)(QT + swz128(16 * it + fr, fq)), *(const LAS bf16x8*)(QT + swz128(16 * it + fr, 4 + fq))};
              bf16x8 kb[4][2];
#pragma unroll
              for (int jt = 0; jt < 4; ++jt)
#pragma unroll
                  for (int k = 0; k < 2; ++k) kb[jt][k] = *(const LAS bf16x8*)(KT + swz128(16 * jt + fr, 4 * k + fq));
              f32x4 pa[4];
#pragma unroll
              for (int jt = 0; jt < 4; ++jt) { pa[jt] = (f32x4){0.f, 0.f, 0.f, 0.f};
#pragma unroll
                  for (int k = 0; k < 2; ++k) pa[jt] = mfma16(qa[k], kb[jt][k], pa[jt]); }
#pragma unroll
              for (int jt = 0; jt < 4; ++jt)
#pragma unroll
                  for (int r = 0; r < 4; ++r) { const int i = 16 * it + 4 * fq + r, j = 16 * jt + fr; const bool keep = dir ? j >= i : j <= i;
                      *(LAS bf16_t*)(lds + GL_P + swz128(i, j >> 3) + (j & 7) * 2) = (bf16_t)f2bf(keep ? pa[jt][r] : 0.f); }
            }
            LGKM_DRAIN(); PROF_B(20); RAW_BAR(); PROF_E(20);
            bf16x8 Vb[2][2], Sb[2][2];
#pragma unroll
            for (int nt = 0; nt < 2; ++nt)
#pragma unroll
                for (int k = 0; k < 2; ++k) { const int row = 32 * k + 8 * fq + ((lane >> 2) & 3), ch = 4 * cw + 2 * nt + ((lane & 3) >> 1), off = (lane & 1) * 8;
                    Vb[nt][k] = join_s4(lds_tr16(VT + swz256(row, ch) + off), lds_tr16(VT + swz256(row + 4, ch) + off)); }
#pragma unroll
            for (int nt = 0; nt < 2; ++nt)
#pragma unroll
                for (int k = 0; k < 2; ++k) { const f32x4 e0 = *(const LAS f32x4*)(VEC + 32 * k + 4 * fq), e1 = *(const LAS f32x4*)(VEC + 32 * k + 16 + 4 * fq);
                    Sb[nt][k] = pack_bf8(S[2 * k][nt] * e0, S[2 * k + 1][nt] * e1); }
            if (ctx_out || row0 < RL) {
                LAS unsigned char* ost = lds + GL_OST + cw * 4096;
                f32x4 oacc[4][2];
#pragma unroll
                for (int it = 0; it < 4; ++it) {
                    const bf16x8 pf0 = *(const LAS bf16x8*)(lds + GL_P + swz128(16 * it + fr, fq)), pf1 = *(const LAS bf16x8*)(lds + GL_P + swz128(16 * it + fr, 4 + fq));
                    const bf16x8 qp0 = afrag_pi128(QT, 16 * it + fr, 0, fq), qp1 = afrag_pi128(QT, 16 * it + fr, 1, fq);
#pragma unroll
                    for (int nt = 0; nt < 2; ++nt) { f32x4 a = {0.f, 0.f, 0.f, 0.f};
                        a = mfma16(pf0, Vb[nt][0], a); a = mfma16(pf1, Vb[nt][1], a); a = mfma16(qp0, Sb[nt][0], a); a = mfma16(qp1, Sb[nt][1], a);
                        oacc[it][nt] = a; }
                }
#pragma unroll
                for (int it = 0; it < 4; ++it)
#pragma unroll
                    for (int nt = 0; nt < 2; ++nt)
#pragma unroll
                        for (int j = 0; j < 4; ++j) *(LAS bf16_t*)(ost + (16 * it + 4 * fq + j) * 64 + (16 * nt + fr) * 2) = (bf16_t)f2bf(oacc[it][nt][j]);
                wave_sync();
                bf16_t* og = (bf16_t*)(P.ws + T_OGLA) + ((size_t)dir * ROWS + row0) * 512 + h * 128 + 32 * cw;
#pragma unroll
                for (int i = 0; i < 4; ++i) { const int c = lane + 64 * i, row = c >> 2, q4 = c & 3;
                    *(u32x4*)(og + (size_t)row * 512 + q4 * 8) = *(const LAS u32x4*)(ost + row * 64 + q4 * 16); }
            }
#pragma unroll
            for (int dkt = 0; dkt < 4; ++dkt) {
                bf16x8 kt[2];
#pragma unroll
                for (int k = 0; k < 2; ++k) { const int row = 32 * k + 8 * fq + ((lane >> 2) & 3), ch = 2 * dkt + ((lane & 3) >> 1), off = (lane & 1) * 8;
                    kt[k] = join_s4(lds_tr16(KT + swz128(row, ch) + off), lds_tr16(KT + swz128(row + 4, ch) + off)); }
                const f32x4 ac = *(const LAS f32x4*)(VEC + 128 + 16 * dkt + 4 * fq), el = *(const LAS f32x4*)(VEC + 64 + 16 * dkt + 4 * fq);
#pragma unroll
                for (int nt = 0; nt < 2; ++nt) { f32x4 a = {0.f, 0.f, 0.f, 0.f};
                    a = mfma16(kt[0], Vb[nt][0], a); a = mfma16(kt[1], Vb[nt][1], a);
                    S[dkt][nt] = S[dkt][nt] * ac + a * el; }
            }
            LGKM_DRAIN(); PROF_B(21); RAW_BAR(); PROF_E(21);
        }
    }
    VM_DRAIN(); block_sync();
}
DEV void phase_scan(const Params& P, LAS unsigned char* lds, int l, int vb, int nvb) {
    const bool ctx_out = (l == 0);
    for (int it = vb; it < GDN_ITEMS + GLA_ITEMS; it += nvb) {
        if (it < GDN_ITEMS) gdn_scan_item(P, lds, it, ctx_out); else gla_scan_item(P, lds, l, it - GDN_ITEMS, ctx_out);
    }
    if (l == 1 && nvb > GDN_ITEMS + GLA_ITEMS && vb >= GDN_ITEMS + GLA_ITEMS) convert_weights(P, lds, vb - (GDN_ITEMS + GLA_ITEMS), nvb - (GDN_ITEMS + GLA_ITEMS), 1);
}

DEV void phase_merge(const Params& P, int l, int vb, int nvb) {
    const int tid = tidx(), wave = tid >> 6, lane = tid & 63;
    const int nrows = l == 1 ? M_LAST : ROWS;
    const bool gdn = lane >= 32; const int c0 = 16 * (lane & 31);
    const bf16_t* O = (const bf16_t*)(P.ws + (gdn ? T_OGDN : T_OGLA));
    float ngv[16];
    { const float* ng = (gdn ? P.gdn_norm_g : P.gla_norm_g) + l * 128 + (c0 & 127);
#pragma unroll
      for (int c = 0; c < 16; ++c) ngv[c] = ng[c]; }
    constexpr int RPI = 2;
    for (int rowb = RPI * (vb * NWAVE + wave); rowb < nrows; rowb += RPI * nvb * NWAVE) {
        u32x4 av[RPI][2], bv[RPI][2], gv[RPI][2];
#pragma unroll
        for (int u = 0; u < RPI; ++u) { const int row = rowb + u < nrows ? rowb + u : nrows - 1;
            const bf16_t* gp = (const bf16_t*)(P.ws + T_PG) + (size_t)row * 1024 + 16 * lane;
#pragma unroll
            for (int e = 0; e < 2; ++e) { av[u][e] = *(const u32x4*)(O + (size_t)row * 512 + c0 + 8 * e); bv[u][e] = *(const u32x4*)(O + ((size_t)ROWS + row) * 512 + c0 + 8 * e); gv[u][e] = *(const u32x4*)(gp + 8 * e); } }
#pragma unroll
        for (int u = 0; u < RPI; ++u) { const int row = rowb + u;
            float o[16]; float ssq = 0.f;
#pragma unroll
            for (int e = 0; e < 2; ++e)
#pragma unroll
                for (int j = 0; j < 4; ++j) { const float x0 = bflo(av[u][e][j]) + bflo(bv[u][e][j]), x1 = bfhi(av[u][e][j]) + bfhi(bv[u][e][j]); o[8 * e + 2 * j] = x0; o[8 * e + 2 * j + 1] = x1; ssq += x0 * x0 + x1 * x1; }
            ssq += wshfl_xor(ssq, 1); ssq += wshfl_xor(ssq, 2); ssq += wshfl_xor(ssq, 4);
            const float rs = frsq(ssq * (1.0f / 128.0f) + EPSN);
            if (row < nrows) {
                bf16_t* yp = ((row < RL || !SKIP_CTX_LAST) ? (bf16_t*)(P.ws + T_Y) + (size_t)row * 1024 : (bf16_t*)(P.ws + WS_YC) + (size_t)(row - RL) * 1024) + 16 * lane;
#pragma unroll
                for (int e = 0; e < 2; ++e) { u32x4 w;
#pragma unroll
                    for (int j = 0; j < 4; ++j) { const int c = 8 * e + 2 * j;
                        w[j] = pk2(o[c] * rs * ngv[c] * silu_f(bflo(gv[u][e][j])), o[c + 1] * rs * ngv[c + 1] * silu_f(bfhi(gv[u][e][j]))); }
                    *(u32x4*)(yp + 8 * e) = w; }
            }
        }
    }
}

DEV void phase_final(const Params& P, int vb, int nvb) {
    const int tid = tidx(), wave = tid >> 6, lane = tid & 63;
    const float* ss = (const float*)(P.ws + WS_SUMSQ) + (size_t)4 * ROWS;
    f32x4 g[4];
#pragma unroll
    for (int j = 0; j < 4; ++j) g[j] = *(const f32x4*)(P.final_norm_g + 4 * (64 * j + lane));
    for (int rowb = 2 * (vb * NWAVE + wave); rowb < RL; rowb += 2 * nvb * NWAVE) {
        f32x4 v[2][4]; float sv[2];
#pragma unroll
        for (int u = 0; u < 2; ++u) { const int row = rowb + u < RL ? rowb + u : RL - 1; sv[u] = ss[row + (lane & 0)];
#pragma unroll
            for (int j = 0; j < 4; ++j) v[u][j] = *(const f32x4*)(P.out + (size_t)row * D + 4 * (64 * j + lane)); }
#pragma unroll
        for (int u = 0; u < 2; ++u) { const int row = rowb + u; if (row < RL) { const float rs = frsq(sv[u] * (1.0f / D) + EPSN);
#pragma unroll
            for (int j = 0; j < 4; ++j) *(f32x4*)(P.out + (size_t)row * D + 4 * (64 * j + lane)) = v[u][j] * rs * g[j]; } }
    }
}

constexpr size_t CTL_CTXCNT = 16384;
static_assert(CTL_QUEUE_OFS + 4 * 8 * 256 <= CTL_BYTES && CTL_QUEUE_OFS > CTL_CTXCNT + 256, "control words");
#ifndef EMU
DEV void handoff_publish(unsigned* cnt) {
    asm volatile("s_waitcnt vmcnt(0)" ::: "memory"); __syncthreads();
    if (threadIdx.x == 0) { __builtin_amdgcn_fence(__ATOMIC_RELEASE, "agent"); asm volatile("s_waitcnt vmcnt(0)" ::: "memory"); __hip_atomic_fetch_add(cnt, 1u, __ATOMIC_RELAXED, __HIP_MEMORY_SCOPE_AGENT); }
}
DEV void handoff_wait(unsigned* cnt, unsigned need) {
    if (threadIdx.x == 0) { unsigned sp = 0; while (__hip_atomic_load(cnt, __ATOMIC_RELAXED, __HIP_MEMORY_SCOPE_AGENT) < need) { __builtin_amdgcn_s_sleep(4); if (++sp > (1u << 24)) break; }
        __builtin_amdgcn_fence(__ATOMIC_ACQUIRE, "agent"); asm volatile("s_waitcnt vmcnt(0)" ::: "memory"); }
    __syncthreads();
}
#else
DEV void handoff_publish(unsigned* cnt) { emu_syncthreads(); if (threadIdx.x == 0) __atomic_fetch_add(cnt, 1u, __ATOMIC_SEQ_CST); }
DEV void handoff_wait(unsigned* cnt, unsigned need) { if (threadIdx.x == 0) { while (__atomic_load_n(cnt, __ATOMIC_SEQ_CST) < need) sched_yield(); } emu_syncthreads(); }
#endif
constexpr int N_PHASES = 19;
DEV void run_phase(const Params& P, LAS unsigned char* lds, int ph, int vb, int nvb) {
    float* ss = (float*)(P.ws + WS_SUMSQ); const float* MOD = (const float*)(P.ws + WS_MOD); const float* GS = (const float*)(P.ws + WS_GS);
    if (ph == 0) { phase0a(P, lds, vb, nvb); return; }
    if (ph == 1) { phase0b(P, lds, vb, nvb); return; }
    if (ph == N_PHASES - 1) { phase_final(P, vb, nvb); return; }
    const int l = (ph - 2) / 8, sub = (ph - 2) % 8;
    const int Mx = l == 1 ? M_LAST : ROWS;
    float* xc = (float*)(P.ws + WS_XC);
    constexpr int PML = RL / 256, PMC = RC / 256;
    const bool defer = SKIP_CTX_LAST;
    if (sub == 0) {
        pg8::Gemm g{(const bf16_t*)(P.ws + T_A), (const bf16_t*)(P.ws + WS_WIN + (size_t)l * WIN_BYTES), ROWS, NP, D};
        pg8::EpiIn E{ss + (size_t)(2 * l) * ROWS, (const float*)(P.ws + WS_SHW1) + (size_t)l * NMOD * NP, P.ws};
        if (l == 0 || !defer) {
            pg8::StaticOrder S; S.init(ROWS, NP, nvb, vb);
            pg8::gemm_phase(lds + LDS_RING, g, S, E);
        } else {
            unsigned* cnt = (unsigned*)(P.ws + WS_CTL + CTL_CTXCNT);
            const int nct = PMC * (D / 256), nhb = nct < nvb ? nct : nvb;
            { pg8::Gemm g2{(const bf16_t*)(P.ws + T_HID), (const bf16_t*)(P.ws + WS_WFF2), ROWS, D, FF};
              pg8::SegOrder S; S.init(PML, PMC, D, vb, nvb, 1 << 20);
              pg8::EpiRes E2{P.out, xc, P.out, xc, MOD + 5 * D, GS + (size_t)(2) * NMOD * D, (bf16_t*)(P.ws + T_A), ss + (size_t)2 * ROWS};
              pg8::gemm_phase(lds + LDS_RING, g2, S, E2);
              if (vb < nhb) handoff_publish(cnt); }
            { const int ntot = PML * (NP / 256), nlight = nvb - nhb;
              const int per_light = nlight > 0 ? (ntot + 4 * nhb + nvb - 1) / nvb : 0, per_heavy = per_light > 4 ? per_light - 4 : 0;
              pg8::SegOrder S;
              if (vb >= nhb) S.init(0, PML, NP, vb - nhb, nlight, per_light); else S.init(0, PML, NP, nlight * per_light + vb, nhb, nlight > 0 ? per_heavy : 1 << 20);
              pg8::gemm_phase(lds + LDS_RING, g, S, E); }
            { pg8::SegOrder S; S.init(PML, PMC, NP, nvb - 1 - vb, nvb, 1 << 20);
              pg8::Unit u0; if (S.next(0, u0)) handoff_wait(cnt, (unsigned)nhb);
              pg8::gemm_phase(lds + LDS_RING, g, S, E); }
        }
    } else if (sub == 1) { phase_prep_a(P, lds, l, vb, nvb);
    } else if (sub == 2) { phase_prep_b(P, lds, l, vb, nvb);
    } else if (sub == 3) { phase_scan(P, lds, l, vb, nvb);
    } else if (sub == 4) { phase_merge(P, l, vb, nvb);
    } else if (sub == 5) {
        pg8::Gemm g{(const bf16_t*)(P.ws + T_Y), (const bf16_t*)(P.ws + WS_WOUT), Mx, D, D};
        pg8::EpiRes E{l == 0 ? P.x : P.out, l == 0 ? P.ctx : xc, P.out, xc, MOD + (size_t)l * NMOD * 6 * D + 2 * D, GS + (size_t)(l * 2 + 1) * NMOD * D,
                      (bf16_t*)(P.ws + T_A), ss + (size_t)(2 * l + 1) * ROWS};
        if (l == 0 && defer) { pg8::SegOrder S; S.init(0, PML, D, vb, nvb, 1 << 20); pg8::gemm_phase(lds + LDS_RING, g, S, E); }
        else { pg8::StaticOrder S; S.init(Mx, D, nvb, vb); pg8::gemm_phase(lds + LDS_RING, g, S, E); }
    } else if (sub == 6) {
        pg8::Gemm g{(const bf16_t*)(P.ws + T_A), (const bf16_t*)(P.ws + WS_WFF1), Mx, FF, D};
        pg8::EpiFF1 E{ss + (size_t)(2 * l + 1) * ROWS, (const float*)(P.ws + WS_SHW2) + (size_t)l * NMOD * FF, (bf16_t*)(P.ws + T_HID)};
        if (l == 0 && defer) {
            { pg8::Gemm g2{(const bf16_t*)(P.ws + WS_YC) - (size_t)RL * D, (const bf16_t*)(P.ws + WS_WOUT), ROWS, D, D};
              pg8::EpiRes E2{P.x, P.ctx, P.out, xc, MOD + 2 * D, GS + (size_t)(1) * NMOD * D, (bf16_t*)(P.ws + T_A), ss + (size_t)1 * ROWS};
              pg8::SegOrder S; S.init(PML, PMC, D, nvb - 1 - vb, nvb, 1 << 20); pg8::gemm_phase(lds + LDS_RING, g2, S, E2); }
            { pg8::SegOrder S; S.init(0, PML, FF, vb, nvb, 1 << 20); pg8::gemm_phase(lds + LDS_RING, g, S, E); }
        } else { pg8::StaticOrder S; S.init(Mx, FF, nvb, vb); pg8::gemm_phase(lds + LDS_RING, g, S, E); }
    } else {
        pg8::Gemm g{(const bf16_t*)(P.ws + T_HID), (const bf16_t*)(P.ws + WS_WFF2), Mx, D, FF};
        pg8::EpiRes E{P.out, xc, P.out, xc, MOD + (size_t)l * NMOD * 6 * D + 5 * D, l == 0 ? GS + (size_t)(2) * NMOD * D : nullptr,
                      (bf16_t*)(P.ws + T_A), ss + (size_t)(l == 0 ? 2 : 4) * ROWS};
        if (l == 0 && defer) {
            { pg8::Gemm g2{(const bf16_t*)(P.ws + T_A), (const bf16_t*)(P.ws + WS_WFF1), ROWS, FF, D};
              pg8::EpiFF1 E2{ss + (size_t)1 * ROWS, (const float*)(P.ws + WS_SHW2), (bf16_t*)(P.ws + T_HID)};
              pg8::SegOrder S; S.init(PML, PMC, FF, nvb - 1 - vb, nvb, 1 << 20); pg8::gemm_phase(lds + LDS_RING, g2, S, E2); }
            { pg8::SegOrder S; S.init(0, PML, D, vb, nvb, 1 << 20); pg8::gemm_phase(lds + LDS_RING, g, S, E); }
        } else { pg8::StaticOrder S; S.init(Mx, D, nvb, vb); pg8::gemm_phase(lds + LDS_RING, g, S, E); }
    }
}

#ifndef EMU
#define XB_TMO      128
#define XB_XCNT(j)  (256  + 64 * (j))
#define XB_XSUB(j)  (1280 + 64 * (j))
#define XB_XGEN(j)  (2304 + 64 * (j))
#define XB_TOP      3328
#define XB_TOPGEN   3392
#define XCD_BAR_WORDS 3456
#define XB_SPIN_CAP (1u << 22)
__device__ __forceinline__ unsigned xb_ld(unsigned* p)              { return __hip_atomic_load(p, __ATOMIC_RELAXED, __HIP_MEMORY_SCOPE_AGENT); }
__device__ __forceinline__ unsigned xb_add(unsigned* p, unsigned v) { return __hip_atomic_fetch_add(p, v, __ATOMIC_RELAXED, __HIP_MEMORY_SCOPE_AGENT); }
__device__ __forceinline__ unsigned xb_xcc_id() { return (unsigned)__builtin_amdgcn_s_getreg((3 << 11) | 20) & 0xFu; }
#define XB_SPIN(cond, bar) do { unsigned _sp = 0; while (cond) { __builtin_amdgcn_s_sleep(1); \
    if ((++_sp & 255u) == 0u) { if (xb_ld(&(bar)[XB_TMO])) break; if (_sp > XB_SPIN_CAP) { atomicAdd(&(bar)[XB_TMO], 1u); break; } } } } while (0)
struct XcdBarrier { unsigned* bar; unsigned x; volatile LAS unsigned* st; };
__device__ __forceinline__ XcdBarrier xcd_barrier_post(unsigned* bar, volatile LAS unsigned* st) {
    XcdBarrier b; b.bar = bar; b.x = xb_xcc_id(); b.st = st;
    if (threadIdx.x == 0) (void)xb_add(&bar[XB_XCNT(b.x)], 1u);
    return b;
}
__device__ __forceinline__ void xcd_barrier_complete(unsigned* bar, unsigned x, unsigned& nloc, unsigned& nx) {
    const unsigned G = gridDim.x * gridDim.y * gridDim.z;
    unsigned sum, cnt, mine, sp = 0u;
    for (;;) {
        sum = 0u; cnt = 0u; mine = 0u;
#pragma unroll
        for (unsigned j = 0; j < 16; ++j) { const unsigned c = xb_ld(&bar[XB_XCNT(j)]); sum += c; cnt += (c > 0u) ? 1u : 0u; mine = (j == x) ? c : mine; }
        if (sum == G) break;
        __builtin_amdgcn_s_sleep(1);
        if ((++sp & 255u) == 0u) { if (xb_ld(&bar[XB_TMO])) break; if (sp > XB_SPIN_CAP) { atomicAdd(&bar[XB_TMO], 1u); break; } }
    }
    nloc = mine > 0u ? mine : 1u; nx = cnt > 0u ? cnt : 1u;
}
__device__ __forceinline__ void xcd_barrier(const XcdBarrier& b) {
    asm volatile("s_waitcnt vmcnt(0)" ::: "memory");
    __syncthreads();
    if (threadIdx.x == 0) {
        unsigned* bar = b.bar;
        __builtin_amdgcn_s_waitcnt(0);
        unsigned nloc = b.st[0], nx = b.st[1];
        if (nloc == 0u) { xcd_barrier_complete(bar, b.x, nloc, nx); b.st[0] = nloc; b.st[1] = nx; }
        const unsigned old = xb_add(&bar[XB_XSUB(b.x)], 1u);
        const unsigned gen = old / nloc;
        if (old + 1u == (gen + 1u) * nloc) {
            __builtin_amdgcn_fence(__ATOMIC_RELEASE, "agent");
            asm volatile("s_waitcnt vmcnt(0)" ::: "memory");
            const unsigned og = xb_add(&bar[XB_TOP], 1u);
            const unsigned tg = og / nx;
            if (og + 1u == (tg + 1u) * nx) xb_add(&bar[XB_TOPGEN], 1u);
            else XB_SPIN(xb_ld(&bar[XB_TOPGEN]) == tg, bar);
            __builtin_amdgcn_fence(__ATOMIC_ACQUIRE, "agent");
            xb_add(&bar[XB_XGEN(b.x)], 1u);
            asm volatile("s_waitcnt vmcnt(0)" ::: "memory");
        } else {
            XB_SPIN(xb_ld(&bar[XB_XGEN(b.x)]) == gen, bar);
            __builtin_amdgcn_fence(__ATOMIC_ACQUIRE, "agent");
            asm volatile("s_waitcnt vmcnt(0)" ::: "memory");
        }
    }
    __syncthreads();
}
constexpr int LDS_MISC = 163840 - 256;

__global__ void __launch_bounds__(NT, 2) k_mega(Params P) {
    extern __shared__ __attribute__((aligned(16))) unsigned char lds_raw[];
    LAS unsigned char* lds = (LAS unsigned char*)lds_raw;
    cg::grid_group grid = cg::this_grid();
    if (threadIdx.x < 64) ((LAS unsigned*)(lds + LDS_MISC))[threadIdx.x] = 0u;
    __syncthreads();
    XcdBarrier bar = xcd_barrier_post((unsigned*)(P.ws + WS_CTL), (volatile LAS unsigned*)(lds + LDS_MISC));
    for (int ph = 0; ph < N_PHASES; ++ph) {
        run_phase(P, lds, ph, (int)blockIdx.x, (int)gridDim.x);
        if (ph == 0) grid.sync();
        else if (ph + 1 < N_PHASES) xcd_barrier(bar);
    }
}

extern "C" void kernel_launch(void* const* d_in, const int* in_sizes, int n_in, void* d_out, int out_size, void* d_ws, size_t ws_size, hipStream_t stream) {
    static int grid = 0;
    if (grid == 0) {
        int dev = 0, cus = 0, per_cu = 0;
        (void)hipGetDevice(&dev); (void)hipDeviceGetAttribute(&cus, hipDeviceAttributeMultiprocessorCount, dev);
        (void)hipFuncSetAttribute((const void*)k_mega, hipFuncAttributeMaxDynamicSharedMemorySize, LDS_BYTES);
        (void)hipOccupancyMaxActiveBlocksPerMultiprocessor(&per_cu, (const void*)k_mega, NT, LDS_BYTES);
        if (per_cu < 1) { fprintf(stderr, "kernel_launch: occupancy query says %d blocks per CU\n", per_cu); per_cu = 1; }
        if (per_cu > 1) per_cu = 1;
        grid = (cus > 0 ? cus : 256) * per_cu;
        if (ws_size < WS_END) { fprintf(stderr, "kernel_launch: workspace too small: %zu < %zu\n", ws_size, (size_t)WS_END); grid = -1; }
    }
    if (grid < 0) return;
    Params P{};
    const float** pp = (const float**)&P;
    for (int i = 0; i < 20; ++i) pp[i] = (const float*)d_in[i];
    P.out = (float*)d_out; P.ws = (unsigned char*)d_ws;
    (void)hipMemsetAsync((char*)d_ws + WS_CTL, 0, CTL_BYTES, stream);
    void* args[] = {&P};
    hipError_t e = hipLaunchCooperativeKernel((const void*)k_mega, dim3(grid), dim3(NT), args, LDS_BYTES, stream);
    if (e != hipSuccess) fprintf(stderr, "cooperative launch failed: %s (grid %d)\n", hipGetErrorString(e), grid);
}
#endif
```

```cpp
#ifndef EMU
#include <hip/hip_runtime.h>
#include <hip/hip_cooperative_groups.h>
#include <cstdio>
#include <cstdint>
namespace cg = cooperative_groups;
typedef short bf16x8 __attribute__((ext_vector_type(8)));
typedef short s16x4 __attribute__((ext_vector_type(4)));
typedef float f32x4 __attribute__((ext_vector_type(4)));
typedef float f32x2 __attribute__((ext_vector_type(2)));
typedef unsigned u32x4 __attribute__((ext_vector_type(4)));
typedef unsigned u32x2 __attribute__((ext_vector_type(2)));
#define LAS __attribute__((address_space(3)))
#define DEV __device__ __forceinline__
#define MDEV __device__ __forceinline__
#else
#define LAS
#define DEV static inline __attribute__((always_inline))
#define MDEV inline __attribute__((always_inline))
#endif
typedef unsigned short bf16_t;

#ifndef CFG_BATCH
#define CFG_BATCH 8
#define CFG_SEQ 4096
#define CFG_CTX 256
#endif
constexpr int D = 1024, NB = CFG_BATCH, SEQ = CFG_SEQ, CTX = CFG_CTX, FF = 4096, NP = 3840, NPROJ = 3616;
constexpr int RL = NB * SEQ, RC = NB * CTX, ROWS = RL + RC;
constexpr int NCL = SEQ / 64, NCC = CTX / 64, NCH = ROWS / 64;
constexpr int NMOD = NB + 1;
constexpr bool SKIP_CTX_LAST = (RL % 256 == 0);
constexpr int M_LAST = SKIP_CTX_LAST ? RL : ROWS;
constexpr float EPSN = 1e-6f;
static_assert(ROWS % 256 == 0 && SEQ % 64 == 0 && CTX % 64 == 0, "shape");
constexpr int NT = 512, NWAVE = 8;

constexpr size_t al256(size_t x) { return (x + 255) & ~(size_t)255; }
constexpr size_t WS_CTL = 0;                                   constexpr size_t CTL_BYTES = 65536;
constexpr size_t WS_MOD = WS_CTL + CTL_BYTES;                  constexpr size_t MOD_BYTES = al256((size_t)2 * NMOD * 6 * D * 4);
constexpr size_t WS_GS = WS_MOD + MOD_BYTES;                   constexpr size_t GS_BYTES = al256((size_t)2 * 2 * NMOD * D * 4);
constexpr size_t WS_SHW1 = WS_GS + GS_BYTES;                   constexpr size_t SHW1_BYTES = al256((size_t)2 * NMOD * NP * 4);
constexpr size_t WS_SHW2 = WS_SHW1 + SHW1_BYTES;               constexpr size_t SHW2_BYTES = al256((size_t)2 * NMOD * FF * 4);
constexpr size_t WS_SUMSQ = WS_SHW2 + SHW2_BYTES;              constexpr size_t SUMSQ_BYTES = al256((size_t)5 * 4 * ROWS * 4);
constexpr size_t WS_GATE = WS_SUMSQ + SUMSQ_BYTES;             constexpr size_t GATE_BYTES = al256((size_t)ROWS * 32 * 4);
constexpr size_t WS_XC = WS_GATE + GATE_BYTES;                 constexpr size_t XC_BYTES = al256((size_t)RC * D * 4);
constexpr size_t WS_WIN = WS_XC + XC_BYTES;                    constexpr size_t WIN_BYTES = al256((size_t)NP * D * 2);
constexpr size_t WS_WOUT = WS_WIN + 2 * WIN_BYTES;             constexpr size_t WOUT_BYTES = al256((size_t)D * D * 2);
constexpr size_t WS_WFF1 = WS_WOUT + WOUT_BYTES;               constexpr size_t WFF1_BYTES = al256((size_t)FF * D * 2);
constexpr size_t WS_WFF2 = WS_WFF1 + WFF1_BYTES;               constexpr size_t WFF2_BYTES = al256((size_t)D * FF * 2);
constexpr size_t WS_QKVNC = WS_WFF2 + WFF2_BYTES;              constexpr size_t QKVNC_BYTES = al256((size_t)RC * 1536 * 2);
constexpr size_t WS_YC = WS_QKVNC + QKVNC_BYTES;               constexpr size_t YC_BYTES = al256((size_t)RC * D * 2);
constexpr size_t WS_TEMP = WS_YC + YC_BYTES;
constexpr size_t SZA = (size_t)ROWS * D * 2;
constexpr size_t TAQK_ITEM = 8192 + 8192 + 1024;
constexpr size_t T_A = WS_TEMP;
constexpr size_t T_PG = WS_TEMP + SZA;
constexpr size_t T_PGLAQK = WS_TEMP + 2 * SZA;
constexpr size_t T_PGLAV = T_PGLAQK + SZA / 2;
constexpr size_t T_PGDN = WS_TEMP + 3 * SZA;
constexpr size_t T_TAQK = T_PGDN + SZA + SZA / 2;
constexpr size_t TAQK_BYTES = al256((size_t)NCH * 8 * TAQK_ITEM);
constexpr size_t T_OGDN = T_TAQK + TAQK_BYTES;
constexpr size_t T_OGLA = T_A;
constexpr size_t T_Y = T_PGLAQK;
constexpr size_t T_HID = T_PG;
constexpr size_t WS_END = T_OGDN + SZA;
constexpr int MODN = 2 * NMOD * 6 * D;
constexpr size_t WS_MODP = T_OGDN;
static_assert((size_t)4 * MODN * 4 <= SZA, "modp fits");
static_assert(T_HID + (size_t)ROWS * FF * 2 <= WS_END, "hid fits");
static_assert(WS_END <= (size_t)512 * 1024 * 1024, "workspace budget (512 MiB)");

constexpr int LDS_BYTES = 163840;
constexpr int LDS_RING = 0;
constexpr int LDS_EPIRED = 131072;
constexpr int LDS_EPISTG = 135168;

#ifndef EMU
DEV f32x4 mfma16(bf16x8 a, bf16x8 b, f32x4 c) { return __builtin_amdgcn_mfma_f32_16x16x32_bf16(a, b, c, 0, 0, 0); }
DEV f32x4 mfma4f32(float a, float b, f32x4 c) { return __builtin_amdgcn_mfma_f32_16x16x4f32(a, b, c, 0, 0, 0); }
DEV void block_sync() { __syncthreads(); }
DEV float wshfl_xor(float v, int m) { return __shfl_xor(v, m); }
DEV float wshfl_up(float v, int d) { return __shfl_up(v, d); }
DEV float wshfl(float v, int l) { return __shfl(v, l); }
DEV s16x4 lds_tr16(const LAS unsigned char* p) { return __builtin_amdgcn_ds_read_tr16_b64_v4i16((LAS s16x4*)p); }
DEV void atomic_addf(float* p, float v) { atomicAdd(p, v); }
DEV float fexp(float x) { return __builtin_amdgcn_exp2f(x * 1.4426950408889634f); }
DEV float flog(float x) { return __builtin_amdgcn_logf(x) * 0.6931471805599453f; }
DEV float frcp(float x) { return __builtin_amdgcn_rcpf(x); }
DEV float frsq(float x) { return __builtin_amdgcn_rsqf(x); }
DEV float fexp_raw(float x) { return __builtin_amdgcn_exp2f(x * 1.4426950408889634f); }
DEV float flog_raw(float x) { return __builtin_amdgcn_logf(x) * 0.6931471805599453f; }
DEV int uniform_i(int x) { return __builtin_amdgcn_readfirstlane(x); }
DEV int opaque_i(int x) { asm volatile("" : "+v"(x)); return x; }
DEV void wave_sync() { asm volatile("s_waitcnt lgkmcnt(0)" ::: "memory"); __builtin_amdgcn_wave_barrier(); }
DEV int tidx() { return opaque_i((int)threadIdx.x); }
#else
DEV f32x4 mfma16(bf16x8 a, bf16x8 b, f32x4 c) { return emu_mfma16(a, b, c); }
DEV f32x4 mfma4f32(float a, float b, f32x4 c) { return emu_mfma4f32(a, b, c); }
DEV void block_sync() { emu_syncthreads(); }
DEV float wshfl_xor(float v, int m) { return emu_shfl_xor(v, m); }
DEV float wshfl_up(float v, int d) { return emu_shfl_up(v, d); }
DEV float wshfl(float v, int l) { return emu_shfl(v, l); }
DEV s16x4 lds_tr16(const unsigned char* p) { return emu_ds_read_tr16(p); }
DEV void atomic_addf(float* p, float v) { emu_atomic_add(p, v); }
DEV float fexp(float x) { return expf(x); }
DEV float flog(float x) { return logf(x); }
DEV float frcp(float x) { return 1.0f / x; }
DEV float frsq(float x) { return 1.0f / sqrtf(x); }
DEV float fexp_raw(float x) { return expf(x); }
DEV float flog_raw(float x) { return logf(x); }
DEV int uniform_i(int x) { return x; }
DEV int opaque_i(int x) { return x; }
DEV void wave_sync() { int z = 0; (void)emu_wave_exchange(&z, 4); }
DEV int tidx() { return (int)threadIdx.x; }
#endif
#ifndef EMU
#define VM_DRAIN() asm volatile("s_waitcnt vmcnt(0)" ::: "memory")
#define LGKM_DRAIN() asm volatile("s_waitcnt lgkmcnt(0)" ::: "memory")
#define RAW_BAR() __builtin_amdgcn_s_barrier()
#define SCHED_FENCE() __builtin_amdgcn_sched_barrier(0)
#else
#define VM_DRAIN()
#define LGKM_DRAIN()
#define RAW_BAR() emu_syncthreads()
#define SCHED_FENCE()
#endif
DEV unsigned f2bf(float f) { unsigned u = __builtin_bit_cast(unsigned, f); return (u + 0x7fffu + ((u >> 16) & 1u)) >> 16; }
#ifndef EMU
typedef __bf16 hwbf16x2 __attribute__((ext_vector_type(2)));
DEV unsigned pk2(float lo, float hi) { const f32x2 f = {lo, hi}; return __builtin_bit_cast(unsigned, __builtin_convertvector(f, hwbf16x2)); }
#else
DEV unsigned pk2(float lo, float hi) { return f2bf(lo) | (f2bf(hi) << 16); }
#endif
DEV float bf2f(unsigned short s) { return __builtin_bit_cast(float, (unsigned)s << 16); }
DEV float bflo(unsigned u) { return __builtin_bit_cast(float, u << 16); }
DEV float bfhi(unsigned u) { return __builtin_bit_cast(float, u & 0xffff0000u); }
DEV float silu_f(float x) { return x * frcp(1.f + fexp(-x)); }
DEV float sigmoid_f(float x) { return frcp(1.f + fexp(-x)); }
DEV float logsigmoid_f(float x) { return fminf(x, 0.f) - flog(1.f + fexp(-fabsf(x))); }
DEV float softplus_f(float x) { return fmaxf(x, 0.f) + log1pf(fexp(-fabsf(x))); }
DEV float wave_sum(float v) {
#pragma unroll
    for (int o = 1; o < 64; o <<= 1) v += wshfl_xor(v, o);
    return v;
}
DEV int mod_of_row(int row) { return row < RL ? row / SEQ : NB; }
DEV int win_src_col(int n) {
    if (n < 1536) return n;
    if (n < 3584) return n + 16;
    if (n < 3600) return n - 3584 + 1536;
    if (n < 3616) return n;
    return -1;
}

#define PROF_B(t)
#define PROF_E(t)
constexpr int GDN_ITEMS = NB * 16, GLA_ITEMS = NB * 8;
struct Params {
    const float *x, *c, *ctx, *c_ctx, *w_ada, *b_ada, *norm1_g, *norm2_g, *w_in, *gla_w_lr, *gla_b_lr, *gdn_conv_w, *gdn_a_log, *gdn_dt_bias,
        *gla_norm_g, *gdn_norm_g, *w_out, *w_ff1, *w_ff2, *final_norm_g;
    float* out; unsigned char* ws;
};

template <class VecFn, class ColFn>
DEV void gemv_item(LAS unsigned char* lds, VecFn vecfn, const float* W, int ldw, ColFn colfn, int n0, const float* bias, float* out, int ldo) {
    LAS float* vec = (LAS float*)lds;
    LAS float* red = (LAS float*)(lds + NMOD * D * 4);
    const int tid = tidx(), wave = tid >> 6, lane = tid & 63;
    static_assert((NMOD * D) % NT == 0, "vec staging");
    { float tmp[NMOD * D / NT];
#pragma unroll
      for (int u = 0; u < NMOD * D / NT; ++u) { const int i = tid + u * NT; tmp[u] = vecfn(i / D, i % D); }
#pragma unroll
      for (int u = 0; u < NMOD * D / NT; ++u) vec[tid + u * NT] = tmp[u]; }
    block_sync();
    const int sc = colfn(n0 + lane);
    float acc[NMOD];
#pragma unroll
    for (int b = 0; b < NMOD; ++b) acc[b] = 0.f;
    const int k0 = wave * (D / 8);
    const float* wp = W + (sc >= 0 ? sc : 0);
    const float wm = sc >= 0 ? 1.f : 0.f;
#pragma unroll 1
    for (int k = k0; k < k0 + D / 8; k += 64) {
        float w[64];
#pragma unroll
        for (int u = 0; u < 64; ++u) w[u] = wp[(size_t)(k + u) * ldw];
#pragma unroll
        for (int u = 0; u < 64; ++u) { const float wv = w[u] * wm;
#pragma unroll
            for (int b = 0; b < NMOD; ++b) acc[b] += vec[b * D + k + u] * wv; }
    }
#pragma unroll
    for (int b = 0; b < NMOD; ++b) red[(wave * NMOD + b) * 64 + lane] = acc[b];
    block_sync();
    for (int i = tid; i < NMOD * 64; i += NT) {
        const int b = i >> 6, ln = i & 63; float s = 0.f;
#pragma unroll
        for (int w = 0; w < 8; ++w) s += red[(w * NMOD + b) * 64 + ln];
        const int sc2 = colfn(n0 + ln);
        if (bias && sc2 >= 0) s += bias[sc2];
        out[(size_t)b * ldo + n0 + ln] = s;
    }
    block_sync();
}
constexpr int GV_KS = 256, GV_NSLAB = D / GV_KS;
template <class VecFn, class ColFn>
DEV void gemv_slab_item(LAS unsigned char* lds, VecFn vecfn, const float* W, int ldw, ColFn colfn, int n0, int ks, float* out, int ldo) {
    LAS float* vec = (LAS float*)lds;
    LAS float* red = (LAS float*)(lds + NMOD * GV_KS * 4);
    const int tid = tidx(), wave = tid >> 6, lane = tid & 63;
    for (int i = tid; i < NMOD * GV_KS; i += NT) vec[i] = vecfn(i / GV_KS, ks * GV_KS + i % GV_KS);
    const int sc = colfn(n0 + 4 * lane);
    const float* wp = W + (sc >= 0 ? sc : 0) + (size_t)(ks * GV_KS + wave * 32) * ldw;
    const float wm = sc >= 0 ? 1.f : 0.f;
    f32x4 w[32];
#pragma unroll
    for (int u = 0; u < 32; ++u) w[u] = *(const f32x4*)(wp + (size_t)u * ldw);
    block_sync();
    f32x4 acc[NMOD];
#pragma unroll
    for (int b = 0; b < NMOD; ++b) acc[b] = (f32x4){0.f, 0.f, 0.f, 0.f};
#pragma unroll
    for (int u = 0; u < 32; ++u) { const f32x4 wv = w[u] * wm;
#pragma unroll
        for (int b = 0; b < NMOD; ++b) acc[b] += wv * vec[b * GV_KS + wave * 32 + u]; }
#pragma unroll
    for (int b = 0; b < NMOD; ++b) *(LAS f32x4*)(red + (wave * NMOD + b) * 256 + 4 * lane) = acc[b];
    block_sync();
    for (int i = tid; i < NMOD * 256; i += NT) {
        const int b = i >> 8, c = i & 255; float sum = 0.f;
#pragma unroll
        for (int wv = 0; wv < 8; ++wv) sum += red[(wv * NMOD + b) * 256 + c];
        out[(size_t)b * ldo + n0 + c] = sum;
    }
    block_sync();
}
struct CvItem { const float* W; bf16_t* WT; int K, ldw, nblk, r; bool win; };
DEV int cv_src_col(const CvItem& c, int n) { return c.win ? win_src_col(n) : n; }
DEV void cv_load(const CvItem& c, f32x4 (&tv)[16], int lane) {
    const int kb = c.r / c.nblk, nb = c.r % c.nblk, k0 = 64 * kb, n0 = 64 * nb;
    const int c4 = lane & 15, kr = lane >> 4;
    const int sc = cv_src_col(c, n0 + 4 * c4);
    const float* wp = c.W + (sc >= 0 ? sc : 0);
#pragma unroll
    for (int i = 0; i < 16; ++i) tv[i] = *(const f32x4*)(wp + (size_t)(k0 + kr + 4 * i) * c.ldw);
}
DEV void cv_finish(const CvItem& c, const f32x4 (&tv)[16], LAS float* scr, int lane) {
    const int kb = c.r / c.nblk, nb = c.r % c.nblk, k0 = 64 * kb, n0 = 64 * nb;
    const int c4 = lane & 15, kr = lane >> 4;
    const float wm = cv_src_col(c, n0 + 4 * c4) >= 0 ? 1.f : 0.f;
#pragma unroll
    for (int i = 0; i < 16; ++i) { LAS float* d = scr + (kr + 4 * i) * 65 + 4 * c4; const f32x4 v = tv[i] * wm; d[0] = v[0]; d[1] = v[1]; d[2] = v[2]; d[3] = v[3]; }
    wave_sync();
    const int cc = lane & 7;
#pragma unroll
    for (int j = 0; j < 8; ++j) { const int n = (lane >> 3) + 8 * j; const LAS float* sp = scr + (8 * cc) * 65 + n;
        u32x4 o; o.x = pk2(sp[0 * 65], sp[1 * 65]); o.y = pk2(sp[2 * 65], sp[3 * 65]); o.z = pk2(sp[4 * 65], sp[5 * 65]); o.w = pk2(sp[6 * 65], sp[7 * 65]);
        *(u32x4*)(c.WT + (size_t)(n0 + n) * c.K + k0 + 8 * cc) = o; }
    wave_sync();
}
struct ColId { MDEV int operator()(int n) const { return n; } };
struct ColWin { MDEV int operator()(int n) const { return win_src_col(n); } };

DEV CvItem cv_decode(const Params& P, int set, int it) {
    constexpr int I_IN = (D / 64) * (NP / 64), I_OUT = (D / 64) * (D / 64), I_F1 = (D / 64) * (FF / 64);
    int r = it; CvItem c;
    if (set == 0) { c.W = P.w_in; c.WT = (bf16_t*)(P.ws + WS_WIN); c.K = D; c.ldw = NPROJ; c.nblk = NP / 64; c.r = r; c.win = true; return c; }
    if (set == 1) {
        if (r < I_IN) { c.W = P.w_in + (size_t)D * NPROJ; c.WT = (bf16_t*)(P.ws + WS_WIN + WIN_BYTES); c.K = D; c.ldw = NPROJ; c.nblk = NP / 64; c.r = r; c.win = true; return c; } r -= I_IN;
    }
    const int l = set == 2 ? 1 : 0;
    c.win = false;
    if (r < I_OUT) { c.W = P.w_out + (size_t)l * D * D; c.WT = (bf16_t*)(P.ws + WS_WOUT); c.K = D; c.ldw = D; c.nblk = D / 64; c.r = r; return c; } r -= I_OUT;
    if (r < I_F1) { c.W = P.w_ff1 + (size_t)l * D * FF; c.WT = (bf16_t*)(P.ws + WS_WFF1); c.K = D; c.ldw = FF; c.nblk = FF / 64; c.r = r; return c; } r -= I_F1;
    c.W = P.w_ff2 + (size_t)l * FF * D; c.WT = (bf16_t*)(P.ws + WS_WFF2); c.K = FF; c.ldw = D; c.nblk = D / 64; c.r = r; return c;
}
DEV void convert_weights(const Params& P, LAS unsigned char* lds, int vb, int nvb, int layer_set) {
    const int tid = tidx(), wave = tid >> 6, lane = tid & 63;
    LAS float* scr = (LAS float*)(lds + wave * 16896);
    const int gw = vb * NWAVE + wave, NGW = nvb * NWAVE;
    constexpr int I_IN = (D / 64) * (NP / 64), I_OUT = (D / 64) * (D / 64), I_F1 = (D / 64) * (FF / 64), I_F2 = (FF / 64) * (D / 64);
    const int l = layer_set;
    const int nitems = l == 0 ? I_IN : (l == 1 ? I_IN : 0) + I_OUT + I_F1 + I_F2;
    int it = gw;
    if (it >= nitems) return;
    f32x4 ta[16], tb[16];
    CvItem ca = cv_decode(P, l, it), cb = ca;
    cv_load(ca, ta, lane);
#pragma unroll 1
    for (;;) {
        int itn = it + NGW; bool hn = itn < nitems;
        if (hn) { cb = cv_decode(P, l, itn); cv_load(cb, tb, lane); }
        cv_finish(ca, ta, scr, lane);
        if (!hn) break;
        it = itn; itn = it + NGW; hn = itn < nitems;
        if (hn) { ca = cv_decode(P, l, itn); cv_load(ca, ta, lane); }
        cv_finish(cb, tb, scr, lane);
        if (!hn) break;
        it = itn;
    }
}

DEV void phase0a(const Params& P, LAS unsigned char* lds, int vb, int nvb) {
    const int tid = tidx();
    { float* ss = (float*)(P.ws + WS_SUMSQ); for (size_t i = (size_t)vb * NT + tid; i < (size_t)5 * 4 * ROWS; i += (size_t)nvb * NT) ss[i] = 0.f; }
    constexpr int NBLK = (6 * D / 256) * GV_NSLAB;
    for (int it = vb; it < 2 * NBLK; it += nvb) {
        const int l = it / NBLK, nb = (it % NBLK) / GV_NSLAB, ks = it % GV_NSLAB;
        auto vf = [&](int b, int k) { const float v = b < NB ? P.c[(size_t)b * D + k] : P.c_ctx[k]; return silu_f(v); };
        gemv_slab_item(lds, vf, P.w_ada + (size_t)l * D * 6 * D, 6 * D, ColId(), nb * 256, ks, (float*)(P.ws + WS_MODP) + (size_t)ks * MODN + (size_t)l * NMOD * 6 * D, 6 * D);
    }
    block_sync();
    convert_weights(P, lds, vb, nvb, 0);
    if (nvb <= GDN_ITEMS + GLA_ITEMS) convert_weights(P, lds, vb, nvb, 1);
}

DEV void phase0b(const Params& P, LAS unsigned char* lds, int vb, int nvb) {
    const int tid = tidx(), wave = tid >> 6, lane = tid & 63;
    const float* MODP = (const float*)(P.ws + WS_MODP);
    auto modv = [&](size_t i) { const int l = (int)(i / ((size_t)NMOD * 6 * D)), c = (int)(i % (6 * D));
        return (((MODP[i] + MODP[MODN + i]) + MODP[2 * (size_t)MODN + i]) + MODP[3 * (size_t)MODN + i]) + P.b_ada[(size_t)l * 6 * D + c]; };
    { float* MODW = (float*)(P.ws + WS_MOD);
      for (int i = vb * NT + tid; i < MODN; i += nvb * NT) MODW[i] = modv((size_t)i); }
    { float* GS = (float*)(P.ws + WS_GS);
      for (int i = vb * NT + tid; i < 2 * 2 * NMOD * D; i += nvb * NT) {
          const int k = i % D, b = (i / D) % NMOD, wh = (i / (D * NMOD)) & 1, l = i / (D * NMOD * 2);
          const float g = (wh ? P.norm2_g : P.norm1_g)[l * D + k];
          GS[i] = g * (1.f + modv(((size_t)l * NMOD + b) * 6 * D + (wh ? 4 : 1) * D + k));
      } }
    constexpr int NB1 = NP / 64, NB2 = FF / 64;
    for (int it = vb; it < 2 * (NB1 + NB2); it += nvb) {
        const int l = it / (NB1 + NB2), r = it % (NB1 + NB2);
        if (r < NB1) {
            auto vf = [&](int b, int k) { return modv(((size_t)l * NMOD + b) * 6 * D + 0 * D + k); };
            gemv_item(lds, vf, P.w_in + (size_t)l * D * NPROJ, NPROJ, ColWin(), r * 64, nullptr, (float*)(P.ws + WS_SHW1) + (size_t)l * NMOD * NP, NP);
        } else {
            auto vf = [&](int b, int k) { return modv(((size_t)l * NMOD + b) * 6 * D + 3 * D + k); };
            gemv_item(lds, vf, P.w_ff1 + (size_t)l * D * FF, FF, ColId(), (r - NB1) * 64, nullptr, (float*)(P.ws + WS_SHW2) + (size_t)l * NMOD * FF, FF);
        }
    }
    bf16_t* A = (bf16_t*)(P.ws + T_A); float* ss = (float*)(P.ws + WS_SUMSQ);
    constexpr int NQ = ROWS / 4;
    const int gw = vb * NWAVE + wave, NGW = nvb * NWAVE;
    const int q_b = (int)(((long)gw * NQ) / NGW), q_e = (int)(((long)(gw + 1) * NQ) / NGW);
    f32x4 gsr[4]; int gs_b9 = -1;
#pragma unroll
    for (int j = 0; j < 4; ++j) gsr[j] = (f32x4){0.f, 0.f, 0.f, 0.f};
    auto loadq = [&](f32x4 (&v)[4][4], int q) {
#pragma unroll
        for (int u = 0; u < 4; ++u) { const int row = 4 * q + u;
            const float* xr = row < RL ? P.x + (size_t)row * D : P.ctx + (size_t)(row - RL) * D;
#pragma unroll
            for (int j = 0; j < 4; ++j) v[u][j] = *(const f32x4*)(xr + 4 * (64 * j + lane)); }
    };
    auto procq = [&](const f32x4 (&v)[4][4], int q) {
        const int b9 = mod_of_row(4 * q);
        if (b9 != gs_b9) { gs_b9 = b9;
#pragma unroll
            for (int j = 0; j < 4; ++j) { const int col = 4 * (64 * j + lane);
                const f32x4 g = *(const f32x4*)(P.norm1_g + col); const size_t mi = (size_t)b9 * 6 * D + 1 * D + col;
                const f32x4 c = {modv(mi), modv(mi + 1), modv(mi + 2), modv(mi + 3)};
                gsr[j] = g * (1.f + c); } }
#pragma unroll
        for (int u = 0; u < 4; ++u) { const int row = 4 * q + u; float s = 0.f;
#pragma unroll
            for (int j = 0; j < 4; ++j) {
                const int col = 4 * (64 * j + lane);
                const f32x4 x = v[u][j]; const f32x4 y = x * gsr[j];
                s += (x[0] * x[0] + x[1] * x[1]) + (x[2] * x[2] + x[3] * x[3]);
                u32x2 o; o.x = pk2(y[0], y[1]); o.y = pk2(y[2], y[3]);
                *(u32x2*)(A + (size_t)row * D + col) = o;
            }
            s = wave_sum(s);
            if (lane == 0) ss[(size_t)row * 4] = s; }
    };
    f32x4 va[4][4], vb2[4][4];
    if (q_b < q_e) loadq(va, q_b);
#pragma unroll 1
    for (int q = q_b; q < q_e; q += 2) {
        const bool h1 = q + 1 < q_e;
        if (h1) loadq(vb2, q + 1);
        procq(va, q);
        if (!h1) break;
        if (q + 2 < q_e) loadq(va, q + 2);
        procq(vb2, q + 1);
    }
}

namespace pg8 {
constexpr int BM = 256, BK = 64, HALF = 128, HTB = HALF * BK * 2, STAGE_BYTES = 8 * HTB, NXCD = 8, WGM = 8;
DEV int lds_byte(int r, int c) { const int st = (r >> 4) * 2 + (c >> 5), rr = r & 15, cc = c & 31, ob = rr * 64 + cc * 2; return st * 1024 + (ob ^ (((ob >> 9) & 1) << 5)); }
DEV void stage_rc(int b, int& R, int& C) { const int st = b / 1024, sb = b % 1024, swz = sb ^ (((sb >> 9) & 1) << 5); R = (st >> 1) * 16 + swz / 64; C = (st & 1) * 32 + (swz % 64) / 2; }
DEV int perm32(int rho) { const int n = rho >> 4, i = rho & 15; return 8 * (i >> 2) + 4 * n + (i & 3); }
struct Unit { int pm, pn; };
struct Gemm { const bf16_t* A; const bf16_t* Bt; int M, N, K; };
struct StaticOrder {
    int nM, nN, nwg, G, c;
    MDEV void init(int M, int N, int G_, int c_) { nM = M / BM; nN = N / BM; nwg = nM * nN; G = G_; c = c_; }
    MDEV void tile_of(long L, Unit& u) const {
        int wgid = (int)L; { const int q = nwg / NXCD, r = nwg % NXCD, xcd = wgid % NXCD, off = wgid / NXCD; wgid = (xcd < r ? xcd * (q + 1) : r * (q + 1) + (xcd - r) * q) + off; }
        const int nig = WGM * nN, gid = wgid / nig, fm = gid * WGM, gsz = (nM - fm) < WGM ? (nM - fm) : WGM;
        u.pm = fm + ((wgid % nig) % gsz); u.pn = (wgid % nig) / gsz;
    }
    MDEV bool next(int i, Unit& u) const { const long L = (long)i * G + c; if (L >= nwg) return false; tile_of(L, u); return true; }
};
struct SegOrder {
    StaticOrder so; int pm0, l0, lstride, lcount;
    MDEV void init(int pm0_, int npm, int N, int l0_, int lstride_, int lcount_) { so.init(npm * BM, N, 1, 0); pm0 = pm0_; l0 = l0_; lstride = lstride_; lcount = lcount_; }
    MDEV bool next(int i, Unit& u) const { if (i >= lcount) return false; const long L = (long)l0 + (long)i * lstride; if (L >= so.nwg) return false; so.tile_of(L, u); u.pm += pm0; return true; }
};
#ifndef EMU
DEV unsigned cvt_pk_bf16(float lo, float hi) { return pk2(lo, hi); }
DEV void glds16(const void* g, LAS unsigned char* l) { __builtin_amdgcn_global_load_lds((const unsigned*)g, (LAS unsigned*)l, 16, 0, 0); }
#define PG8_WAIT_V(n) asm volatile("s_waitcnt vmcnt(" #n ")" ::: "memory")
#define PG8_WAIT_L(n) asm volatile("s_waitcnt lgkmcnt(" #n ")" ::: "memory")
#define PG8_BAR __builtin_amdgcn_s_barrier()
#define PG8_SCHED __builtin_amdgcn_sched_barrier(0)
#define PG8_PRIO(x) __builtin_amdgcn_s_setprio(x)
#else
DEV unsigned cvt_pk_bf16(float lo, float hi) { return pk2(lo, hi); }
DEV void glds16(const void* g, unsigned char* l) { memcpy(l + (threadIdx.x & 63) * 16, g, 16); }
#define PG8_WAIT_V(n)
#define PG8_WAIT_L(n)
#define PG8_BAR emu_syncthreads()
#define PG8_SCHED
#define PG8_PRIO(x)
#endif

template <class Epi, class Sched>
DEV void gemm_phase(LAS unsigned char* lds, const Gemm g, const Sched& S, const Epi& E) {
    const int tid = tidx(), wid = uniform_i(tid >> 6), lane = tid & 63, wr = wid >> 2, wc = wid & 3, fr = lane & 15, fq = lane >> 4;
    const int K = g.K, nt = K / BK;
    unsigned voffA[2], voffB[2];
#pragma unroll
    for (int i = 0; i < 2; ++i) { int R, C; stage_rc(tid * 16 + i * 8192, R, C); const int Rb = Epi::PERM ? (Epi::WIDE ? (((R >> 5) & 3) * 64 + perm32(R & 31)) : ((R & ~31) + perm32(R & 31))) : R;
        voffA[i] = (unsigned)(R * K + C) * 2u; voffB[i] = (unsigned)(Rb * K + C) * 2u; }
    const size_t kstep = (size_t)(BK * 2);
    const size_t hstep = (size_t)HALF * K * 2;
    const size_t hstepB = (Epi::PERM && Epi::WIDE) ? (size_t)32 * K * 2 : hstep;
    const size_t tstep = 2 * hstep;
    const unsigned ldsw = (unsigned)wid * 1024u;
    const int aoff = lds_byte(wr * 64 + fr, fq * 8), boff = lds_byte(wc * 32 + fr, fq * 8);
#define PG8_SA(b, h) (((b) * 2 + (h)) * HTB)
#define PG8_SB(b, h) ((4 + (b) * 2 + (h)) * HTB)
#define PG8_STAGE(bufoff, gbase, voff) do { _Pragma("unroll") for (int _i = 0; _i < 2; ++_i) \
        glds16((const char*)(gbase) + (voff)[_i], lds + (bufoff) + ldsw + _i * 8192); } while (0)
#define PG8_LDA(dst, b, h) do { _Pragma("unroll") for (int m = 0; m < 4; ++m) _Pragma("unroll") for (int k = 0; k < 2; ++k) dst[m][k] = *(const LAS bf16x8*)(lds + PG8_SA(b, h) + aoff + m * 2048 + k * 1024); } while (0)
#define PG8_LDB(dst, b, h) do { _Pragma("unroll") for (int n = 0; n < 2; ++n) _Pragma("unroll") for (int k = 0; k < 2; ++k) dst[n][k] = *(const LAS bf16x8*)(lds + PG8_SB(b, h) + boff + n * 2048 + k * 1024); } while (0)
#define PG8_MMA(ai, bj, At, Bt) do { PG8_PRIO(1); _Pragma("unroll") for (int m = 0; m < 4; ++m) _Pragma("unroll") for (int n = 0; n < 2; ++n) _Pragma("unroll") for (int k = 0; k < 2; ++k) \
        acc[ai][bj][m][n] = mfma16(Bt[n][k], At[m][k], acc[ai][bj][m][n]); PG8_PRIO(0); } while (0)
    Unit cur, nxt; int ui = 0;
    if (!S.next(0, cur)) return;
    f32x4 acc[2][2][4][2];
#pragma unroll
    for (int a = 0; a < 2; ++a)
#pragma unroll
        for (int b = 0; b < 2; ++b)
#pragma unroll
            for (int m = 0; m < 4; ++m)
#pragma unroll
                for (int n = 0; n < 2; ++n) acc[a][b][m][n] = (f32x4){0.f, 0.f, 0.f, 0.f};
    bf16x8 At[4][2], B0[2][2], B1[2][2];
    const char* cA = (const char*)g.A + (size_t)cur.pm * tstep; const char* cB = (const char*)g.Bt + (size_t)cur.pn * tstep;
    PG8_STAGE(PG8_SB(0, 0), cB, voffB); PG8_STAGE(PG8_SB(0, 1), cB + hstepB, voffB); PG8_STAGE(PG8_SA(0, 0), cA, voffA); PG8_STAGE(PG8_SA(0, 1), cA + hstep, voffA);
    if (wr == 1) PG8_BAR;
    PG8_WAIT_V(2); PG8_BAR;
    PG8_STAGE(PG8_SB(1, 0), cB + kstep, voffB); PG8_STAGE(PG8_SA(1, 0), cA + kstep, voffA); PG8_STAGE(PG8_SB(1, 1), cB + hstepB + kstep, voffB);
    PG8_WAIT_V(6); PG8_BAR;
    for (;;) {
        const bool has_next = S.next(ui + 1, nxt);
        const char* nA = has_next ? (const char*)g.A + (size_t)nxt.pm * tstep : cA; const char* nB = has_next ? (const char*)g.Bt + (size_t)nxt.pn * tstep : cB;
        for (int t = 0; t < nt; t += 2) {
            const bool last = (t == nt - 2);
            const char* a1 = cA + (size_t)(t + 1) * kstep;
            const char* a2 = last ? nA : cA + (size_t)(t + 2) * kstep; const char* b2 = last ? nB : cB + (size_t)(t + 2) * kstep;
            const char* a3 = a2 + kstep; const char* b3 = b2 + kstep;
            PG8_LDB(B0, 0, 0); PG8_LDB(B1, 0, 1); PG8_SCHED; PG8_LDA(At, 0, 0); PG8_STAGE(PG8_SA(1, 1), a1 + hstep, voffA);
            PG8_WAIT_V(8); PG8_WAIT_L(0); PG8_BAR; PG8_MMA(0, 0, At, B0); PG8_MMA(0, 1, At, B1); PG8_BAR; PG8_SCHED;
            PG8_LDA(At, 0, 1); PG8_STAGE(PG8_SB(0, 0), b2, voffB); PG8_STAGE(PG8_SB(0, 1), b2 + hstepB, voffB); PG8_STAGE(PG8_SA(0, 0), a2, voffA);
            PG8_WAIT_V(8); PG8_WAIT_L(0); PG8_BAR; PG8_MMA(1, 0, At, B0); PG8_MMA(1, 1, At, B1); PG8_BAR; PG8_SCHED;
            PG8_LDB(B0, 1, 0); PG8_LDB(B1, 1, 1); PG8_SCHED; PG8_LDA(At, 1, 0); PG8_STAGE(PG8_SA(0, 1), a2 + hstep, voffA);
            PG8_WAIT_V(8); PG8_WAIT_L(0); PG8_BAR; PG8_MMA(0, 0, At, B0); PG8_MMA(0, 1, At, B1); PG8_BAR; PG8_SCHED;
            PG8_LDA(At, 1, 1); PG8_STAGE(PG8_SB(1, 0), b3, voffB); PG8_STAGE(PG8_SB(1, 1), b3 + hstepB, voffB); PG8_STAGE(PG8_SA(1, 0), a3, voffA);
            PG8_WAIT_V(8); PG8_WAIT_L(0); PG8_BAR; PG8_MMA(1, 0, At, B0); PG8_MMA(1, 1, At, B1); PG8_BAR; PG8_SCHED;
        }
        if (wr == 0) PG8_BAR;
        E(acc, cur, wr, wc, fr, fq);
        if (!has_next) break;
#pragma unroll
        for (int a = 0; a < 2; ++a)
#pragma unroll
            for (int b = 0; b < 2; ++b)
#pragma unroll
                for (int m = 0; m < 4; ++m)
#pragma unroll
                    for (int n = 0; n < 2; ++n) acc[a][b][m][n] = (f32x4){0.f, 0.f, 0.f, 0.f};
        cur = nxt; cA = nA; cB = nB; ++ui;
        if (wr == 1) PG8_BAR;
    }
    PG8_WAIT_V(0);
    PG8_BAR;
#undef PG8_SA
#undef PG8_SB
#undef PG8_STAGE
#undef PG8_LDA
#undef PG8_LDB
#undef PG8_MMA
}

struct EpiIn {
    static constexpr bool PERM = true, WIDE = true;
    const float* sumsq; const float* shw; unsigned char* ws; LAS unsigned char* stg;
    MDEV void operator()(const f32x4 (&acc)[2][2][4][2], const Unit& u, int wr, int wc, int fr, int fq) const {
        const int pn = u.pn;
        bf16_t* base; int ld, cofs;
        if (pn < 2) { base = (bf16_t*)(ws + T_PGLAQK); ld = 512; cofs = pn * 256; }
        else if (pn < 4) { base = (bf16_t*)(ws + T_PGLAV); ld = 512; cofs = (pn - 2) * 256; }
        else if (pn < 6) { base = (bf16_t*)(ws + T_PG); ld = 1024; cofs = (pn - 4) * 256; }
        else if (pn < 12) { base = (bf16_t*)(ws + T_PGDN); ld = 1536; cofs = (pn - 6) * 256; }
        else if (pn < 14) { base = (bf16_t*)(ws + T_PG); ld = 1024; cofs = 512 + (pn - 12) * 256; }
        else { base = nullptr; ld = 0; cofs = 0; }
        const int lc = wc * 64 + 8 * fq;
        const int r0 = u.pm * BM + wr * 64 + fr;
        const int b9t = mod_of_row(u.pm * BM); const bool uni = b9t == mod_of_row(u.pm * BM + BM - 1);
        float ssv[2][4];
#pragma unroll
        for (int ai = 0; ai < 2; ++ai)
#pragma unroll
            for (int m = 0; m < 4; ++m) { const f32x4 sp = *(const f32x4*)(sumsq + (size_t)(r0 + ai * HALF + m * 16) * 4); ssv[ai][m] = ((sp[0] + sp[1]) + sp[2]) + sp[3]; }
        f32x4 bv[2][2];
        { const float* sh = shw + (size_t)b9t * NP + pn * BM + lc;
#pragma unroll
          for (int bj = 0; bj < 2; ++bj) { bv[bj][0] = *(const f32x4*)(sh + bj * 32); bv[bj][1] = *(const f32x4*)(sh + bj * 32 + 4); } }
        LAS unsigned char* sw = stg + (wr * 4 + wc) * 2048;
        const int lane = fq * 16 + fr, rr = lane >> 3, cc = lane & 7;
#pragma unroll
        for (int ai = 0; ai < 2; ++ai)
#pragma unroll
            for (int m = 0; m < 4; ++m) {
                const int row = r0 + ai * HALF + m * 16;
                const float rstd = frsq(ssv[ai][m] * (1.0f / D) + EPSN);
                if (!uni) { const float* sh = shw + (size_t)mod_of_row(row) * NP + pn * BM + lc;
#pragma unroll
                    for (int bj = 0; bj < 2; ++bj) { bv[bj][0] = *(const f32x4*)(sh + bj * 32); bv[bj][1] = *(const f32x4*)(sh + bj * 32 + 4); } }
                if (base) {
#pragma unroll
                    for (int bj = 0; bj < 2; ++bj) {
                        const f32x4 v0 = acc[ai][bj][m][0] * rstd + bv[bj][0], v1 = acc[ai][bj][m][1] * rstd + bv[bj][1];
                        u32x4 w; w.x = cvt_pk_bf16(v0[0], v0[1]); w.y = cvt_pk_bf16(v0[2], v0[3]); w.z = cvt_pk_bf16(v1[0], v1[1]); w.w = cvt_pk_bf16(v1[2], v1[3]);
                        *(LAS u32x4*)(sw + fr * 128 + (((bj * 4 + fq) ^ (fr >> 1)) & 7) * 16) = w;
                    }
                    wave_sync();
                    bf16_t* op = base + (size_t)(u.pm * BM + wr * 64 + ai * HALF + m * 16) * ld + cofs + wc * 64 + cc * 8;
#pragma unroll
                    for (int i = 0; i < 2; ++i) { const int r = rr + 8 * i;
                        *(u32x4*)(op + (size_t)r * ld) = *(const LAS u32x4*)(sw + r * 128 + ((cc ^ (r >> 1)) & 7) * 16); }
                    wave_sync();
                } else if (wc == 0) {
                    float* gp = (float*)(ws + WS_GATE) + (size_t)row * 32 + lc;
                    *(f32x4*)gp = acc[ai][0][m][0] * rstd + bv[0][0]; *(f32x4*)(gp + 4) = acc[ai][0][m][1] * rstd + bv[0][1];
                }
            }
    }
};
struct EpiFF1 {
    static constexpr bool PERM = true, WIDE = true;
    const float* sumsq; const float* shw; bf16_t* hid; LAS unsigned char* stg;
    MDEV void operator()(const f32x4 (&acc)[2][2][4][2], const Unit& u, int wr, int wc, int fr, int fq) const {
        const int c0 = u.pn * BM + wc * 64 + 8 * fq;
        const int r0 = u.pm * BM + wr * 64 + fr;
        const int b9t = mod_of_row(u.pm * BM); const bool uni = b9t == mod_of_row(u.pm * BM + BM - 1);
        float ssv[2][4];
#pragma unroll
        for (int ai = 0; ai < 2; ++ai)
#pragma unroll
            for (int m = 0; m < 4; ++m) { const f32x4 sp = *(const f32x4*)(sumsq + (size_t)(r0 + ai * HALF + m * 16) * 4); ssv[ai][m] = ((sp[0] + sp[1]) + sp[2]) + sp[3]; }
        f32x4 bv[2][2];
        { const float* sh = shw + (size_t)b9t * FF + c0;
#pragma unroll
          for (int bj = 0; bj < 2; ++bj) { bv[bj][0] = *(const f32x4*)(sh + bj * 32); bv[bj][1] = *(const f32x4*)(sh + bj * 32 + 4); } }
        LAS unsigned char* sw = stg + (wr * 4 + wc) * 2048;
        const int lane = fq * 16 + fr, rr = lane >> 3, cc = lane & 7;
#pragma unroll
        for (int ai = 0; ai < 2; ++ai)
#pragma unroll
            for (int m = 0; m < 4; ++m) {
                const int row = r0 + ai * HALF + m * 16;
                const float rstd = frsq(ssv[ai][m] * (1.0f / D) + EPSN);
                if (!uni) { const float* sh = shw + (size_t)mod_of_row(row) * FF + c0;
#pragma unroll
                    for (int bj = 0; bj < 2; ++bj) { bv[bj][0] = *(const f32x4*)(sh + bj * 32); bv[bj][1] = *(const f32x4*)(sh + bj * 32 + 4); } }
#pragma unroll
                for (int bj = 0; bj < 2; ++bj) {
                    f32x4 v0 = acc[ai][bj][m][0] * rstd + bv[bj][0], v1 = acc[ai][bj][m][1] * rstd + bv[bj][1];
#pragma unroll
                    for (int e = 0; e < 4; ++e) { const float a = fmaxf(v0[e], 0.f), b = fmaxf(v1[e], 0.f); v0[e] = a * a; v1[e] = b * b; }
                    u32x4 w; w.x = cvt_pk_bf16(v0[0], v0[1]); w.y = cvt_pk_bf16(v0[2], v0[3]); w.z = cvt_pk_bf16(v1[0], v1[1]); w.w = cvt_pk_bf16(v1[2], v1[3]);
                    *(LAS u32x4*)(sw + fr * 128 + (((bj * 4 + fq) ^ (fr >> 1)) & 7) * 16) = w;
                }
                wave_sync();
                bf16_t* hp = hid + (size_t)(u.pm * BM + wr * 64 + ai * HALF + m * 16) * FF + u.pn * BM + wc * 64 + cc * 8;
#pragma unroll
                for (int i = 0; i < 2; ++i) { const int r = rr + 8 * i;
                    *(u32x4*)(hp + (size_t)r * FF) = *(const LAS u32x4*)(sw + r * 128 + ((cc ^ (r >> 1)) & 7) * 16); }
                wave_sync();
            }
    }
};
constexpr int XLD = 2 * D, XOFS = D;
template <bool RES_BF>
struct EpiRes {
    static constexpr bool PERM = true, WIDE = true;
    const void* res_lat; const void* res_ctx;
    bf16_t* out_lat; bf16_t* out_ctx;
    const float* gt;
    const float* gsn;
    bf16_t* anext; float* ssn;
    LAS float* red;
    LAS unsigned char* stg;
    MDEV void operator()(const f32x4 (&acc)[2][2][4][2], const Unit& u, int wr, int wc, int fr, int fq) const {
        const int c0 = u.pn * BM + wc * 64 + 8 * fq;
        LAS unsigned char* sw = stg + (wr * 4 + wc) * 2048;
        const int lane = fq * 16 + fr, rr = lane >> 3, cc = lane & 7;
        float part[2][4];
        const int b9t = mod_of_row(u.pm * BM); const bool uni = b9t == mod_of_row(u.pm * BM + BM - 1);
        f32x4 gtv[2][2], gsv[2][2];
#pragma unroll
        for (int bj = 0; bj < 2; ++bj)
#pragma unroll
            for (int n = 0; n < 2; ++n) { const int col = c0 + bj * 32 + n * 4;
                gtv[bj][n] = *(const f32x4*)(gt + (size_t)b9t * 6 * D + col); gsv[bj][n] = gsn ? *(const f32x4*)(gsn + (size_t)b9t * D + col) : (f32x4){0.f, 0.f, 0.f, 0.f}; }
#pragma unroll
        for (int aim = 0; aim < 4; ++aim) {
            const int ai = aim >> 1;
            f32x4 rv[2][2][2];
            u32x4 rb[2][2];
#pragma unroll
            for (int m2 = 0; m2 < 2; ++m2) { const int m = 2 * (aim & 1) + m2; const int row = u.pm * BM + ai * HALF + wr * 64 + m * 16 + fr;
                if (RES_BF) {
                    const bf16_t* rp = row < RL ? (const bf16_t*)res_lat + (size_t)row * XLD + XOFS : (const bf16_t*)res_ctx + (size_t)(row - RL) * XLD + XOFS;
#pragma unroll
                    for (int bj = 0; bj < 2; ++bj) rb[m2][bj] = *(const u32x4*)(rp + c0 + bj * 32);
                } else {
                    const float* rp = row < RL ? (const float*)res_lat + (size_t)row * D : (const float*)res_ctx + (size_t)(row - RL) * D;
#pragma unroll
                    for (int bj = 0; bj < 2; ++bj)
#pragma unroll
                        for (int n = 0; n < 2; ++n) rv[m2][bj][n] = *(const f32x4*)(rp + c0 + bj * 32 + n * 4);
                } }
#pragma unroll
            for (int m2 = 0; m2 < 2; ++m2) {
                const int m = 2 * (aim & 1) + m2;
                const int row = u.pm * BM + ai * HALF + wr * 64 + m * 16 + fr;
                if (!uni) { const int b9 = mod_of_row(row);
#pragma unroll
                    for (int bj = 0; bj < 2; ++bj)
#pragma unroll
                        for (int n = 0; n < 2; ++n) { const int col = c0 + bj * 32 + n * 4;
                            gtv[bj][n] = *(const f32x4*)(gt + (size_t)b9 * 6 * D + col); if (gsn) gsv[bj][n] = *(const f32x4*)(gsn + (size_t)b9 * D + col); } }
                float s = 0.f;
                u32x4 xw[2], aw[2];
#pragma unroll
                for (int bj = 0; bj < 2; ++bj) {
                    f32x4 xn[2];
#pragma unroll
                    for (int n = 0; n < 2; ++n) {
                        f32x4 r;
                        if (RES_BF) { const unsigned q0 = n ? rb[m2][bj].z : rb[m2][bj].x, q1 = n ? rb[m2][bj].w : rb[m2][bj].y; r = (f32x4){bflo(q0), bfhi(q0), bflo(q1), bfhi(q1)}; } else r = rv[m2][bj][n];
                        xn[n] = r + gtv[bj][n] * acc[ai][bj][m][n];
                        s += (xn[n][0] * xn[n][0] + xn[n][1] * xn[n][1]) + (xn[n][2] * xn[n][2] + xn[n][3] * xn[n][3]);
                    }
                    xw[bj].x = cvt_pk_bf16(xn[0][0], xn[0][1]); xw[bj].y = cvt_pk_bf16(xn[0][2], xn[0][3]); xw[bj].z = cvt_pk_bf16(xn[1][0], xn[1][1]); xw[bj].w = cvt_pk_bf16(xn[1][2], xn[1][3]);
                    const f32x4 g0 = gsv[bj][0], g1 = gsv[bj][1];
                    aw[bj].x = cvt_pk_bf16(xn[0][0] * g0[0], xn[0][1] * g0[1]); aw[bj].y = cvt_pk_bf16(xn[0][2] * g0[2], xn[0][3] * g0[3]);
                    aw[bj].z = cvt_pk_bf16(xn[1][0] * g1[0], xn[1][1] * g1[1]); aw[bj].w = cvt_pk_bf16(xn[1][2] * g1[2], xn[1][3] * g1[3]);
                }
                const int rowg = u.pm * BM + ai * HALF + wr * 64 + m * 16;
#pragma unroll
                for (int bj = 0; bj < 2; ++bj) *(LAS u32x4*)(sw + fr * 128 + (((bj * 4 + fq) ^ (fr >> 1)) & 7) * 16) = xw[bj];
                wave_sync();
#pragma unroll
                for (int i = 0; i < 2; ++i) { const int r = rr + 8 * i, rw = rowg + r;
                    bf16_t* xp = rw < RL ? out_lat + (size_t)rw * XLD + XOFS : out_ctx + (size_t)(rw - RL) * XLD + XOFS;
                    *(u32x4*)(xp + u.pn * BM + wc * 64 + cc * 8) = *(const LAS u32x4*)(sw + r * 128 + ((cc ^ (r >> 1)) & 7) * 16); }
                wave_sync();
                if (gsn) {
#pragma unroll
                    for (int bj = 0; bj < 2; ++bj) *(LAS u32x4*)(sw + fr * 128 + (((bj * 4 + fq) ^ (fr >> 1)) & 7) * 16) = aw[bj];
                    wave_sync();
#pragma unroll
                    for (int i = 0; i < 2; ++i) { const int r = rr + 8 * i;
                        *(u32x4*)(anext + (size_t)(rowg + r) * D + u.pn * BM + wc * 64 + cc * 8) = *(const LAS u32x4*)(sw + r * 128 + ((cc ^ (r >> 1)) & 7) * 16); }
                    wave_sync();
                }
                part[ai][m] = s;
            }
        }
        {
#pragma unroll
            for (int ai = 0; ai < 2; ++ai) {
                float v[4];
#pragma unroll
                for (int m = 0; m < 4; ++m) { float s = part[ai][m]; s += wshfl_xor(s, 16); s += wshfl_xor(s, 32); v[m] = s; }
                const float mine = fq == 0 ? v[0] : fq == 1 ? v[1] : fq == 2 ? v[2] : v[3];
                red[wc * BM + ai * HALF + wr * 64 + fq * 16 + fr] = mine;
            }
            PG8_WAIT_L(0); PG8_BAR;
            const int t = (wr * 4 + wc) * 64 + fq * 16 + fr;
            if (t < BM) ssn[(size_t)(u.pm * BM + t) * 4 + u.pn] = ((red[t] + red[BM + t]) + red[2 * BM + t]) + red[3 * BM + t];
        }
    }
};
}

DEV int swz256(int row, int chunk16) { return row * 256 + (((chunk16) ^ (row & 15)) << 4); }
DEV bf16_t* gdn_qkvn_row(unsigned char* ws, int row) {
    return row < RL ? (bf16_t*)(ws + T_PGDN) + (size_t)row * 1536 : (bf16_t*)(ws + WS_QKVNC) + (size_t)(row - RL) * 1536;
}
#ifndef EMU
DEV unsigned row_ror1(unsigned v) { return (unsigned)__builtin_amdgcn_update_dpp(0, (int)v, 0x121, 0xf, 0xf, false); }
DEV unsigned row_ror15(unsigned v) { return (unsigned)__builtin_amdgcn_update_dpp(0, (int)v, 0x12f, 0xf, 0xf, false); }
#else
DEV unsigned row_ror1(unsigned v) { const int l = threadIdx.x & 63; return __builtin_bit_cast(unsigned, emu_shfl(__builtin_bit_cast(float, v), (l & ~15) | ((l - 1) & 15))); }
DEV unsigned row_ror15(unsigned v) { const int l = threadIdx.x & 63; return __builtin_bit_cast(unsigned, emu_shfl(__builtin_bit_cast(float, v), (l & ~15) | ((l + 1) & 15))); }
#endif
DEV u32x4 ror1x4(const u32x4 v) { const unsigned a = v.x, b = v.y, c = v.z, d = v.w; u32x4 r; r.x = row_ror1(a); r.y = row_ror1(b); r.z = row_ror1(c); r.w = row_ror1(d); return r; }
DEV u32x4 ror15x4(const u32x4 v) { const unsigned a = v.x, b = v.y, c = v.z, d = v.w; u32x4 r; r.x = row_ror15(a); r.y = row_ror15(b); r.z = row_ror15(c); r.w = row_ror15(d); return r; }
DEV u32x4 shfl4(const u32x4 v, int src) {
    const unsigned a = v.x, b = v.y, c = v.z, d = v.w;
    u32x4 r;
    r.x = __builtin_bit_cast(unsigned, wshfl(__builtin_bit_cast(float, a), src));
    r.y = __builtin_bit_cast(unsigned, wshfl(__builtin_bit_cast(float, b), src));
    r.z = __builtin_bit_cast(unsigned, wshfl(__builtin_bit_cast(float, c), src));
    r.w = __builtin_bit_cast(unsigned, wshfl(__builtin_bit_cast(float, d), src));
    return r;
}
#ifndef EMU
template <int N> DEV float row_rorf(float v) { return __builtin_bit_cast(float, __builtin_amdgcn_update_dpp(0, __builtin_bit_cast(int, v), 0x120 + N, 0xf, 0xf, false)); }
#else
template <int N> DEV float row_rorf(float v) { const int l = threadIdx.x & 63; return emu_shfl(v, (l & ~15) | ((l - N) & 15)); }
#endif
DEV float row16_allsum(float s) { s += row_rorf<1>(s); s += row_rorf<2>(s); s += row_rorf<4>(s); s += row_rorf<8>(s); return s; }
DEV void gdn_conv_unit(const Params& P, const LAS float* cwl, int l, int gc, int h, int part, int lane) {
    const int c16 = lane & 15, q = lane >> 4;
    const int row0 = gc * 64; const bool is_ctx = row0 >= RL;
    const bf16_t* raw = (const bf16_t*)(P.ws + T_PGDN) + part * 512 + h * 128 + 8 * c16;
    u32x4 c0[16], hp, hn;
#pragma unroll
    for (int it = 0; it < 16; ++it) c0[it] = *(const u32x4*)(raw + (size_t)(row0 + 16 * q + it) * 1536);
    { bool hasp = false, hasn = false;
      if (is_ctx) { const int pos0 = (row0 - RL) % CTX; hasp = pos0 > 0; hasn = pos0 + 64 < CTX; }
      const unsigned mp = hasp ? 0xffffffffu : 0u, mn = hasn ? 0xffffffffu : 0u;
      const bf16_t* rp = raw + (size_t)(hasp ? row0 - 1 : row0) * 1536; const bf16_t* rn = raw + (size_t)(hasn ? row0 + 64 : row0) * 1536;
      hp = *(const u32x4*)rp & mp; hn = *(const u32x4*)rn & mn; }
    f32x4 w0[2], w1[2], w2[2];
    { const LAS float* cw = cwl + part * 512 + h * 128 + 8 * c16;
#pragma unroll
      for (int e = 0; e < 2; ++e) { w0[e] = *(const LAS f32x4*)(cw + 4 * e); w1[e] = *(const LAS f32x4*)(cw + 1536 + 4 * e); w2[e] = *(const LAS f32x4*)(cw + 3072 + 4 * e); } }
    const u32x4 upin = shfl4(c0[15], (lane - 16) & 63), dnin = shfl4(c0[0], (lane + 16) & 63);
    const u32x4 prev0 = q > 0 ? upin : hp, next15 = q < 3 ? dnin : hn;
#pragma unroll
    for (int it = 0; it < 16; ++it) {
        const u32x4 cm = it > 0 ? c0[it > 0 ? it - 1 : 0] : prev0, cp = it < 15 ? c0[it < 15 ? it + 1 : 15] : next15, cc = c0[it];
        float y[8]; float ssq = 0.f;
#pragma unroll
        for (int j = 0; j < 4; ++j) {
            const int e = j >> 1, o = (j & 1) * 2;
            const float a = w0[e][o] * bflo(cm[j]) + w1[e][o] * bflo(cc[j]) + w2[e][o] * bflo(cp[j]);
            const float b = w0[e][o + 1] * bfhi(cm[j]) + w1[e][o + 1] * bfhi(cc[j]) + w2[e][o + 1] * bfhi(cp[j]);
            const float sa = silu_f(a), sb = silu_f(b);
            y[2 * j] = sa; y[2 * j + 1] = sb; ssq += sa * sa + sb * sb;
        }
        float scale = 1.f;
        if (part < 2) { ssq = row16_allsum(ssq); scale = 1.0f / sqrtf(ssq + EPSN); if (part == 0) scale *= 0.08838834764831845f; }
        bf16_t* orow = gdn_qkvn_row(P.ws, row0 + 16 * q + it) + part * 512 + h * 128 + 8 * c16;
        u32x4 w;
#pragma unroll
        for (int j = 0; j < 4; ++j) w[j] = pk2(y[2 * j] * scale, y[2 * j + 1] * scale);
        *(u32x4*)orow = w;
        if ((it & 3) == 3) SCHED_FENCE();
    }
}
constexpr int WLD = 68;
DEV void gdn_mat_unit(const Params& P, LAS unsigned char* slot, LAS float* gb, int l, int gc, int h, int dir, int lane) {
    const int fr = lane & 15, fq = lane >> 4;
    const int row0 = gc * 64;
    unsigned char* item = P.ws + T_TAQK + (size_t)((gc * 4 + h) * 2 + dir) * TAQK_ITEM;
    bf16x8 Qf[4][4], Kf[4][4];
    { const bf16_t* qn0 = gdn_qkvn_row(P.ws, row0 + fr) + h * 128 + 8 * fq;
#pragma unroll
      for (int it = 0; it < 4; ++it)
#pragma unroll
        for (int s4 = 0; s4 < 4; ++s4) { Qf[it][s4] = *(const bf16x8*)(qn0 + (size_t)it * 16 * 1536 + 32 * s4); Kf[it][s4] = *(const bf16x8*)(qn0 + 512 + (size_t)it * 16 * 1536 + 32 * s4); } }
    { const int tok = dir ? 63 - lane : lane;
      const float* gr = (const float*)(P.ws + WS_GATE) + (size_t)(row0 + tok) * 32;
      const float av = gr[16 + dir * 4 + h], bbv = gr[24 + dir * 4 + h];
      const float la = -fexp(P.gdn_a_log[(l * 2 + dir) * 4 + h]) * softplus_f(av + P.gdn_dt_bias[(l * 2 + dir) * 4 + h]);
      const float beta = sigmoid_f(bbv);
      float g = la;
#pragma unroll
      for (int o = 1; o < 64; o <<= 1) { const float t = wshfl_up(g, o); if (lane >= o) g += t; }
      const float gl = wshfl(g, 63);
      gb[tok] = g; gb[64 + tok] = beta;
      float* sc = (float*)(item + 16384);
      sc[tok] = fexp(g); sc[64 + tok] = fexp(gl - g); sc[128 + tok] = beta; sc[192 + tok] = fexp(gl); }
    wave_sync();
    float gi[4][4], bi[4][4], gjv[4];
#pragma unroll
    for (int it = 0; it < 4; ++it) { const f32x4 gv = *(const LAS f32x4*)(gb + 16 * it + 4 * fq), bv = *(const LAS f32x4*)(gb + 64 + 16 * it + 4 * fq);
#pragma unroll
        for (int r = 0; r < 4; ++r) { gi[it][r] = gv[r]; bi[it][r] = bv[r]; } }
#pragma unroll
    for (int jt = 0; jt < 4; ++jt) gjv[jt] = gb[16 * jt + fr];
#pragma unroll
    for (int it = 0; it < 4; ++it)
#pragma unroll
        for (int jt = 0; jt < 4; ++jt) {
            f32x4 c = {0.f, 0.f, 0.f, 0.f};
            if (dir ? jt >= it : jt <= it) {
#pragma unroll
            for (int s4 = 0; s4 < 4; ++s4) c = mfma16(Qf[it][s4], Kf[jt][s4], c);
            }
            const int j = 16 * jt + fr; const float gj = gjv[jt];
#pragma unroll
            for (int r = 0; r < 4; ++r) { const int i = 16 * it + 4 * fq + r; const bool keep = dir ? j >= i : j <= i;
                const float v = c[r] * fexp(fminf(gi[it][r] - gj, 0.f)) * (keep ? 1.f : 0.f);
                *(LAS bf16_t*)(slot + i * 144 + j * 2) = (bf16_t)f2bf(v); }
        }
    wave_sync();
#pragma unroll 1
    for (int q = 0; q < 8; ++q) { const int c = lane + 64 * q; *(u32x4*)(item + 8192 + c * 16) = *(const LAS u32x4*)(slot + (c >> 3) * 144 + (c & 7) * 16); }
    wave_sync();
    LAS float* W = (LAS float*)slot;
#pragma unroll
    for (int it = 0; it < 4; ++it)
#pragma unroll
        for (int jt = 0; jt < 4; ++jt) {
            f32x4 c = {0.f, 0.f, 0.f, 0.f};
            if (dir ? jt >= it : jt <= it) {
#pragma unroll
            for (int s4 = 0; s4 < 4; ++s4) c = mfma16(Kf[it][s4], Kf[jt][s4], c);
            }
            const int j = 16 * jt + fr, jp = dir ? 63 - j : j; const float gj = gjv[jt];
#pragma unroll
            for (int r = 0; r < 4; ++r) { const int i = 16 * it + 4 * fq + r, ip = dir ? 63 - i : i;
                W[jp * WLD + ip] = bi[it][r] * c[r] * fexp(fminf(gi[it][r] - gj, 0.f)) * (jp < ip ? 1.f : 0.f); }
        }
    wave_sync();
    const int nj = dir ? 63 - lane : lane;
#pragma unroll
    for (int bk = 0; bk < 4; ++bk) {
        if (bk > 0) {
#pragma unroll
            for (int nt = 0; nt < bk; ++nt) {
                f32x4 acc = {0.f, 0.f, 0.f, 0.f};
#pragma unroll
                for (int m0 = 16 * nt; m0 < 16 * bk; m0 += 4) {
                    const int m = m0 + fq;
                    const float av = W[m * WLD + 16 * bk + fr];
                    const float xv = W[m * WLD + 16 * nt + fr];
                    const float bvv = (16 * nt + fr <= m) ? xv : 0.f;
                    acc = mfma4f32(av, bvv, acc);
                }
                wave_sync();
#pragma unroll
                for (int r = 0; r < 4; ++r) W[(16 * bk + 4 * fq + r) * WLD + 16 * nt + fr] = acc[r];
            }
            wave_sync();
        }
        float v[16];
#pragma unroll
        for (int r = 0; r < 16; ++r) { const float a = (bk > 0 && lane < 16 * bk) ? W[(16 * bk + r) * WLD + lane] : 0.f; v[r] = ((16 * bk + r == lane) ? 1.f : 0.f) - a; }
#pragma unroll
        for (int rp = 0; rp < 15; ++rp) {
            const float xp = v[rp];
            const LAS float* lrow = W + (16 * bk + rp) * WLD + 16 * bk;
#pragma unroll
            for (int q4 = (rp + 1) / 4; q4 < 4; ++q4) { const f32x4 lv = *(const LAS f32x4*)(lrow + 4 * q4);
#pragma unroll
                for (int e = 0; e < 4; ++e) if (4 * q4 + e > rp) v[4 * q4 + e] -= lv[e] * xp; }
        }
        wave_sync();
#pragma unroll
        for (int r = 0; r < 16; ++r) if (lane <= 16 * bk + r) W[(16 * bk + r) * WLD + lane] = v[r];
        wave_sync();
    }
    float x[64];
#pragma unroll
    for (int i = 0; i < 64; ++i) x[i] = lane <= i ? W[i * WLD + lane] : 0.f;
    wave_sync();
#pragma unroll
    for (int i = 0; i < 64; ++i) { const int ni = dir ? 63 - i : i; *(LAS bf16_t*)(slot + (ni * 64 + nj) * 2) = (bf16_t)f2bf(x[i]); }
    wave_sync();
#pragma unroll 1
    for (int q = 0; q < 8; ++q) { const int off = (lane + 64 * q) * 16; *(u32x4*)(item + off) = *(const LAS u32x4*)(slot + off); }
    wave_sync();
}
constexpr int PREP_CW = 0, PREP_SLOT0 = 18432, PREP_SLOT_STRIDE = 18432;
constexpr size_t CTL_QUEUE_OFS = 20480;
DEV int queue_pull(const Params& P, int inst, int vb, int first, int total, int lane) {
    unsigned* head = (unsigned*)(P.ws + WS_CTL + CTL_QUEUE_OFS + (size_t)(inst * 8 + (vb & 7)) * 256);
    unsigned k = 0;
#ifndef EMU
    if (lane == 0) k = __hip_atomic_fetch_add(head, 1u, __ATOMIC_RELAXED, __HIP_MEMORY_SCOPE_AGENT);
    k = (unsigned)__builtin_amdgcn_readfirstlane((int)k);
#else
    if (lane == 0) k = __atomic_fetch_add(head, 1u, __ATOMIC_SEQ_CST);
    k = __builtin_bit_cast(unsigned, wshfl(__builtin_bit_cast(float, k), 0));
#endif
    const long u = (long)first + (vb & 7) + 8l * k;
    return u < total ? (int)u : -1;
}
DEV void phase_prep_a(const Params& P, LAS unsigned char* lds, int l, int vb, int nvb) {
    const int tid = tidx(), wave = uniform_i(tid >> 6), lane = tid & 63;
    LAS float* cwl = (LAS float*)(lds + PREP_CW);
    { float tmp[9];
#pragma unroll
      for (int u = 0; u < 9; ++u) tmp[u] = P.gdn_conv_w[(size_t)l * 3 * 1536 + tid + u * NT];
#pragma unroll
      for (int u = 0; u < 9; ++u) cwl[tid + u * NT] = tmp[u]; }
    block_sync();
#pragma unroll 1
    for (int it = vb * NWAVE + wave; it >= 0 && it < NCH * 12; it = queue_pull(P, 2 * l, vb, nvb * NWAVE, NCH * 12, lane)) { const int part = it % 3, gh = it / 3; gdn_conv_unit(P, cwl, l, gh >> 2, gh & 3, part, opaque_i(lane)); }
    block_sync();
    if (l == 1 && nvb <= GDN_ITEMS + GLA_ITEMS) convert_weights(P, lds, vb, nvb, 2);
}
DEV void phase_prep_b(const Params& P, LAS unsigned char* lds, int l, int vb, int nvb) {
    const int tid = tidx(), wave = uniform_i(tid >> 6), lane = tid & 63;
    LAS unsigned char* slot = lds + wave * PREP_SLOT_STRIDE;
#pragma unroll 1
    for (int it = vb * NWAVE + wave; it >= 0 && it < NCH * 8; it = queue_pull(P, 2 * l + 1, vb, nvb * NWAVE, NCH * 8, lane)) gdn_mat_unit(P, slot, (LAS float*)(slot + 17408), l, it >> 3, (it >> 1) & 3, it & 1, opaque_i(lane));
    block_sync();
}

DEV int swz128(int row, int chunk16) { return row * 128 + (((chunk16) ^ ((row >> 1) & 7)) << 4); }
DEV bf16x8 pack_bf8(const f32x4& a, const f32x4& b) {
    u32x4 w; w.x = pk2(a[0], a[1]); w.y = pk2(a[2], a[3]); w.z = pk2(b[0], b[1]); w.w = pk2(b[2], b[3]); return __builtin_bit_cast(bf16x8, w);
}
DEV bf16x8 join_s4(const s16x4& a, const s16x4& b) { return (bf16x8){a[0], a[1], a[2], a[3], b[0], b[1], b[2], b[3]}; }
DEV bf16x8 afrag_pi256(const LAS unsigned char* tile, int row, int s, int fq) {
    const u32x2 lo = *(const LAS u32x2*)(tile + swz256(row, 4 * s + (fq >> 1)) + (fq & 1) * 8);
    const u32x2 hi = *(const LAS u32x2*)(tile + swz256(row, 4 * s + 2 + (fq >> 1)) + (fq & 1) * 8);
    return __builtin_bit_cast(bf16x8, (u32x4){lo.x, lo.y, hi.x, hi.y});
}
DEV bf16x8 afrag_pi128(const LAS unsigned char* tile, int row, int s, int fq) {
    const u32x2 lo = *(const LAS u32x2*)(tile + swz128(row, 4 * s + (fq >> 1)) + (fq & 1) * 8);
    const u32x2 hi = *(const LAS u32x2*)(tile + swz128(row, 4 * s + 2 + (fq >> 1)) + (fq & 1) * 8);
    return __builtin_bit_cast(bf16x8, (u32x4){lo.x, lo.y, hi.x, hi.y});
}
constexpr int GB_K = 0, GB_Q = 16384, GB_T = 32768, GB_AQ = 40960, GB_V = 49152, GB_SC = 57344, GB_SIZE = 58368;

DEV void gdn_chunk_of_step(int b, int dir, int s, int& gc) {
    if (s < NCC) { const int c = dir ? NCC - 1 - s : s; gc = RL / 64 + b * NCC + c; }
    else { const int c2 = s - NCC; const int c = dir ? NCL - 1 - c2 : c2; gc = b * NCL + c; }
}
DEV void gdn_issue_loads(const Params& P, LAS unsigned char* buf, int lw, int lane, int gc, int h, int dir, int dvh);
DEV void gdn_issue_loads(const Params& P, LAS unsigned char* buf, int lw, int lane, int gc, int h, int dir, int dvh) {
    const int row0 = gc * 64;
    const unsigned char* item = P.ws + T_TAQK + (size_t)((gc * 4 + h) * 2 + dir) * TAQK_ITEM;
#pragma unroll
    for (int jj = 0; jj < 4; ++jj) { const int j = 4 * jj + lw, r = 4 * j + (lane >> 4), ch = (lane & 15) ^ (r & 15);
        const bf16_t* rp = gdn_qkvn_row(P.ws, row0 + r) + h * 128 + ch * 8;
        pg8::glds16(rp, buf + GB_Q + 1024 * j); pg8::glds16(rp + 512, buf + GB_K + 1024 * j); }
#pragma unroll
    for (int jj = 0; jj < 2; ++jj) { const int j = 4 * jj + lw, r = 8 * j + (lane >> 3), pos = lane & 7, ch = pos ^ ((r >> 1) & 7);
        pg8::glds16(item + (r * 64 + ch * 8) * 2, buf + GB_T + 1024 * j); pg8::glds16(item + 8192 + (r * 64 + ch * 8) * 2, buf + GB_AQ + 1024 * j);
        pg8::glds16(gdn_qkvn_row(P.ws, row0 + r) + 1024 + h * 128 + dvh * 64 + pos * 8, buf + GB_V + 1024 * j); }
    if (lw == 0) pg8::glds16(item + 16384 + lane * 16, buf + GB_SC);
}
constexpr int GDN_OT_LD = 144, GDN_OT_BYTES = 64 * GDN_OT_LD;
DEV void gdn_store_otile(const Params& P, const LAS unsigned char* tile, int row0, int dir, int h, int dvh, int wave, int lane) {
    bf16_t* og = (bf16_t*)(P.ws + T_OGDN) + ((size_t)dir * ROWS + row0) * 512 + h * 128 + dvh * 64;
#pragma unroll
    for (int i = 0; i < 2; ++i) { const int row = 16 * wave + (lane >> 3) + 8 * i, ch = lane & 7;
        *(u32x4*)(og + (size_t)row * 512 + ch * 8) = *(const LAS u32x4*)(tile + row * GDN_OT_LD + ch * 16); }
}
DEV void gdn_scan_item(const Params& P, LAS unsigned char* lds, int item, bool ctx_out) {
    const int tid = tidx(), wave = uniform_i(tid >> 6), lane0 = tid & 63;
    const int b = item % NB, rest = item / NB, h = rest >> 2, dir = (rest >> 1) & 1, dvh = rest & 1;
    constexpr int NS = NCC + NCL;
    const bool loader = wave >= 4; const int lw = wave - 4;
    int gc; int prev_row0 = -1;
    if (loader) { gdn_chunk_of_step(b, dir, 0, gc); gdn_issue_loads(P, lds, lw, lane0, gc, h, dir, dvh); }
    f32x4 S[8];
#pragma unroll
    for (int i = 0; i < 8; ++i) S[i] = (f32x4){0.f, 0.f, 0.f, 0.f};
    if (loader) VM_DRAIN();
    RAW_BAR();
    for (int s = 0; s < NS; ++s) {
        LAS unsigned char* buf = lds + (s & 1) * GB_SIZE;
        if (loader) {
            if (s + 1 < NS) { gdn_chunk_of_step(b, dir, s + 1, gc); gdn_issue_loads(P, lds + ((s + 1) & 1) * GB_SIZE, lw, opaque_i(lane0), gc, h, dir, dvh); }
        } else {
            gdn_chunk_of_step(b, dir, s, gc);
            const int row0 = gc * 64, n0 = 16 * wave;
            const int lane = opaque_i(lane0), fr = lane & 15, fq = lane >> 4;
            if (prev_row0 >= 0) { gdn_store_otile(P, lds + 2 * GB_SIZE + ((s + 1) & 1) * GDN_OT_BYTES, prev_row0, dir, h, dvh, wave, lane); prev_row0 = -1; }
            const LAS float* SC = (const LAS float*)(buf + GB_SC);
            bf16x8 Sb[4];
#pragma unroll
            for (int k = 0; k < 4; ++k) Sb[k] = pack_bf8(S[2 * k], S[2 * k + 1]);
            f32x4 rr[4];
            { bf16x8 Af[4][4];
#pragma unroll
              for (int mt = 0; mt < 4; ++mt)
#pragma unroll
                for (int k = 0; k < 4; ++k) Af[mt][k] = afrag_pi256(buf + GB_K, 16 * mt + fr, k, fq);
              f32x4 acc[4];
#pragma unroll
              for (int mt = 0; mt < 4; ++mt) acc[mt] = (f32x4){0.f, 0.f, 0.f, 0.f};
#pragma unroll
              for (int k = 0; k < 4; ++k)
#pragma unroll
                for (int mt = 0; mt < 4; ++mt) acc[mt] = mfma16(Af[mt][k], Sb[k], acc[mt]);
#pragma unroll
              for (int mt = 0; mt < 4; ++mt) {
                const f32x4 eg = *(const LAS f32x4*)(SC + 16 * mt + 4 * fq), be = *(const LAS f32x4*)(SC + 128 + 16 * mt + 4 * fq);
                const s16x4 vv = lds_tr16(buf + GB_V + (16 * mt + 4 * fq + ((lane >> 2) & 3)) * 128 + (n0 + 4 * (lane & 3)) * 2);
#pragma unroll
                for (int j = 0; j < 4; ++j) { const float v = bf2f((bf16_t)vv[j]); rr[mt][j] = be[j] * (v - eg[j] * acc[mt][j]); }
              } }
            SCHED_FENCE();
            bf16x8 Rb[2] = {pack_bf8(rr[0], rr[1]), pack_bf8(rr[2], rr[3])};
            f32x4 dl[4];
            { bf16x8 Tf[4][2];
#pragma unroll
              for (int it = 0; it < 4; ++it)
#pragma unroll
                for (int k = 0; k < 2; ++k) Tf[it][k] = afrag_pi128(buf + GB_T, 16 * it + fr, k, fq);
#pragma unroll
              for (int it = 0; it < 4; ++it) dl[it] = (f32x4){0.f, 0.f, 0.f, 0.f};
#pragma unroll
              for (int k = 0; k < 2; ++k)
#pragma unroll
                for (int it = 0; it < 4; ++it) dl[it] = mfma16(Tf[it][k], Rb[k], dl[it]); }
            SCHED_FENCE();
            bf16x8 Db[2] = {pack_bf8(dl[0], dl[1]), pack_bf8(dl[2], dl[3])};
            { f32x4 ds[4];
#pragma unroll
              for (int mt = 0; mt < 4; ++mt) { const f32x4 el = *(const LAS f32x4*)(SC + 64 + 16 * mt + 4 * fq); ds[mt] = dl[mt] * el; }
              bf16x8 Dp[2] = {pack_bf8(ds[0], ds[1]), pack_bf8(ds[2], ds[3])};
              const float ach = SC[192];
#pragma unroll
              for (int dkt = 0; dkt < 8; ++dkt) S[dkt] = S[dkt] * ach;
#pragma unroll
              for (int hf = 0; hf < 2; ++hf) {
                  bf16x8 Kt[4][2];
#pragma unroll
                  for (int d4 = 0; d4 < 4; ++d4)
#pragma unroll
                    for (int k = 0; k < 2; ++k) {
                        const int dkt = 4 * hf + d4;
                        const int row = 32 * k + 4 * fq + ((lane >> 2) & 3), ch = 2 * dkt + ((lane & 3) >> 1), off = (lane & 1) * 8;
                        Kt[d4][k] = join_s4(lds_tr16(buf + GB_K + swz256(row, ch) + off), lds_tr16(buf + GB_K + swz256(row + 16, ch) + off));
                    }
#pragma unroll
                  for (int k = 0; k < 2; ++k)
#pragma unroll
                    for (int d4 = 0; d4 < 4; ++d4) S[4 * hf + d4] = mfma16(Kt[d4][k], Dp[k], S[4 * hf + d4]);
                  SCHED_FENCE();
              } }
            SCHED_FENCE();
            const bool want_o = ctx_out || row0 < RL;
            if (want_o) {
                LAS unsigned char* ost = lds + 2 * GB_SIZE + (s & 1) * GDN_OT_BYTES;
                f32x4 oa[4];
                { bf16x8 Qf[4][4];
#pragma unroll
                  for (int it = 0; it < 4; ++it)
#pragma unroll
                    for (int k = 0; k < 4; ++k) Qf[it][k] = afrag_pi256(buf + GB_Q, 16 * it + fr, k, fq);
#pragma unroll
                  for (int it = 0; it < 4; ++it) oa[it] = (f32x4){0.f, 0.f, 0.f, 0.f};
#pragma unroll
                  for (int k = 0; k < 4; ++k)
#pragma unroll
                    for (int it = 0; it < 4; ++it) oa[it] = mfma16(Qf[it][k], Sb[k], oa[it]); }
                SCHED_FENCE();
                { bf16x8 Gf[4][2];
#pragma unroll
                  for (int it = 0; it < 4; ++it)
#pragma unroll
                    for (int k = 0; k < 2; ++k) Gf[it][k] = afrag_pi128(buf + GB_AQ, 16 * it + fr, k, fq);
#pragma unroll
                  for (int it = 0; it < 4; ++it) oa[it] = oa[it] * *(const LAS f32x4*)(SC + 16 * it + 4 * fq);
#pragma unroll
                  for (int k = 0; k < 2; ++k)
#pragma unroll
                    for (int it = 0; it < 4; ++it) oa[it] = mfma16(Gf[it][k], Db[k], oa[it]); }
#pragma unroll
                for (int it = 0; it < 4; ++it)
#pragma unroll
                    for (int j = 0; j < 4; ++j) *(LAS bf16_t*)(ost + (16 * it + 4 * fq + j) * GDN_OT_LD + (n0 + fr) * 2) = (bf16_t)f2bf(oa[it][j]);
                prev_row0 = row0;
            }
        }
        if (loader) VM_DRAIN(); else LGKM_DRAIN();
        RAW_BAR();
    }
    if (!loader && prev_row0 >= 0) gdn_store_otile(P, lds + 2 * GB_SIZE + ((NS - 1) & 1) * GDN_OT_BYTES, prev_row0, dir, h, dvh, wave, opaque_i(lane0));
    VM_DRAIN(); block_sync();
}

constexpr int GLA_OT_LD = 80;
constexpr int GL_RAW = 0, GL_RA = 32768, GL_V = 40960, GL_QK = 73728, GL_P = 106496, GL_VEC = 114688, GL_OST = 116736;
struct GlaDmaOff { unsigned qk[2], v[4], ra; };
DEV void gla_dma_offsets(GlaDmaOff& o, int pw, int lane) {
#pragma unroll
    for (int jj = 0; jj < 2; ++jj) { const int j = 4 * jj + pw, r = 8 * j + (lane >> 3), ch = (lane & 7) ^ ((r >> 1) & 7); o.qk[jj] = (unsigned)(r * 512 + ch * 8) * 2u; }
#pragma unroll
    for (int jj = 0; jj < 4; ++jj) { const int j = 4 * jj + pw, r = 4 * j + (lane >> 4), ch = (lane & 15) ^ (r & 15); o.v[jj] = (unsigned)(r * 512 + ch * 8) * 2u; }
    { const int idx = pw * 64 + lane, r = idx >> 2, c4 = idx & 3; o.ra = (unsigned)(r * 32 + (c4 ^ ((r >> 2) & 3)) * 4) * 4u; }
}
DEV void gla_issue_raw(const Params& P, LAS unsigned char* lds, int slot, int pw, const GlaDmaOff& o, int gc, int h) {
    const size_t row0 = (size_t)gc * 64;
    const unsigned char* qk = P.ws + T_PGLAQK + (row0 * 512 + h * 64) * 2;
    LAS unsigned char* dst = lds + GL_RAW + slot * 16384;
#pragma unroll
    for (int jj = 0; jj < 2; ++jj) { const int j = 4 * jj + pw; pg8::glds16(qk + o.qk[jj], dst + 1024 * j); pg8::glds16(qk + 512 + o.qk[jj], dst + 8192 + 1024 * j); }
    pg8::glds16(P.ws + WS_GATE + row0 * 128 + o.ra, lds + GL_RA + slot * 4096 + 1024 * pw);
}
DEV void gla_issue_v(const Params& P, LAS unsigned char* lds, int slot, int pw, const GlaDmaOff& o, int gc, int h) {
    const unsigned char* vp = P.ws + T_PGLAV + ((size_t)gc * 64 * 512 + h * 128) * 2;
#pragma unroll
    for (int jj = 0; jj < 4; ++jj) { const int j = 4 * jj + pw; pg8::glds16(vp + o.v[jj], lds + GL_V + slot * 16384 + 1024 * j); }
}
template <bool BARB, int DIRC>
DEV void gla_alpha(LAS unsigned char* lds, int rslot, int oslot, int pw, int lane, const float (&wb)[4], float blr, const int (&offr)[4]) {
    constexpr int dir = DIRC, mtstep = DIRC ? -2048 : 2048;
    const int c = lane & 15, g = lane >> 4, dk = 16 * pw + c;
    const LAS float* RA = (const LAS float*)(lds + GL_RA + rslot * 4096);
    float bcs[4][4]; float toff = 0.f, bmid = 0.f;
    const int ra0 = (dir ? 63 - c : c) * 16 + g, rastep = dir ? -256 : 256;
    const int raf = ((dir ? 63 - c : c) >> 2) & 3;
#pragma unroll
    for (int mt = 0; mt < 4; ++mt) {
        f32x4 acc = {0.f, 0.f, 0.f, 0.f};
#pragma unroll
        for (int kk = 0; kk < 4; ++kk) acc = mfma4f32(RA[ra0 + mt * rastep + 4 * (kk ^ raf)], wb[kk], acc);
        float run = 0.f;
#pragma unroll
        for (int r = 0; r < 4; ++r) { const float x = acc[r] + blr; run += (fminf(x, 0.f) - flog_raw(1.f + fexp_raw(-fabsf(x)))) * (1.0f / 16.0f); bcs[mt][r] = run; }
        const float t0 = wshfl(run, c), t1 = wshfl(run, c + 16), t2 = wshfl(run, c + 32), t3 = wshfl(run, c + 48);
        const float goff = (g > 0 ? t0 : 0.f) + (g > 1 ? t1 : 0.f) + (g > 2 ? t2 : 0.f);
#pragma unroll
        for (int r = 0; r < 4; ++r) bcs[mt][r] += toff + goff;
        toff += (t0 + t1) + (t2 + t3);
        if (mt == 1) bmid = toff;
    }
    const float blast = toff;
    if (BARB) { LGKM_DRAIN(); PROF_B(10); RAW_BAR(); PROF_E(10); }
    const LAS unsigned char* rq = lds + GL_RAW + rslot * 16384; LAS unsigned char* oq = lds + GL_QK + oslot * 16384;
    bf16_t qr[4][4], kr[4][4];
#pragma unroll
    for (int mt = 0; mt < 4; ++mt)
#pragma unroll
        for (int r = 0; r < 4; ++r) { const int off = offr[r] + mt * mtstep; qr[mt][r] = *(const LAS bf16_t*)(rq + off); kr[mt][r] = *(const LAS bf16_t*)(rq + 8192 + off); }
#pragma unroll
    for (int mt = 0; mt < 4; ++mt)
#pragma unroll
        for (int r = 0; r < 4; ++r) { const float bb = bcs[mt][r];
            const int off = offr[r] + mt * mtstep;
            const float ef = fexp_raw(bb - bmid), eb = frcp(ef);
            const float qv = bf2f(qr[mt][r]) * 0.125f * ef, kv = bf2f(kr[mt][r]) * eb;
            const unsigned pr = pk2(qv, kv);
            *(LAS bf16_t*)(oq + off) = (bf16_t)(pr & 0xffffu); *(LAS bf16_t*)(oq + 8192 + off) = (bf16_t)(pr >> 16); }
    if (g == 0) { LAS float* VEC = (LAS float*)(lds + GL_VEC + oslot * 1024); VEC[dk] = fexp_raw(bmid); VEC[64 + dk] = fexp_raw(blast - bmid); VEC[128 + dk] = fexp_raw(blast); }
}
DEV void gla_scan_item(const Params& P, LAS unsigned char* lds, int l, int item, bool ctx_out) {
    const int tid = tidx(), wave = uniform_i(tid >> 6), lane0 = tid & 63;
    const int b = item % NB, rest = item / NB, h = rest >> 1, dir = rest & 1;
    constexpr int NS = NCC + NCL;
    const bool producer = wave >= 4; const int pw = wave - 4, cw = wave;
    int gc;
    if (producer) {
        float wl[4];
        { const int dk = 16 * pw + (lane0 & 15);
#pragma unroll
          for (int kk = 0; kk < 4; ++kk) wl[kk] = P.gla_w_lr[(((size_t)l * 2 + dir) * 16 + 4 * kk + (lane0 >> 4)) * 256 + h * 64 + dk]; }
        const float blr = P.gla_b_lr[((size_t)l * 2 + dir) * 256 + h * 64 + 16 * pw + (lane0 & 15)];
        int offr[4];
        { const int dk = 16 * pw + (lane0 & 15), g = lane0 >> 4;
#pragma unroll
          for (int r = 0; r < 4; ++r) { const int ip = 4 * g + r, tok = dir ? 63 - ip : ip; offr[r] = swz128(tok, dk >> 3) + (dk & 7) * 2; } }
        GlaDmaOff dmo; gla_dma_offsets(dmo, pw, lane0);
        gdn_chunk_of_step(b, dir, 0, gc); gla_issue_raw(P, lds, 0, pw, dmo, gc, h); gla_issue_v(P, lds, 0, pw, dmo, gc, h);
        if (NS > 1) { gdn_chunk_of_step(b, dir, 1, gc); gla_issue_raw(P, lds, 1, pw, dmo, gc, h); }
        VM_DRAIN(); RAW_BAR();
        if (dir) gla_alpha<false, 1>(lds, 0, 0, pw, lane0, wl, blr, offr); else gla_alpha<false, 0>(lds, 0, 0, pw, lane0, wl, blr, offr);
        LGKM_DRAIN(); RAW_BAR();
#pragma unroll 1
        for (int s = 0; s < NS; ++s) {
            const int lane = opaque_i(lane0);
            if (s + 2 < NS) { gdn_chunk_of_step(b, dir, s + 2, gc); gla_issue_raw(P, lds, s & 1, pw, dmo, gc, h); }
            if (s + 1 < NS) { gdn_chunk_of_step(b, dir, s + 1, gc); gla_issue_v(P, lds, (s + 1) & 1, pw, dmo, gc, h);
                if (dir) gla_alpha<true, 1>(lds, (s + 1) & 1, (s + 1) & 1, pw, lane, wl, blr, offr); else gla_alpha<true, 0>(lds, (s + 1) & 1, (s + 1) & 1, pw, lane, wl, blr, offr); }
            else { RAW_BAR(); }
            PROF_B(12); VM_DRAIN(); PROF_E(12); LGKM_DRAIN(); PROF_B(11); RAW_BAR(); PROF_E(11);
        }
    } else {
        f32x4 S[4][2];
#pragma unroll
        for (int i = 0; i < 4; ++i) { S[i][0] = (f32x4){0.f, 0.f, 0.f, 0.f}; S[i][1] = (f32x4){0.f, 0.f, 0.f, 0.f}; }
        RAW_BAR(); RAW_BAR();
#pragma unroll 1
        for (int s = 0; s < NS; ++s) {
            const int lane = opaque_i(lane0), fr = lane & 15, fq = lane >> 4;
            gdn_chunk_of_step(b, dir, s, gc); const int row0 = gc * 64;
            const LAS unsigned char* QT = lds + GL_QK + (s & 1) * 16384; const LAS unsigned char* KT = QT + 8192;
            const LAS unsigned char* VT = lds + GL_V + (s & 1) * 16384; const LAS float* VEC = (const LAS float*)(lds + GL_VEC + (s & 1) * 1024);
            { const int it = cw;
              bf16x8 qa[2] = {*(const LAS bf16x8*)(QT + swz128(16 * it + fr, fq)), *(const LAS bf16x8*)(QT + swz128(16 * it + fr, 4 + fq))};
              bf16x8 kb[4][2];
#pragma unroll
              for (int jt = 0; jt < 4; ++jt)
#pragma unroll
                  for (int k = 0; k < 2; ++k) kb[jt][k] = *(const LAS bf16x8*)(KT + swz128(16 * jt + fr, 4 * k + fq));
              f32x4 pa[4];
#pragma unroll
              for (int jt = 0; jt < 4; ++jt) { pa[jt] = (f32x4){0.f, 0.f, 0.f, 0.f};
#pragma unroll
                  for (int k = 0; k < 2; ++k) pa[jt] = mfma16(kb[jt][k], qa[k], pa[jt]); }
#pragma unroll
              for (int jt = 0; jt < 4; ++jt) { const int i = 16 * it + fr, j0 = 16 * jt + 4 * fq;
                  float pm[4];
#pragma unroll
                  for (int r = 0; r < 4; ++r) { const int j = j0 + r; const bool keep = dir ? j >= i : j <= i; pm[r] = keep ? pa[jt][r] : 0.f; }
                  u32x2 w; w.x = pk2(pm[0], pm[1]); w.y = pk2(pm[2], pm[3]);
                  *(LAS u32x2*)(lds + GL_P + swz128(i, j0 >> 3) + (j0 & 7) * 2) = w; }
            }
            LGKM_DRAIN(); PROF_B(20); RAW_BAR(); PROF_E(20);
            bf16x8 Vb[2][2], Sb[2][2];
#pragma unroll
            for (int nt = 0; nt < 2; ++nt)
#pragma unroll
                for (int k = 0; k < 2; ++k) { const int row = 32 * k + 8 * fq + ((lane >> 2) & 3), ch = 4 * cw + 2 * nt + ((lane & 3) >> 1), off = (lane & 1) * 8;
                    Vb[nt][k] = join_s4(lds_tr16(VT + swz256(row, ch) + off), lds_tr16(VT + swz256(row + 4, ch) + off)); }
#pragma unroll
            for (int nt = 0; nt < 2; ++nt)
#pragma unroll
                for (int k = 0; k < 2; ++k) { const f32x4 e0 = *(const LAS f32x4*)(VEC + 32 * k + 4 * fq), e1 = *(const LAS f32x4*)(VEC + 32 * k + 16 + 4 * fq);
                    Sb[nt][k] = pack_bf8(S[2 * k][nt] * e0, S[2 * k + 1][nt] * e1); }
            if (ctx_out || row0 < RL) {
                LAS unsigned char* ost = lds + GL_OST + cw * (64 * GLA_OT_LD);
                f32x4 oacc[4][2];
#pragma unroll
                for (int it = 0; it < 4; ++it) {
                    const bf16x8 pf0 = *(const LAS bf16x8*)(lds + GL_P + swz128(16 * it + fr, fq)), pf1 = *(const LAS bf16x8*)(lds + GL_P + swz128(16 * it + fr, 4 + fq));
                    const bf16x8 qp0 = afrag_pi128(QT, 16 * it + fr, 0, fq), qp1 = afrag_pi128(QT, 16 * it + fr, 1, fq);
#pragma unroll
                    for (int nt = 0; nt < 2; ++nt) { f32x4 a = {0.f, 0.f, 0.f, 0.f};
                        a = mfma16(pf0, Vb[nt][0], a); a = mfma16(pf1, Vb[nt][1], a); a = mfma16(qp0, Sb[nt][0], a); a = mfma16(qp1, Sb[nt][1], a);
                        oacc[it][nt] = a; }
                }
#pragma unroll
                for (int it = 0; it < 4; ++it)
#pragma unroll
                    for (int nt = 0; nt < 2; ++nt)
#pragma unroll
                        for (int j = 0; j < 4; ++j) *(LAS bf16_t*)(ost + (16 * it + 4 * fq + j) * GLA_OT_LD + (16 * nt + fr) * 2) = (bf16_t)f2bf(oacc[it][nt][j]);
                wave_sync();
                bf16_t* og = (bf16_t*)(P.ws + T_OGLA) + ((size_t)dir * ROWS + row0) * 512 + h * 128 + 32 * cw;
#pragma unroll
                for (int i = 0; i < 4; ++i) { const int c = lane + 64 * i, row = c >> 2, q4 = c & 3;
                    *(u32x4*)(og + (size_t)row * 512 + q4 * 8) = *(const LAS u32x4*)(ost + row * GLA_OT_LD + q4 * 16); }
            }
#pragma unroll
            for (int dkt = 0; dkt < 4; ++dkt) {
                bf16x8 kt[2];
#pragma unroll
                for (int k = 0; k < 2; ++k) { const int row = 32 * k + 8 * fq + ((lane >> 2) & 3), ch = 2 * dkt + ((lane & 3) >> 1), off = (lane & 1) * 8;
                    kt[k] = join_s4(lds_tr16(KT + swz128(row, ch) + off), lds_tr16(KT + swz128(row + 4, ch) + off)); }
                const f32x4 ac = *(const LAS f32x4*)(VEC + 128 + 16 * dkt + 4 * fq), el = *(const LAS f32x4*)(VEC + 64 + 16 * dkt + 4 * fq);
#pragma unroll
                for (int nt = 0; nt < 2; ++nt) { f32x4 a = {0.f, 0.f, 0.f, 0.f};
                    a = mfma16(kt[0], Vb[nt][0], a); a = mfma16(kt[1], Vb[nt][1], a);
                    S[dkt][nt] = S[dkt][nt] * ac + a * el; }
            }
            LGKM_DRAIN(); PROF_B(21); RAW_BAR(); PROF_E(21);
        }
    }
    VM_DRAIN(); block_sync();
}
DEV void phase_scan(const Params& P, LAS unsigned char* lds, int l, int vb, int nvb) {
    const bool ctx_out = (l == 0);
    for (int it = vb; it < GDN_ITEMS + GLA_ITEMS; it += nvb) {
        if (it < GDN_ITEMS) gdn_scan_item(P, lds, it, ctx_out); else gla_scan_item(P, lds, l, it - GDN_ITEMS, ctx_out);
    }
    if (nvb > GDN_ITEMS + GLA_ITEMS && vb >= GDN_ITEMS + GLA_ITEMS) convert_weights(P, lds, vb - (GDN_ITEMS + GLA_ITEMS), nvb - (GDN_ITEMS + GLA_ITEMS), l + 1);
}

DEV void phase_merge(const Params& P, int l, int vb, int nvb) {
    const int tid = tidx(), wave = tid >> 6, lane = tid & 63;
    const int nrows = l == 1 ? M_LAST : ROWS;
    const bool gdn = lane >= 32; const int c0 = 16 * (lane & 31);
    const bf16_t* O = (const bf16_t*)(P.ws + (gdn ? T_OGDN : T_OGLA));
    float ngv[16];
    { const float* ng = (gdn ? P.gdn_norm_g : P.gla_norm_g) + l * 128 + (c0 & 127);
#pragma unroll
      for (int c = 0; c < 16; ++c) ngv[c] = ng[c]; }
    constexpr int RPI = 2;
    for (int rowb = RPI * (vb * NWAVE + wave); rowb < nrows; rowb += RPI * nvb * NWAVE) {
        u32x4 av[RPI][2], bv[RPI][2], gv[RPI][2];
#pragma unroll
        for (int u = 0; u < RPI; ++u) { const int row = rowb + u < nrows ? rowb + u : nrows - 1;
            const bf16_t* gp = (const bf16_t*)(P.ws + T_PG) + (size_t)row * 1024 + 16 * lane;
#pragma unroll
            for (int e = 0; e < 2; ++e) { av[u][e] = *(const u32x4*)(O + (size_t)row * 512 + c0 + 8 * e); bv[u][e] = *(const u32x4*)(O + ((size_t)ROWS + row) * 512 + c0 + 8 * e); gv[u][e] = *(const u32x4*)(gp + 8 * e); } }
#pragma unroll
        for (int u = 0; u < RPI; ++u) { const int row = rowb + u;
            float o[16]; float ssq = 0.f;
#pragma unroll
            for (int e = 0; e < 2; ++e)
#pragma unroll
                for (int j = 0; j < 4; ++j) { const float x0 = bflo(av[u][e][j]) + bflo(bv[u][e][j]), x1 = bfhi(av[u][e][j]) + bfhi(bv[u][e][j]); o[8 * e + 2 * j] = x0; o[8 * e + 2 * j + 1] = x1; ssq += x0 * x0 + x1 * x1; }
            ssq += wshfl_xor(ssq, 1); ssq += wshfl_xor(ssq, 2); ssq += wshfl_xor(ssq, 4);
            const float rs = frsq(ssq * (1.0f / 128.0f) + EPSN);
            if (row < nrows) {
                bf16_t* yp = ((row < RL || !SKIP_CTX_LAST) ? (bf16_t*)(P.ws + T_Y) + (size_t)row * 1024 : (bf16_t*)(P.ws + WS_YC) + (size_t)(row - RL) * 1024) + 16 * lane;
#pragma unroll
                for (int e = 0; e < 2; ++e) { u32x4 w;
#pragma unroll
                    for (int j = 0; j < 4; ++j) { const int c = 8 * e + 2 * j;
                        w[j] = pk2(o[c] * rs * ngv[c] * silu_f(bflo(gv[u][e][j])), o[c + 1] * rs * ngv[c + 1] * silu_f(bfhi(gv[u][e][j]))); }
                    *(u32x4*)(yp + 8 * e) = w; }
            }
        }
    }
}

DEV void phase_final(const Params& P, int vb, int nvb) {
    const int tid = tidx(), wave = tid >> 6, lane = tid & 63;
    const float* ss = (const float*)(P.ws + WS_SUMSQ) + (size_t)4 * 4 * ROWS;
    f32x4 g[4];
#pragma unroll
    for (int j = 0; j < 4; ++j) g[j] = *(const f32x4*)(P.final_norm_g + 4 * (64 * j + lane));
    const bf16_t* xs = (const bf16_t*)P.out;
    for (int rowb = 2 * (vb * NWAVE + wave); rowb < RL; rowb += 2 * nvb * NWAVE) {
        u32x2 v[2][4]; float sv[2];
#pragma unroll
        for (int u = 0; u < 2; ++u) { const int row = rowb + u < RL ? rowb + u : RL - 1; { const f32x4 sp = *(const f32x4*)(ss + (size_t)row * 4 + (lane & 0)); sv[u] = ((sp[0] + sp[1]) + sp[2]) + sp[3]; }
#pragma unroll
            for (int j = 0; j < 4; ++j) v[u][j] = *(const u32x2*)(xs + (size_t)row * pg8::XLD + pg8::XOFS + 4 * (64 * j + lane)); }
        wave_sync();
#pragma unroll
        for (int u = 0; u < 2; ++u) { const int row = rowb + u; if (row < RL) { const float rs = frsq(sv[u] * (1.0f / D) + EPSN);
#pragma unroll
            for (int j = 0; j < 4; ++j) { const f32x4 x = {bflo(v[u][j].x), bfhi(v[u][j].x), bflo(v[u][j].y), bfhi(v[u][j].y)};
                *(f32x4*)(P.out + (size_t)row * D + 4 * (64 * j + lane)) = x * rs * g[j]; } } }
    }
}

constexpr size_t CTL_CTXCNT = 16384;
static_assert(CTL_QUEUE_OFS + 4 * 8 * 256 <= CTL_BYTES && CTL_QUEUE_OFS > CTL_CTXCNT + 256, "control words");
#ifndef EMU
DEV void handoff_publish(unsigned* cnt) {
    asm volatile("s_waitcnt vmcnt(0)" ::: "memory"); __syncthreads();
    if (threadIdx.x == 0) { __builtin_amdgcn_fence(__ATOMIC_RELEASE, "agent"); asm volatile("s_waitcnt vmcnt(0)" ::: "memory"); __hip_atomic_fetch_add(cnt, 1u, __ATOMIC_RELAXED, __HIP_MEMORY_SCOPE_AGENT); }
}
DEV void handoff_wait(unsigned* cnt, unsigned need) {
    if (threadIdx.x == 0) { unsigned sp = 0; while (__hip_atomic_load(cnt, __ATOMIC_RELAXED, __HIP_MEMORY_SCOPE_AGENT) < need) { __builtin_amdgcn_s_sleep(4); if (++sp > (1u << 24)) break; }
        __builtin_amdgcn_fence(__ATOMIC_ACQUIRE, "agent"); asm volatile("s_waitcnt vmcnt(0)" ::: "memory"); }
    __syncthreads();
}
#else
DEV void handoff_publish(unsigned* cnt) { emu_syncthreads(); if (threadIdx.x == 0) __atomic_fetch_add(cnt, 1u, __ATOMIC_SEQ_CST); }
DEV void handoff_wait(unsigned* cnt, unsigned need) { if (threadIdx.x == 0) { while (__atomic_load_n(cnt, __ATOMIC_SEQ_CST) < need) sched_yield(); } emu_syncthreads(); }
#endif
constexpr int N_PHASES = 19;
DEV void run_phase(const Params& P, LAS unsigned char* lds, int ph, int vb, int nvb) {
    float* ss = (float*)(P.ws + WS_SUMSQ); const float* MOD = (const float*)(P.ws + WS_MOD); const float* GS = (const float*)(P.ws + WS_GS);
    if (ph == 0) { phase0a(P, lds, vb, nvb); return; }
    if (ph == 1) { phase0b(P, lds, vb, nvb); return; }
    if (ph == N_PHASES - 1) { phase_final(P, vb, nvb); return; }
    const int l = (ph - 2) / 8, sub = (ph - 2) % 8;
    const int Mx = l == 1 ? M_LAST : ROWS;
    LAS float* red = (LAS float*)(lds + LDS_EPIRED);
    bf16_t* xs = (bf16_t*)P.out; bf16_t* xcs = (bf16_t*)(P.ws + WS_XC);
    constexpr int PML = RL / 256, PMC = RC / 256;
    const bool defer = SKIP_CTX_LAST;
    if (sub == 0) {
        pg8::Gemm g{(const bf16_t*)(P.ws + T_A), (const bf16_t*)(P.ws + WS_WIN + (size_t)l * WIN_BYTES), ROWS, NP, D};
        pg8::EpiIn E{ss + (size_t)(2 * l) * 4 * ROWS, (const float*)(P.ws + WS_SHW1) + (size_t)l * NMOD * NP, P.ws, lds + LDS_EPISTG};
        if (l == 0 || !defer) {
            pg8::StaticOrder S; S.init(ROWS, NP, nvb, vb);
            pg8::gemm_phase(lds + LDS_RING, g, S, E);
        } else {
            unsigned* cnt = (unsigned*)(P.ws + WS_CTL + CTL_CTXCNT);
            const int nct = PMC * (D / 256), nhb = nct < nvb ? nct : nvb;
            { pg8::Gemm g2{(const bf16_t*)(P.ws + T_HID), (const bf16_t*)(P.ws + WS_WFF2), ROWS, D, FF};
              pg8::SegOrder S; S.init(PML, PMC, D, vb, nvb, 1 << 20);
              pg8::EpiRes<true> E2{xs, xcs, xs, xcs, MOD + 5 * D, GS + (size_t)(2) * NMOD * D, (bf16_t*)(P.ws + T_A), ss + (size_t)2 * 4 * ROWS, red, lds + LDS_EPISTG};
              pg8::gemm_phase(lds + LDS_RING, g2, S, E2);
              if (vb < nhb) handoff_publish(cnt); }
            { const int ntot = PML * (NP / 256), nlight = nvb - nhb;
              const int per_light = nlight > 0 ? (ntot + 4 * nhb + nvb - 1) / nvb : 0, per_heavy = per_light > 4 ? per_light - 4 : 0;
              pg8::SegOrder S;
              if (vb >= nhb) S.init(0, PML, NP, vb - nhb, nlight, per_light); else S.init(0, PML, NP, nlight * per_light + vb, nhb, nlight > 0 ? per_heavy : 1 << 20);
              pg8::gemm_phase(lds + LDS_RING, g, S, E); }
            { pg8::SegOrder S; S.init(PML, PMC, NP, nvb - 1 - vb, nvb, 1 << 20);
              pg8::Unit u0; if (S.next(0, u0)) handoff_wait(cnt, (unsigned)nhb);
              pg8::gemm_phase(lds + LDS_RING, g, S, E); }
        }
    } else if (sub == 1) { phase_prep_a(P, lds, l, vb, nvb);
    } else if (sub == 2) { phase_prep_b(P, lds, l, vb, nvb);
    } else if (sub == 3) { phase_scan(P, lds, l, vb, nvb);
    } else if (sub == 4) { phase_merge(P, l, vb, nvb);
    } else if (sub == 5) {
        pg8::Gemm g{(const bf16_t*)(P.ws + T_Y), (const bf16_t*)(P.ws + WS_WOUT), Mx, D, D};
        const float* gtp = MOD + (size_t)l * NMOD * 6 * D + 2 * D; const float* gsp = GS + (size_t)(l * 2 + 1) * NMOD * D; float* ssp = ss + (size_t)(2 * l + 1) * 4 * ROWS;
        if (l == 0) { pg8::EpiRes<false> E{P.x, P.ctx, xs, xcs, gtp, gsp, (bf16_t*)(P.ws + T_A), ssp, red, lds + LDS_EPISTG};
            if (defer) { pg8::SegOrder S; S.init(0, PML, D, vb, nvb, 1 << 20); pg8::gemm_phase(lds + LDS_RING, g, S, E); }
            else { pg8::StaticOrder S; S.init(Mx, D, nvb, vb); pg8::gemm_phase(lds + LDS_RING, g, S, E); }
        } else { pg8::EpiRes<true> E{xs, xcs, xs, xcs, gtp, gsp, (bf16_t*)(P.ws + T_A), ssp, red, lds + LDS_EPISTG};
            pg8::StaticOrder S; S.init(Mx, D, nvb, vb); pg8::gemm_phase(lds + LDS_RING, g, S, E); }
    } else if (sub == 6) {
        pg8::Gemm g{(const bf16_t*)(P.ws + T_A), (const bf16_t*)(P.ws + WS_WFF1), Mx, FF, D};
        pg8::EpiFF1 E{ss + (size_t)(2 * l + 1) * 4 * ROWS, (const float*)(P.ws + WS_SHW2) + (size_t)l * NMOD * FF, (bf16_t*)(P.ws + T_HID), lds + LDS_EPISTG};
        if (l == 0 && defer) {
            { pg8::Gemm g2{(const bf16_t*)(P.ws + WS_YC) - (size_t)RL * D, (const bf16_t*)(P.ws + WS_WOUT), ROWS, D, D};
              pg8::EpiRes<false> E2{P.x, P.ctx, xs, xcs, MOD + 2 * D, GS + (size_t)(1) * NMOD * D, (bf16_t*)(P.ws + T_A), ss + (size_t)1 * 4 * ROWS, red, lds + LDS_EPISTG};
              pg8::SegOrder S; S.init(PML, PMC, D, nvb - 1 - vb, nvb, 1 << 20); pg8::gemm_phase(lds + LDS_RING, g2, S, E2); }
            { pg8::SegOrder S; S.init(0, PML, FF, vb, nvb, 1 << 20); pg8::gemm_phase(lds + LDS_RING, g, S, E); }
        } else { pg8::StaticOrder S; S.init(Mx, FF, nvb, vb); pg8::gemm_phase(lds + LDS_RING, g, S, E); }
    } else {
        pg8::Gemm g{(const bf16_t*)(P.ws + T_HID), (const bf16_t*)(P.ws + WS_WFF2), Mx, D, FF};
        pg8::EpiRes<true> E{xs, xcs, xs, xcs, MOD + (size_t)l * NMOD * 6 * D + 5 * D, l == 0 ? GS + (size_t)(2) * NMOD * D : nullptr,
                      (bf16_t*)(P.ws + T_A), ss + (size_t)(l == 0 ? 2 : 4) * 4 * ROWS, red, lds + LDS_EPISTG};
        if (l == 0 && defer) {
            { pg8::Gemm g2{(const bf16_t*)(P.ws + T_A), (const bf16_t*)(P.ws + WS_WFF1), ROWS, FF, D};
              pg8::EpiFF1 E2{ss + (size_t)1 * 4 * ROWS, (const float*)(P.ws + WS_SHW2), (bf16_t*)(P.ws + T_HID), lds + LDS_EPISTG};
              pg8::SegOrder S; S.init(PML, PMC, FF, nvb - 1 - vb, nvb, 1 << 20); pg8::gemm_phase(lds + LDS_RING, g2, S, E2); }
            { pg8::SegOrder S; S.init(0, PML, D, vb, nvb, 1 << 20); pg8::gemm_phase(lds + LDS_RING, g, S, E); }
        } else { pg8::StaticOrder S; S.init(Mx, D, nvb, vb); pg8::gemm_phase(lds + LDS_RING, g, S, E); }
    }
}

#ifndef EMU
#define XB_TMO      128
#define XB_XCNT(j)  (256  + 64 * (j))
#define XB_XSUB(j)  (1280 + 64 * (j))
#define XB_XGEN(j)  (2304 + 64 * (j))
#define XB_TOP      3328
#define XB_TOPGEN   3392
#define XCD_BAR_WORDS 3456
#define XB_SPIN_CAP (1u << 22)
__device__ __forceinline__ unsigned xb_ld(unsigned* p)              { return __hip_atomic_load(p, __ATOMIC_RELAXED, __HIP_MEMORY_SCOPE_AGENT); }
__device__ __forceinline__ unsigned xb_add(unsigned* p, unsigned v) { return __hip_atomic_fetch_add(p, v, __ATOMIC_RELAXED, __HIP_MEMORY_SCOPE_AGENT); }
__device__ __forceinline__ unsigned xb_xcc_id() { return (unsigned)__builtin_amdgcn_s_getreg((3 << 11) | 20) & 0xFu; }
#define XB_SPIN(cond, bar) do { unsigned _sp = 0; while (cond) { __builtin_amdgcn_s_sleep(1); \
    if ((++_sp & 255u) == 0u) { if (xb_ld(&(bar)[XB_TMO])) break; if (_sp > XB_SPIN_CAP) { atomicAdd(&(bar)[XB_TMO], 1u); break; } } } } while (0)
struct XcdBarrier { unsigned* bar; unsigned x; volatile LAS unsigned* st; };
__device__ __forceinline__ XcdBarrier xcd_barrier_post(unsigned* bar, volatile LAS unsigned* st) {
    XcdBarrier b; b.bar = bar; b.x = xb_xcc_id(); b.st = st;
    if (threadIdx.x == 0) (void)xb_add(&bar[XB_XCNT(b.x)], 1u);
    return b;
}
__device__ __forceinline__ void xcd_barrier_complete(unsigned* bar, unsigned x, unsigned& nloc, unsigned& nx) {
    const unsigned G = gridDim.x * gridDim.y * gridDim.z;
    unsigned sum, cnt, mine, sp = 0u;
    for (;;) {
        sum = 0u; cnt = 0u; mine = 0u;
#pragma unroll
        for (unsigned j = 0; j < 16; ++j) { const unsigned c = xb_ld(&bar[XB_XCNT(j)]); sum += c; cnt += (c > 0u) ? 1u : 0u; mine = (j == x) ? c : mine; }
        if (sum == G) break;
        __builtin_amdgcn_s_sleep(1);
        if ((++sp & 255u) == 0u) { if (xb_ld(&bar[XB_TMO])) break; if (sp > XB_SPIN_CAP) { atomicAdd(&bar[XB_TMO], 1u); break; } }
    }
    nloc = mine > 0u ? mine : 1u; nx = cnt > 0u ? cnt : 1u;
}
__device__ __forceinline__ void xcd_barrier(const XcdBarrier& b) {
    asm volatile("s_waitcnt vmcnt(0)" ::: "memory");
    __syncthreads();
    if (threadIdx.x == 0) {
        unsigned* bar = b.bar;
        __builtin_amdgcn_s_waitcnt(0);
        unsigned nloc = b.st[0], nx = b.st[1];
        if (nloc == 0u) { xcd_barrier_complete(bar, b.x, nloc, nx); b.st[0] = nloc; b.st[1] = nx; }
        const unsigned old = xb_add(&bar[XB_XSUB(b.x)], 1u);
        const unsigned gen = old / nloc;
        if (old + 1u == (gen + 1u) * nloc) {
            __builtin_amdgcn_fence(__ATOMIC_RELEASE, "agent");
            asm volatile("s_waitcnt vmcnt(0)" ::: "memory");
            const unsigned og = xb_add(&bar[XB_TOP], 1u);
            const unsigned tg = og / nx;
            if (og + 1u == (tg + 1u) * nx) xb_add(&bar[XB_TOPGEN], 1u);
            else XB_SPIN(xb_ld(&bar[XB_TOPGEN]) == tg, bar);
            __builtin_amdgcn_fence(__ATOMIC_ACQUIRE, "agent");
            xb_add(&bar[XB_XGEN(b.x)], 1u);
            asm volatile("s_waitcnt vmcnt(0)" ::: "memory");
        } else {
            XB_SPIN(xb_ld(&bar[XB_XGEN(b.x)]) == gen, bar);
            __builtin_amdgcn_fence(__ATOMIC_ACQUIRE, "agent");
            asm volatile("s_waitcnt vmcnt(0)" ::: "memory");
        }
    }
    __syncthreads();
}
constexpr int LDS_MISC = 163840 - 256;

__global__ void __launch_bounds__(NT, 2) k_mega(Params P) {
    extern __shared__ __attribute__((aligned(16))) unsigned char lds_raw[];
    LAS unsigned char* lds = (LAS unsigned char*)lds_raw;
    cg::grid_group grid = cg::this_grid();
    if (threadIdx.x < 64) ((LAS unsigned*)(lds + LDS_MISC))[threadIdx.x] = 0u;
    __syncthreads();
    XcdBarrier bar = xcd_barrier_post((unsigned*)(P.ws + WS_CTL), (volatile LAS unsigned*)(lds + LDS_MISC));
    for (int ph = 0; ph < N_PHASES; ++ph) {
        run_phase(P, lds, ph, (int)blockIdx.x, (int)gridDim.x);
        if (ph == 0) grid.sync();
        else if (ph + 1 < N_PHASES) xcd_barrier(bar);
    }
}

extern "C" void kernel_launch(void* const* d_in, const int* in_sizes, int n_in, void* d_out, int out_size, void* d_ws, size_t ws_size, hipStream_t stream) {
    static int grid = 0;
    if (grid == 0) {
        int dev = 0, cus = 0, per_cu = 0;
        (void)hipGetDevice(&dev); (void)hipDeviceGetAttribute(&cus, hipDeviceAttributeMultiprocessorCount, dev);
        (void)hipFuncSetAttribute((const void*)k_mega, hipFuncAttributeMaxDynamicSharedMemorySize, LDS_BYTES);
        (void)hipOccupancyMaxActiveBlocksPerMultiprocessor(&per_cu, (const void*)k_mega, NT, LDS_BYTES);
        if (per_cu < 1) { fprintf(stderr, "kernel_launch: occupancy query says %d blocks per CU\n", per_cu); per_cu = 1; }
        if (per_cu > 1) per_cu = 1;
        grid = (cus > 0 ? cus : 256) * per_cu;
        if (ws_size < WS_END) { fprintf(stderr, "kernel_launch: workspace too small: %zu < %zu\n", ws_size, (size_t)WS_END); grid = -1; }
    }
    if (grid < 0) return;
    Params P{};
    const float** pp = (const float**)&P;
    for (int i = 0; i < 20; ++i) pp[i] = (const float*)d_in[i];
    P.out = (float*)d_out; P.ws = (unsigned char*)d_ws;
    (void)hipMemsetAsync((char*)d_ws + WS_CTL, 0, CTL_BYTES, stream);
    void* args[] = {&P};
    hipError_t e = hipLaunchCooperativeKernel((const void*)k_mega, dim3(grid), dim3(NT), args, LDS_BYTES, stream);
    if (e != hipSuccess) fprintf(stderr, "cooperative launch failed: %s (grid %d)\n", hipGetErrorString(e), grid);
}
#endif
```
